# Optimizing an MI355X kernel written in HIP

```python
import math
import jax, jax.numpy as jnp
from jax import lax
import numpy as np

D_MODEL = 1024
BATCH = 4
SEQ = 8192
DEPTH = 2
DEC_BATCH = 8
DEC_SEQ = 32
PAST_LEN = 1024

CHUNK = 64
Q_BLOCK = 128
HEAD_DIM = 64
H_A = 4
H_B = 4
H_C = 4
H_X = 4
C_PREV = 8
C_PAST = C_PREV * CHUNK
REL_CLIP = 128
T5_BUCKETS = 32
T5_MAX_DIST = 128
N_MEM = 256
D_FF = 4 * D_MODEL
WA = H_A * 2 * HEAD_DIM
WB = H_B * HEAD_DIM
WC = H_C * HEAD_DIM
WX = H_X * HEAD_DIM
N_BRANCH = 3
IN_SPLITS = (WA, WA, WA, WB, WB, WB, WC, WC, WC, N_BRANCH * D_MODEL)
IN_COLS = sum(IN_SPLITS)
EPS = 1e-6

kernel_name = 'hybrid_chunk_streaming_encoder_step'


def rmsnorm(x, g):
    xf = x.astype(jnp.float32)
    y = xf * lax.rsqrt(jnp.mean(xf * xf, axis=-1, keepdims=True) + EPS)
    return (y * g.astype(jnp.float32)).astype(x.dtype)


def half_ffn(x, g, wg, wu, wd):
    h = rmsnorm(x, g)
    return 0.5 * ((jax.nn.silu(h @ wg) * (h @ wu)) @ wd)


def lambda_init(layer):
    return 0.8 - 0.6 * math.exp(-0.3 * layer)


def diff_lambda(lq1, lk1, lq2, lk2, layer):
    f = lambda a, b: jnp.exp(jnp.sum(a.astype(jnp.float32) * b.astype(jnp.float32)))
    return f(lq1, lk1) - f(lq2, lk2) + lambda_init(layer)


def t5_bucket(rel):
    half = T5_BUCKETS // 2
    max_exact = half // 2
    n = jnp.abs(rel)
    nf = jnp.maximum(n, 1).astype(jnp.float32)
    large = max_exact + (jnp.log(nf / max_exact) / math.log(T5_MAX_DIST / max_exact) * (half - max_exact)).astype(jnp.int32)
    large = jnp.minimum(large, half - 1)
    return jnp.where(rel > 0, half, 0) + jnp.where(n < max_exact, n, large)


def diff_attend(q, k, v, qpos, kpos, t5_bias, lam):
    bias = jnp.transpose(t5_bias[t5_bucket(kpos[None, :] - qpos[:, None])], (2, 0, 1)).astype(jnp.float32)
    mask = (kpos[None, :] // CHUNK) <= (qpos[:, None] // CHUNK)
    s = jnp.einsum('bqhmd,bkhmd->bmhqk', q, k).astype(jnp.float32) * (HEAD_DIM ** -0.5) + bias
    p = jax.nn.softmax(jnp.where(mask, s, -jnp.inf), axis=-1)
    a = p[:, 0] - lam * p[:, 1]
    return jnp.einsum('bhqk,bkhe->bqhe', a.astype(v.dtype), v)


def stick_attend(q, k, v, qpos, kpos):
    z = jnp.einsum('bqhd,bkhd->bhqk', q, k).astype(jnp.float32) * (HEAD_DIM ** -0.5)
    valid = kpos[None, :] < qpos[:, None]
    log_1m = jnp.where(valid, jax.nn.log_sigmoid(-z), 0.0)
    after = lax.cumsum(log_1m, axis=3, reverse=True) - log_1m
    w = jnp.where(valid, jnp.exp(jax.nn.log_sigmoid(z) + after), 0.0)
    return jnp.einsum('bhqk,bkhd->bqhd', w.astype(v.dtype), v)


def band_attend(q, k, v, qpos, kpos, rel_table):
    rel = kpos[:, None, :] - qpos[:, :, None]
    bias = jnp.moveaxis(rel_table[:, jnp.clip(rel, -REL_CLIP, REL_CLIP) + REL_CLIP], 0, 1).astype(jnp.float32)
    qc = qpos[:, :, None] // CHUNK
    kc = kpos[:, None, :] // CHUNK
    mask = (kpos[:, None, :] >= 0) & (kc <= qc) & (kc >= qc - C_PREV)
    s = jnp.einsum('bcqhd,bckhd->bchqk', q, k).astype(jnp.float32) * (HEAD_DIM ** -0.5) + bias
    p = jax.nn.softmax(jnp.where(mask[:, None], s, -jnp.inf), axis=-1)
    return jnp.einsum('bchqk,bckhd->bcqhd', p.astype(v.dtype), v)


def band_gather(t):
    b, s, h, d = t.shape
    nc = s // CHUNK
    tp = jnp.pad(t.reshape(b, nc, CHUNK, h, d), ((0, 0), (C_PREV, 0), (0, 0), (0, 0), (0, 0)))
    return jnp.concatenate([tp[:, j:j + nc] for j in range(C_PREV + 1)], axis=2)


def map_query_blocks(attend, q):
    b, s = q.shape[0], q.shape[1]
    nb = s // Q_BLOCK
    qb = jnp.moveaxis(q.reshape((b, nb, Q_BLOCK) + q.shape[2:]), 1, 0)

    def body(args):
        qi, bi = args
        return attend(qi, bi * Q_BLOCK + jnp.arange(Q_BLOCK))

    o = lax.map(body, (qb, jnp.arange(nb)))
    return jnp.moveaxis(o, 0, 1).reshape((b, s) + o.shape[3:])


def mixer_project(x, g, w_in, a_qn, a_kn, c_qn, c_kn):
    h = rmsnorm(x, g)
    lead = h.shape[:-1]
    cuts = [int(c) for c in np.cumsum(IN_SPLITS)[:-1]]
    qa, ka, va, qb, kb, vb, qc, kc, vc, gz = jnp.split(h @ w_in, cuts, axis=-1)
    qa = rmsnorm(qa.reshape(lead + (H_A, 2, HEAD_DIM)), a_qn)
    ka = rmsnorm(ka.reshape(lead + (H_A, 2, HEAD_DIM)), a_kn)
    va = va.reshape(lead + (H_A, 2 * HEAD_DIM))
    qb = qb.reshape(lead + (H_B, HEAD_DIM))
    kb = kb.reshape(lead + (H_B, HEAD_DIM))
    vb = vb.reshape(lead + (H_B, HEAD_DIM))
    qc = rmsnorm(qc.reshape(lead + (H_C, HEAD_DIM)), c_qn)
    kc = rmsnorm(kc.reshape(lead + (H_C, HEAD_DIM)), c_kn)
    vc = vc.reshape(lead + (H_C, HEAD_DIM))
    gates = jax.nn.sigmoid(gz.reshape(lead + (N_BRANCH, D_MODEL)))
    return qa, ka, va, qb, kb, vb, qc, kc, vc, gates


def mixer_merge(oa, ob, oc, gates, subln, layer, w_br_a, w_br_b, w_br_c, w_out):
    lead = oa.shape[:-2]
    oa = rmsnorm(oa, subln) * (1.0 - lambda_init(layer))
    ba = oa.reshape(lead + (WA,)) @ w_br_a
    bb = ob.reshape(lead + (WB,)) @ w_br_b
    bc = oc.reshape(lead + (WC,)) @ w_br_c
    merged = gates[..., 0, :] * ba + gates[..., 1, :] * bb + gates[..., 2, :] * bc
    return merged @ w_out


def memory_kv(mem, g, w_kv, kn):
    lead = mem.shape[:-1]
    mk, mv = jnp.split(rmsnorm(mem, g) @ w_kv, 2, axis=-1)
    return rmsnorm(mk.reshape(lead + (H_X, HEAD_DIM)), kn), mv.reshape(lead + (H_X, HEAD_DIM))


def cross_attend(x, mk, mv, g, w_q, qn, w_o):
    lead = x.shape[:-1]
    q = rmsnorm((rmsnorm(x, g) @ w_q).reshape(lead + (H_X, HEAD_DIM)), qn)
    s = jnp.einsum('bqhd,bmhd->bhqm', q, mk).astype(jnp.float32) * (HEAD_DIM ** -0.5)
    p = jax.nn.softmax(s, axis=-1)
    o = jnp.einsum('bhqm,bmhd->bqhd', p.astype(mv.dtype), mv)
    return o.reshape(lead + (WX,)) @ w_o


def setup_inputs(seed: int = 0) -> dict:
    key = jax.random.key(seed)
    ks = iter(jax.random.split(key, 64))
    nrm = lambda shape, scale: jax.random.normal(next(ks), shape, jnp.float32) * scale
    gain = lambda shape: 1.0 + 0.05 * jax.random.normal(next(ks), shape, jnp.float32)
    c_buf = min(C_PAST, PAST_LEN)
    L = DEPTH
    return {
        'x_prompt': nrm((BATCH, SEQ, D_MODEL), 1.0),
        'x_sample': nrm((DEC_BATCH, DEC_SEQ, D_MODEL), 1.0),
        'mem_prompt': nrm((BATCH, N_MEM, D_MODEL), 1.0),
        'cache_a_k': nrm((L, DEC_BATCH, PAST_LEN, H_A, 2 * HEAD_DIM), 1.0),
        'cache_a_v': nrm((L, DEC_BATCH, PAST_LEN, H_A, 2 * HEAD_DIM), 1.0),
        'cache_b_k': nrm((L, DEC_BATCH, PAST_LEN, H_B, HEAD_DIM), 1.0),
        'cache_b_v': nrm((L, DEC_BATCH, PAST_LEN, H_B, HEAD_DIM), 1.0),
        'cache_c_k': nrm((L, DEC_BATCH, c_buf, H_C, HEAD_DIM), 1.0),
        'cache_c_v': nrm((L, DEC_BATCH, c_buf, H_C, HEAD_DIM), 1.0),
        'cache_mem_k': nrm((L, DEC_BATCH, N_MEM, H_X, HEAD_DIM), 1.0),
        'cache_mem_v': nrm((L, DEC_BATCH, N_MEM, H_X, HEAD_DIM), 1.0),
        't5_bias': nrm((T5_BUCKETS, H_A), 0.5),
        'ffn1_norm': gain((L, D_MODEL)),
        'ffn1_wg': nrm((L, D_MODEL, D_FF), D_MODEL ** -0.5),
        'ffn1_wu': nrm((L, D_MODEL, D_FF), D_MODEL ** -0.5),
        'ffn1_wd': nrm((L, D_FF, D_MODEL), D_FF ** -0.5),
        'mix_norm': gain((L, D_MODEL)),
        'w_in': nrm((L, D_MODEL, IN_COLS), D_MODEL ** -0.5),
        'a_qnorm': gain((L, HEAD_DIM)),
        'a_knorm': gain((L, HEAD_DIM)),
        'a_lq1': nrm((L, HEAD_DIM), 0.1),
        'a_lk1': nrm((L, HEAD_DIM), 0.1),
        'a_lq2': nrm((L, HEAD_DIM), 0.1),
        'a_lk2': nrm((L, HEAD_DIM), 0.1),
        'a_subln': gain((L, 2 * HEAD_DIM)),
        'c_qnorm': gain((L, HEAD_DIM)),
        'c_knorm': gain((L, HEAD_DIM)),
        'c_rel_bias': nrm((L, H_C, 2 * REL_CLIP + 1), 0.5),
        'w_br_a': nrm((L, WA, D_MODEL), WA ** -0.5),
        'w_br_b': nrm((L, WB, D_MODEL), WB ** -0.5),
        'w_br_c': nrm((L, WC, D_MODEL), WC ** -0.5),
        'w_out': nrm((L, D_MODEL, D_MODEL), D_MODEL ** -0.5),
        'x_norm': gain((L, D_MODEL)),
        'mem_norm': gain((L, D_MODEL)),
        'x_wq': nrm((L, D_MODEL, WX), D_MODEL ** -0.5),
        'x_wkv': nrm((L, D_MODEL, 2 * WX), D_MODEL ** -0.5),
        'x_qnorm': gain((L, HEAD_DIM)),
        'x_knorm': gain((L, HEAD_DIM)),
        'x_wo': nrm((L, WX, D_MODEL), WX ** -0.5),
        'ffn2_norm': gain((L, D_MODEL)),
        'ffn2_wg': nrm((L, D_MODEL, D_FF), D_MODEL ** -0.5),
        'ffn2_wu': nrm((L, D_MODEL, D_FF), D_MODEL ** -0.5),
        'ffn2_wd': nrm((L, D_FF, D_MODEL), D_FF ** -0.5),
    }


def reference(x_prompt, x_sample, mem_prompt, cache_a_k, cache_a_v, cache_b_k, cache_b_v,
              cache_c_k, cache_c_v, cache_mem_k, cache_mem_v, t5_bias,
              ffn1_norm, ffn1_wg, ffn1_wu, ffn1_wd, mix_norm, w_in,
              a_qnorm, a_knorm, a_lq1, a_lk1, a_lq2, a_lk2, a_subln,
              c_qnorm, c_knorm, c_rel_bias, w_br_a, w_br_b, w_br_c, w_out,
              x_norm, mem_norm, x_wq, x_wkv, x_qnorm, x_knorm, x_wo,
              ffn2_norm, ffn2_wg, ffn2_wu, ffn2_wd):
    xp = x_prompt
    bp, sp = xp.shape[0], xp.shape[1]
    nc = sp // CHUNK
    pos_p = jnp.arange(sp)
    qpos_band = pos_p.reshape(nc, CHUNK)
    kpos_band = (jnp.arange(nc)[:, None] - C_PREV) * CHUNK + jnp.arange((C_PREV + 1) * CHUNK)[None, :]
    w_keep = min(C_PAST, sp)
    ak_p, av_p, bk_p, bv_p, ck_p, cv_p, mk_p, mv_p = [], [], [], [], [], [], [], []
    for i in range(DEPTH):
        xp = xp + half_ffn(xp, ffn1_norm[i], ffn1_wg[i], ffn1_wu[i], ffn1_wd[i])
        qa, ka, va, qb, kb, vb, qc, kc, vc, gates = mixer_project(
            xp, mix_norm[i], w_in[i], a_qnorm[i], a_knorm[i], c_qnorm[i], c_knorm[i])
        lam = diff_lambda(a_lq1[i], a_lk1[i], a_lq2[i], a_lk2[i], i)
        oa = map_query_blocks(lambda qi, qpos: diff_attend(qi, ka, va, qpos, pos_p, t5_bias, lam), qa)
        ob = map_query_blocks(lambda qi, qpos: stick_attend(qi, kb, vb, qpos, pos_p), qb)
        oc = band_attend(qc.reshape(bp, nc, CHUNK, H_C, HEAD_DIM), band_gather(kc), band_gather(vc),
                         qpos_band, kpos_band, c_rel_bias[i]).reshape(bp, sp, H_C, HEAD_DIM)
        xp = xp + mixer_merge(oa, ob, oc, gates, a_subln[i], i, w_br_a[i], w_br_b[i], w_br_c[i], w_out[i])
        mk, mv = memory_kv(mem_prompt, mem_norm[i], x_wkv[i], x_knorm[i])
        xp = xp + cross_attend(xp, mk, mv, x_norm[i], x_wq[i], x_qnorm[i], x_wo[i])
        xp = xp + half_ffn(xp, ffn2_norm[i], ffn2_wg[i], ffn2_wu[i], ffn2_wd[i])
        ak_p.append(ka.reshape(bp, sp, H_A, 2 * HEAD_DIM))
        av_p.append(va)
        bk_p.append(kb)
        bv_p.append(vb)
        ck_p.append(kc[:, sp - w_keep:])
        cv_p.append(vc[:, sp - w_keep:])
        mk_p.append(mk)
        mv_p.append(mv)

    xs = x_sample
    bs, ns = xs.shape[0], xs.shape[1]
    past = cache_a_k.shape[2]
    w_buf = cache_c_k.shape[2]
    qpos_s = past + jnp.arange(ns)
    kpos_s = jnp.arange(past + ns)
    kpos_sb = (past - w_buf + jnp.arange(w_buf + ns))[None, :]
    ak_s, av_s, bk_s, bv_s, ck_s, cv_s = [], [], [], [], [], []
    for i in range(DEPTH):
        xs = xs + half_ffn(xs, ffn1_norm[i], ffn1_wg[i], ffn1_wu[i], ffn1_wd[i])
        qa, ka, va, qb, kb, vb, qc, kc, vc, gates = mixer_project(
            xs, mix_norm[i], w_in[i], a_qnorm[i], a_knorm[i], c_qnorm[i], c_knorm[i])
        lam = diff_lambda(a_lq1[i], a_lk1[i], a_lq2[i], a_lk2[i], i)
        ka_all = jnp.concatenate([cache_a_k[i].reshape(bs, past, H_A, 2, HEAD_DIM), ka], axis=1)
        va_all = jnp.concatenate([cache_a_v[i], va], axis=1)
        oa = diff_attend(qa, ka_all, va_all, qpos_s, kpos_s, t5_bias, lam)
        kb_all = jnp.concatenate([cache_b_k[i], kb], axis=1)
        vb_all = jnp.concatenate([cache_b_v[i], vb], axis=1)
        ob = stick_attend(qb, kb_all, vb_all, qpos_s, kpos_s)
        kc_all = jnp.concatenate([cache_c_k[i], kc], axis=1)
        vc_all = jnp.concatenate([cache_c_v[i], vc], axis=1)
        oc = band_attend(qc[:, None], kc_all[:, None], vc_all[:, None], qpos_s[None, :], kpos_sb, c_rel_bias[i])[:, 0]
        xs = xs + mixer_merge(oa, ob, oc, gates, a_subln[i], i, w_br_a[i], w_br_b[i], w_br_c[i], w_out[i])
        xs = xs + cross_attend(xs, cache_mem_k[i], cache_mem_v[i], x_norm[i], x_wq[i], x_qnorm[i], x_wo[i])
        xs = xs + half_ffn(xs, ffn2_norm[i], ffn2_wg[i], ffn2_wu[i], ffn2_wd[i])
        ak_s.append(ka.reshape(bs, ns, H_A, 2 * HEAD_DIM))
        av_s.append(va)
        bk_s.append(kb)
        bv_s.append(vb)
        ck_s.append(kc_all[:, ns:])
        cv_s.append(vc_all[:, ns:])

    return (xp, xs,
            jnp.stack(ak_p), jnp.stack(av_p), jnp.stack(bk_p), jnp.stack(bv_p),
            jnp.stack(ck_p), jnp.stack(cv_p), jnp.stack(mk_p), jnp.stack(mv_p),
            jnp.stack(ak_s), jnp.stack(av_s), jnp.stack(bk_s), jnp.stack(bv_s),
            jnp.stack(ck_s), jnp.stack(cv_s))
```

```cpp
#include <hip/hip_runtime.h>
#include <hip/hip_cooperative_groups.h>
#include <cstdio>
#include <cstdint>
namespace cg = cooperative_groups;
namespace pg8 {
#define PG8_LAS __attribute__((address_space(3)))
typedef unsigned short bf16_t;
typedef short bf16x8 __attribute__((ext_vector_type(8)));
typedef float f32x4 __attribute__((ext_vector_type(4)));
typedef unsigned u32x4 __attribute__((ext_vector_type(4)));
constexpr int BM = 256, BK = 64, HALF = 128, HTB = HALF * BK * 2  , STAGE_BYTES = 8 * HTB, NXCD = 8, WGM = 8;

__host__ __device__ __forceinline__ int lds_byte(int r, int c) { const int st = (r >> 4) * 2 + (c >> 5), rr = r & 15, cc = c & 31, ob = rr * 64 + cc * 2; return st * 1024 + (ob ^ (((ob >> 9) & 1) << 5)); }
__host__ __device__ __forceinline__ void stage_rc(int b, int& R, int& C) { const int st = b / 1024, sb = b % 1024, swz = sb ^ (((sb >> 9) & 1) << 5); R = (st >> 1) * 16 + swz / 64; C = (st & 1) * 32 + (swz % 64) / 2; }
__host__ __device__ __forceinline__ int perm32(int rho) { const int n = rho >> 4, i = rho & 15; return 8 * (i >> 2) + 4 * n + (i & 3); }

struct Unit { int pm, pn; };
struct Gemm { const bf16_t* A; const bf16_t* Bt; int M, N, K; };

struct StaticOrder {
    int nM, nN, nwg, G, c;
    __host__ __device__ void init(int M, int N, int G_, int c_) { nM = M / BM; nN = N / BM; nwg = nM * nN; G = G_; c = c_; }
    __host__ __device__ bool next(int i, Unit& u) const {
        const long L = (long)i * G + c; if (L >= nwg) return false;
        int wgid = (int)L; { const int q = nwg / NXCD, r = nwg % NXCD, xcd = wgid % NXCD, off = wgid / NXCD; wgid = (xcd < r ? xcd * (q + 1) : r * (q + 1) + (xcd - r) * q) + off; }
        const int nig = WGM * nN, gid = wgid / nig, fm = gid * WGM, gsz = (nM - fm) < WGM ? (nM - fm) : WGM;
        u.pm = fm + ((wgid % nig) % gsz); u.pn = (wgid % nig) / gsz; return true;
    }
    __device__ __forceinline__ void a_ready(const Unit&) const {}
    __device__ __forceinline__ void done(const Unit&) const {}
};

__device__ __forceinline__ unsigned cvt_pk_bf16(float lo, float hi) { unsigned r; asm volatile("v_cvt_pk_bf16_f32 %0, %1, %2" : "=v"(r) : "v"(lo), "v"(hi)); return r; }
typedef float f32x2 __attribute__((ext_vector_type(2)));
template <class Epi, class Sched, bool ALIGN_EPI = false, bool SP2 = false>
__device__ __forceinline__ void gemm_phase(PG8_LAS unsigned char* lds, const Gemm g, const Sched& S, const Epi& E) {
    int tid_l = threadIdx.x; asm volatile("" : "+v"(tid_l));
    const int tid = tid_l, wid = __builtin_amdgcn_readfirstlane(tid >> 6), lane = tid & 63, wr = wid >> 2, wc = wid & 3, fr = lane & 15, fq = lane >> 4;
    const int K = g.K, nt = K / BK;
    unsigned voffA[2], voffB[2];
#pragma unroll
    for (int i = 0; i < 2; ++i) { int R, C; stage_rc(tid * 16 + i * 8192, R, C); const int Rb = Epi::PERM ? ((R & ~31) + perm32(R & 31)) : R;
        voffA[i] = (unsigned)(R * K + C) * 2u; voffB[i] = (unsigned)(Rb * K + C) * 2u; }
    const size_t kstep = (size_t)(BK * 2);
    const size_t hstep = (size_t)HALF * K * 2;
    const size_t tstep = 2 * hstep;
    const unsigned ldsw = (unsigned)wid * 1024u;
    const int aoff = lds_byte(wr * 64 + fr, fq * 8), boff = lds_byte(wc * 32 + fr, fq * 8);
#define PG8_SA(b, h) (((b) * 2 + (h)) * HTB)
#define PG8_SB(b, h) ((4 + (b) * 2 + (h)) * HTB)
#define PG8_STAGE(bufoff, gbase, voff) do { _Pragma("unroll") for (int _i = 0; _i < 2; ++_i) \
        __builtin_amdgcn_global_load_lds((const unsigned*)((const char*)(gbase) + (voff)[_i]), (PG8_LAS unsigned*)(lds + (bufoff) + ldsw + _i * 8192), 16, 0, 0); } while (0)
#define PG8_LDA(dst, b, h) do { _Pragma("unroll") for (int m = 0; m < 4; ++m) _Pragma("unroll") for (int k = 0; k < 2; ++k) dst[m][k] = *(const PG8_LAS bf16x8*)(lds + PG8_SA(b, h) + aoff + m * 2048 + k * 1024); } while (0)
#define PG8_LDB(dst, b, h) do { _Pragma("unroll") for (int n = 0; n < 2; ++n) _Pragma("unroll") for (int k = 0; k < 2; ++k) dst[n][k] = *(const PG8_LAS bf16x8*)(lds + PG8_SB(b, h) + boff + n * 2048 + k * 1024); } while (0)
#define PG8_MMA(ai, bj, At, Bt) do { __builtin_amdgcn_s_setprio(1); _Pragma("unroll") for (int m = 0; m < 4; ++m) _Pragma("unroll") for (int n = 0; n < 2; ++n) _Pragma("unroll") for (int k = 0; k < 2; ++k) \
        acc[ai][bj][m][n] = __builtin_amdgcn_mfma_f32_16x16x32_bf16(Bt[n][k], At[m][k], acc[ai][bj][m][n], 0, 0, 0); __builtin_amdgcn_s_setprio(0); } while (0)
#define PG8_WAIT_V(n) asm volatile("s_waitcnt vmcnt(" #n ")" ::: "memory")
#define PG8_WAIT_L(n) asm volatile("s_waitcnt lgkmcnt(" #n ")" ::: "memory")
#define PG8_BAR __builtin_amdgcn_s_barrier()
#define PG8_SCHED __builtin_amdgcn_sched_barrier(0)
    Unit cur, nxt; int ui = 0;
    if (!S.next(0, cur)) return;
    f32x4 acc[2][2][4][2];
#pragma unroll
    for (int a = 0; a < 2; ++a)
#pragma unroll
        for (int b = 0; b < 2; ++b)
#pragma unroll
            for (int m = 0; m < 4; ++m)
#pragma unroll
                for (int n = 0; n < 2; ++n) acc[a][b][m][n] = (f32x4){0.f, 0.f, 0.f, 0.f};
    bf16x8 At[4][2], B0[2][2], B1[2][2];
    const char* cA = (const char*)g.A + (size_t)cur.pm * tstep; const char* cB = (const char*)g.Bt + (size_t)cur.pn * tstep;
    S.a_ready(cur);
    if constexpr (SP2) {
        PG8_STAGE(PG8_SB(0, 0), cB, voffB); PG8_STAGE(PG8_SB(0, 1), cB + hstep, voffB); PG8_STAGE(PG8_SA(0, 0), cA, voffA); PG8_STAGE(PG8_SA(0, 1), cA + hstep, voffA);
        if (wr == 1) PG8_BAR;
        PG8_WAIT_V(2); PG8_BAR;
        PG8_STAGE(PG8_SB(1, 0), cB + kstep, voffB); PG8_STAGE(PG8_SA(1, 0), cA + kstep, voffA); PG8_STAGE(PG8_SB(1, 1), cB + hstep + kstep, voffB);
        PG8_WAIT_V(6); PG8_BAR;
    } else {
        PG8_STAGE(PG8_SB(0, 0), cB, voffB); PG8_STAGE(PG8_SA(0, 0), cA, voffA); PG8_STAGE(PG8_SB(0, 1), cB + hstep, voffB); PG8_STAGE(PG8_SA(0, 1), cA + hstep, voffA);
        if (wr == 1) PG8_BAR;
        PG8_WAIT_V(4); PG8_BAR;
        PG8_STAGE(PG8_SB(1, 0), cB + kstep, voffB); PG8_STAGE(PG8_SA(1, 0), cA + kstep, voffA); PG8_STAGE(PG8_SB(1, 1), cB + hstep + kstep, voffB);
        PG8_WAIT_V(6); PG8_BAR;
    }
    for (;;) {
        const bool has_next = S.next(ui + 1, nxt);
        const char* nA = has_next ? (const char*)g.A + (size_t)nxt.pm * tstep : cA; const char* nB = has_next ? (const char*)g.Bt + (size_t)nxt.pn * tstep : cB;
        for (int t = 0; t < nt; t += 2) {
            const bool last = (t == nt - 2);
            const char* a1 = cA + (size_t)(t + 1) * kstep;
            const char* a2 = last ? nA : cA + (size_t)(t + 2) * kstep; const char* b2 = last ? nB : cB + (size_t)(t + 2) * kstep;
            const char* a3 = a2 + kstep; const char* b3 = b2 + kstep;
            if (last && has_next) S.a_ready(nxt);
            if constexpr (SP2) {
            PG8_LDB(B0, 0, 0); PG8_LDB(B1, 0, 1); PG8_SCHED; PG8_LDA(At, 0, 0); PG8_STAGE(PG8_SA(1, 1), a1 + hstep, voffA);
            PG8_WAIT_V(8); PG8_WAIT_L(0); PG8_BAR; PG8_MMA(0, 0, At, B0); PG8_MMA(0, 1, At, B1); PG8_BAR; PG8_SCHED;
            PG8_LDA(At, 0, 1); PG8_STAGE(PG8_SB(0, 0), b2, voffB); PG8_STAGE(PG8_SB(0, 1), b2 + hstep, voffB); PG8_STAGE(PG8_SA(0, 0), a2, voffA);
            PG8_WAIT_V(8); PG8_WAIT_L(0); PG8_BAR; PG8_MMA(1, 0, At, B0); PG8_MMA(1, 1, At, B1); PG8_BAR; PG8_SCHED;
            PG8_LDB(B0, 1, 0); PG8_LDB(B1, 1, 1); PG8_SCHED; PG8_LDA(At, 1, 0); PG8_STAGE(PG8_SA(0, 1), a2 + hstep, voffA);
            PG8_WAIT_V(8); PG8_WAIT_L(0); PG8_BAR; PG8_MMA(0, 0, At, B0); PG8_MMA(0, 1, At, B1); PG8_BAR; PG8_SCHED;
            PG8_LDA(At, 1, 1); PG8_STAGE(PG8_SB(1, 0), b3, voffB); PG8_STAGE(PG8_SB(1, 1), b3 + hstep, voffB); PG8_STAGE(PG8_SA(1, 0), a3, voffA);
            PG8_WAIT_V(8); PG8_WAIT_L(0); PG8_BAR; PG8_MMA(1, 0, At, B0); PG8_MMA(1, 1, At, B1); PG8_BAR; PG8_SCHED;
            } else {
            PG8_LDB(B0, 0, 0); PG8_SCHED; PG8_LDA(At, 0, 0); PG8_STAGE(PG8_SA(1, 1), a1 + hstep, voffA);
            PG8_WAIT_L(8); PG8_BAR; PG8_WAIT_L(0); PG8_MMA(0, 0, At, B0); PG8_BAR; PG8_SCHED;
            PG8_LDB(B1, 0, 1); PG8_STAGE(PG8_SB(0, 0), b2, voffB);
            PG8_BAR; PG8_WAIT_L(0); PG8_MMA(0, 1, At, B1); PG8_BAR;
            PG8_LDA(At, 0, 1); PG8_STAGE(PG8_SA(0, 0), a2, voffA);
            PG8_BAR; PG8_WAIT_L(0); PG8_MMA(1, 0, At, B0); PG8_BAR; PG8_SCHED;
            PG8_STAGE(PG8_SB(0, 1), b2 + hstep, voffB);
            PG8_WAIT_V(6); PG8_BAR; PG8_MMA(1, 1, At, B1); PG8_BAR;
            PG8_LDB(B0, 1, 0); PG8_SCHED; PG8_LDA(At, 1, 0); PG8_STAGE(PG8_SA(0, 1), a2 + hstep, voffA);
            PG8_WAIT_L(8); PG8_BAR; PG8_WAIT_L(0); PG8_MMA(0, 0, At, B0); PG8_BAR; PG8_SCHED;
            PG8_LDB(B1, 1, 1); PG8_STAGE(PG8_SB(1, 0), b3, voffB);
            PG8_BAR; PG8_WAIT_L(0); PG8_MMA(0, 1, At, B1); PG8_BAR;
            PG8_LDA(At, 1, 1); PG8_STAGE(PG8_SA(1, 0), a3, voffA);
            PG8_BAR; PG8_WAIT_L(0); PG8_MMA(1, 0, At, B0); PG8_BAR; PG8_SCHED;
            PG8_STAGE(PG8_SB(1, 1), b3 + hstep, voffB);
            PG8_WAIT_V(6); PG8_BAR; PG8_MMA(1, 1, At, B1); PG8_BAR;
            }
        }
        if constexpr (ALIGN_EPI) { if (wr == 0) PG8_BAR; }
        if constexpr (!Epi::AFTER_DRAIN) { asm volatile("s_waitcnt vmcnt(0)" ::: "memory"); E(acc, cur, wr, wc, fr, fq); asm volatile("s_waitcnt vmcnt(0)" ::: "memory"); S.done(cur); }
        if (!has_next) break;
#pragma unroll
        for (int a = 0; a < 2; ++a)
#pragma unroll
            for (int b = 0; b < 2; ++b)
#pragma unroll
                for (int m = 0; m < 4; ++m)
#pragma unroll
                    for (int n = 0; n < 2; ++n) acc[a][b][m][n] = (f32x4){0.f, 0.f, 0.f, 0.f};
        cur = nxt; cA = nA; cB = nB; ++ui;
        if constexpr (ALIGN_EPI) { if (wr == 1) PG8_BAR; }
    }
    PG8_WAIT_V(0);
    if constexpr (!ALIGN_EPI) { if (wr == 0) PG8_BAR; }
    PG8_BAR;
    if constexpr (Epi::AFTER_DRAIN) { E.fused(acc, cur, wr, wc, fr, fq, lds, wid, lane); S.done(cur); }
#undef PG8_SA
#undef PG8_SB
#undef PG8_STAGE
#undef PG8_LDA
#undef PG8_LDB
#undef PG8_MMA
#undef PG8_WAIT_V
#undef PG8_WAIT_L
#undef PG8_BAR
#undef PG8_SCHED
}
}

#define LAS __attribute__((address_space(3)))
typedef unsigned short bf16_t;
typedef short bf16x8 __attribute__((ext_vector_type(8)));
typedef float f32x4 __attribute__((ext_vector_type(4)));
typedef float f32x16 __attribute__((ext_vector_type(16)));
typedef unsigned u32x2 __attribute__((ext_vector_type(2)));
typedef unsigned u32x4 __attribute__((ext_vector_type(4)));
typedef short s16x4 __attribute__((ext_vector_type(4)));

constexpr int T_ = 32768, MS_ = 256, M_ = 33024, D_ = 1024, S_ = 8192, FF_ = 4096;
constexpr float EPS_ = 1e-6f;
constexpr float LOG2E = 1.4426950408889634f;
constexpr int LDS_BYTES = 147456;

constexpr size_t O_Y = 0, O_YS = 33554432, O_AKP = 33816576, O_AVP = O_AKP + 33554432, O_BKP = O_AVP + 33554432, O_BVP = O_BKP + 16777216,
                 O_CKP = O_BVP + 16777216, O_CVP = O_CKP + 1048576, O_MKP = O_CVP + 1048576, O_MVP = O_MKP + 524288, O_AKS = O_MVP + 524288,
                 O_AVS = O_AKS + 262144, O_BKS = O_AVS + 262144, O_BVS = O_BKS + 131072, O_CKS = O_BVS + 131072, O_CVS = O_CKS + 2097152, O_END = O_CVS + 2097152;

constexpr size_t MiB = 1048576;
constexpr size_t WS_SS = 464 * MiB;
constexpr size_t SS_STRIDE = (size_t)M_ * 16;
constexpr size_t WS_SSMEM = 484 * MiB;
constexpr size_t WS_MEMB = 2 * MiB;
constexpr size_t WS_MKB = 4 * MiB, WS_MVB = 5 * MiB;
constexpr size_t WS_W = 8 * MiB;
constexpr size_t W_LAYER = 34603008;
constexpr size_t W_GU1 = 0, W_D1 = 8388608, W_IN = 12582912, W_BRA = 18874368, W_BRB = 19398656, W_BRC = 19660800, W_OUT = 19922944,
                 W_Q = 20971520, W_KV = 21233664, W_O = 21757952, W_GU2 = 22020096, W_D2 = 30408704;
constexpr size_t WS_XB = 140 * MiB;
constexpr size_t WS_R = 205 * MiB;
constexpr size_t R_QA = 0, R_QB = 33816576, R_QC = 50724864, R_KA = 67633152, R_VA = 101449728, R_KB = 135266304, R_VB = 152174592,
                 R_KC = 169082880, R_VC = 185991168, R_G = 67633152, R_GPLANE = 67633152, R_U = 0, R_QX = 0;
constexpr size_t WS_END = 485 * MiB;
static_assert(WS_R + 270532608 <= WS_SS && WS_SS + 9 * SS_STRIDE * 4 <= WS_SSMEM, "ws map");

struct Args {
    const float* in[43];
    float* out;
    unsigned char* ws;
};

__device__ __forceinline__ float bf2f(unsigned v) { return __uint_as_float(v << 16); }
typedef float f32x2v __attribute__((ext_vector_type(2)));
typedef __bf16 bf16x2v __attribute__((ext_vector_type(2)));
__device__ __forceinline__ unsigned pk2(float lo, float hi) { const f32x2v v = {lo, hi}; const bf16x2v b = __builtin_convertvector(v, bf16x2v); return __builtin_bit_cast(unsigned, b); }
__device__ __forceinline__ float wave_sum(float v) {
#pragma unroll
    for (int o = 1; o < 64; o <<= 1) v += __shfl_xor(v, o);
    return v;
}
__device__ __forceinline__ float wave_max(float v) {
#pragma unroll
    for (int o = 1; o < 64; o <<= 1) v = fmaxf(v, __shfl_xor(v, o));
    return v;
}

__device__ __forceinline__ float row_rstd(const float* ss, int row) {
    const f32x4* q = (const f32x4*)(ss + (size_t)row * 16);
    const f32x4 a = q[0], b = q[1], c = q[2], d = q[3];
    const float s = ((a[0] + a[1]) + (a[2] + a[3])) + ((b[0] + b[1]) + (b[2] + b[3])) + ((c[0] + c[1]) + (c[2] + c[3])) + ((d[0] + d[1]) + (d[2] + d[3]));
    return rsqrtf(s * (1.f / 1024.f) + EPS_);
}
struct EpiSwiglu {
    static constexpr bool PERM = false, AFTER_DRAIN = false;
    const float* ss; bf16_t* U;
    __device__ __forceinline__ void operator()(const pg8::f32x4 (&acc)[2][2][4][2], const pg8::Unit& u, int wr, int wc, int fr, int fq) const {
        const int row0 = u.pm * 256 + wr * 64 + fr;
        const int f0 = u.pn * 128 + wc * 32 + 4 * fq;
#pragma unroll
        for (int ai = 0; ai < 2; ++ai)
#pragma unroll
            for (int m = 0; m < 4; ++m) {
                const int row = row0 + ai * 128 + m * 16;
                const float rs = row_rstd(ss, row);
#pragma unroll
                for (int n = 0; n < 2; ++n) {
                    const pg8::f32x4 g = acc[ai][0][m][n] * rs, up = acc[ai][1][m][n] * rs;
                    float o[4];
#pragma unroll
                    for (int i = 0; i < 4; ++i) o[i] = g[i] * __builtin_amdgcn_rcpf(1.f + __expf(-g[i])) * up[i];
                    u32x2 w; w.x = pk2(o[0], o[1]); w.y = pk2(o[2], o[3]);
                    *(u32x2*)(U + (size_t)row * 4096 + f0 + 16 * n) = w;
                }
                asm volatile("" ::: "memory");
            }
    }
};

struct EpiRes {
    static constexpr bool PERM = false, AFTER_DRAIN = false;
    const float* base_p; const float* base_s; float* out; bf16_t* xb; float* ssn; float scale;
    __device__ __forceinline__ void operator()(const pg8::f32x4 (&acc)[2][2][4][2], const pg8::Unit& u, int wr, int wc, int fr, int fq) const {
        const float* base = (u.pm < 128) ? base_p : base_s;
        const int row0 = u.pm * 256 + wr * 64 + fr;
        const int col0 = u.pn * 256 + wc * 64 + 4 * fq;
#pragma unroll
        for (int ai = 0; ai < 2; ++ai)
#pragma unroll
            for (int m = 0; m < 4; ++m) {
                const int row = row0 + ai * 128 + m * 16;
                float sq = 0.f;
#pragma unroll
                for (int bj = 0; bj < 2; ++bj)
#pragma unroll
                    for (int n = 0; n < 2; ++n) {
                        const size_t off = (size_t)row * 1024 + col0 + 32 * bj + 16 * n;
                        const pg8::f32x4 bv = *(const pg8::f32x4*)(base + off);
                        const pg8::f32x4 v = bv + acc[ai][bj][m][n] * scale;
                        *(pg8::f32x4*)(out + off) = v;
                        sq += (v[0] * v[0] + v[1] * v[1]) + (v[2] * v[2] + v[3] * v[3]);
                        u32x2 w; w.x = pk2(v[0], v[1]); w.y = pk2(v[2], v[3]);
                        *(u32x2*)(xb + off) = w;
                    }
                sq += __shfl_xor(sq, 16); sq += __shfl_xor(sq, 32);
                if (fq == 0) ssn[(size_t)row * 16 + u.pn * 4 + wc] = sq;
                asm volatile("" ::: "memory");
            }
    }
};

struct ColDesc {
    const float* gain;
    int sig;
    bf16_t* db; int ldb, cb;
    float* df_p; float* df_s; int ldf, cf, mode;
};

template <class DescFn> struct EpiGen {
    static constexpr bool PERM = false, AFTER_DRAIN = false;
    const float* ss; DescFn fn;
    __device__ __forceinline__ void operator()(const pg8::f32x4 (&acc)[2][2][4][2], const pg8::Unit& u, int wr, int wc, int fr, int fq) const {
        const ColDesc d = fn(u.pn);
        const int row0 = u.pm * 256 + wr * 64 + fr;
        const int lc0 = wc * 64 + 4 * fq;
        pg8::f32x4 gn[2][2];
        if (d.gain) {
#pragma unroll
            for (int bj = 0; bj < 2; ++bj)
#pragma unroll
                for (int n = 0; n < 2; ++n) gn[bj][n] = *(const pg8::f32x4*)(d.gain + 4 * fq + 32 * bj + 16 * n);
        }
        const bool samp = (u.pm >= 128);
#pragma unroll
        for (int ai = 0; ai < 2; ++ai)
#pragma unroll
            for (int m = 0; m < 4; ++m) {
                const int row = row0 + ai * 128 + m * 16;
                const float rs = row_rstd(ss, row);
                pg8::f32x4 v[2][2];
                float sq = 0.f;
#pragma unroll
                for (int bj = 0; bj < 2; ++bj)
#pragma unroll
                    for (int n = 0; n < 2; ++n) { v[bj][n] = acc[ai][bj][m][n] * rs; const pg8::f32x4 t = v[bj][n]; sq += (t[0] * t[0] + t[1] * t[1]) + (t[2] * t[2] + t[3] * t[3]); }
                if (d.gain) {
                    sq += __shfl_xor(sq, 16); sq += __shfl_xor(sq, 32);
                    const float hn = rsqrtf(sq * (1.f / 64.f) + EPS_);
#pragma unroll
                    for (int bj = 0; bj < 2; ++bj)
#pragma unroll
                        for (int n = 0; n < 2; ++n) v[bj][n] = v[bj][n] * hn * gn[bj][n];
                }
                if (d.sig) {
#pragma unroll
                    for (int bj = 0; bj < 2; ++bj)
#pragma unroll
                        for (int n = 0; n < 2; ++n)
#pragma unroll
                            for (int i = 0; i < 4; ++i) v[bj][n][i] = __builtin_amdgcn_rcpf(1.f + __expf(-v[bj][n][i]));
                }
                {
                    bf16_t* p = d.db + (size_t)row * d.ldb + d.cb + lc0;
#pragma unroll
                    for (int bj = 0; bj < 2; ++bj)
#pragma unroll
                        for (int n = 0; n < 2; ++n) { u32x2 w; w.x = pk2(v[bj][n][0], v[bj][n][1]); w.y = pk2(v[bj][n][2], v[bj][n][3]); *(u32x2*)(p + 32 * bj + 16 * n) = w; }
                }
                if (d.df_p) {
                    float* p = nullptr;
                    if (!samp) {
                        if (d.mode == 0) p = d.df_p + (size_t)row * d.ldf;
                        else { const int s = row & (S_ - 1), b = row >> 13; if (s >= S_ - 512) p = d.df_p + (size_t)(b * 512 + s - (S_ - 512)) * d.ldf; }
                    } else {
                        const int r2 = row - T_;
                        if (d.mode == 0) p = d.df_s + (size_t)r2 * d.ldf;
                        else p = d.df_s + (size_t)((r2 >> 5) * 512 + 480 + (r2 & 31)) * d.ldf;
                    }
                    if (p) {
                        p += d.cf + lc0;
#pragma unroll
                        for (int bj = 0; bj < 2; ++bj)
#pragma unroll
                            for (int n = 0; n < 2; ++n) *(pg8::f32x4*)(p + 32 * bj + 16 * n) = v[bj][n];
                    }
                }
                asm volatile("" ::: "memory");
            }
    }
};

struct EpiMerge {
    static constexpr bool PERM = false, AFTER_DRAIN = false;
    const bf16_t* gate; bf16_t* merged; int first;
    __device__ __forceinline__ void operator()(const pg8::f32x4 (&acc)[2][2][4][2], const pg8::Unit& u, int wr, int wc, int fr, int fq) const {
        const int row0 = u.pm * 256 + wr * 64 + fr;
        const int col0 = u.pn * 256 + wc * 64 + 4 * fq;
#pragma unroll
        for (int ai = 0; ai < 2; ++ai)
#pragma unroll
            for (int m = 0; m < 4; ++m) {
                const int row = row0 + ai * 128 + m * 16;
#pragma unroll
                for (int bj = 0; bj < 2; ++bj)
#pragma unroll
                    for (int n = 0; n < 2; ++n) {
                        const size_t off = (size_t)row * 1024 + col0 + 32 * bj + 16 * n;
                        const u32x2 g = *(const u32x2*)(gate + off);
                        float o0 = bf2f(g.x & 0xffffu) * acc[ai][bj][m][n][0], o1 = bf2f(g.x >> 16) * acc[ai][bj][m][n][1];
                        float o2 = bf2f(g.y & 0xffffu) * acc[ai][bj][m][n][2], o3 = bf2f(g.y >> 16) * acc[ai][bj][m][n][3];
                        if (!first) { const u32x2 mo = *(const u32x2*)(merged + off); o0 += bf2f(mo.x & 0xffffu); o1 += bf2f(mo.x >> 16); o2 += bf2f(mo.y & 0xffffu); o3 += bf2f(mo.y >> 16); }
                        u32x2 w; w.x = pk2(o0, o1); w.y = pk2(o2, o3);
                        *(u32x2*)(merged + off) = w;
                    }
                asm volatile("" ::: "memory");
            }
    }
};

__device__ __forceinline__ void p0_transpose_item(const float* W, int ldw, int srccol, const float* gain, bf16_t* dst, int K, int k0, LAS float* scr, int lane) {
#pragma unroll 8
    for (int i = 0; i < 32; ++i) {
        const int kk = 2 * i + (lane >> 5);
        float v = W[(size_t)(k0 + kk) * ldw + srccol + (lane & 31)];
        if (gain) v *= gain[k0 + kk];
        scr[kk * 33 + (lane & 31)] = v;
    }
    asm volatile("s_waitcnt lgkmcnt(0)" ::: "memory");
    const int c = lane & 7;
#pragma unroll
    for (int j = 0; j < 4; ++j) {
        const int n = (lane >> 3) + 8 * j; const LAS float* s = scr + (8 * c) * 33 + n;
        u32x4 o; o.x = pk2(s[0 * 33], s[1 * 33]); o.y = pk2(s[2 * 33], s[3 * 33]); o.z = pk2(s[4 * 33], s[5 * 33]); o.w = pk2(s[6 * 33], s[7 * 33]);
        *(u32x4*)(dst + (size_t)n * K + k0 + 8 * c) = o;
    }
    asm volatile("s_waitcnt lgkmcnt(0)" ::: "memory");
}
__device__ __forceinline__ void p0_convert(const float* W, const float* W2, const float* gain, bf16_t* dst, int K, int N, int ldw, int kind, LAS float* scr, int gw, int ngw, int lane) {
    const int nblk = N / 32, nitems = (K / 64) * nblk;
    for (int it = gw; it < nitems; it += ngw) {
        const int kb = it / nblk, db = it % nblk;
        const int pn = db >> 3, pb = db & 7, bj = pb >> 2, wc = pb & 3;
        const float* src = W; int sc;
        if (kind == 0) sc = 256 * pn + 64 * wc + 32 * bj; else { sc = 128 * pn + 32 * wc; if (bj) src = W2; }
        p0_transpose_item(src, ldw, sc, gain, dst + (size_t)(32 * db) * K, K, 64 * kb, scr, lane);
    }
}
__device__ __forceinline__ void row_to_bf16(const float* xrow, bf16_t* orow, float* ssp, int lane) {
    const f32x4* xr = (const f32x4*)xrow + lane;
    f32x4 v[4]; float s = 0.f;
#pragma unroll
    for (int j = 0; j < 4; ++j) { v[j] = xr[64 * j]; s += (v[j].x * v[j].x + v[j].y * v[j].y) + (v[j].z * v[j].z + v[j].w * v[j].w); }
    s = wave_sum(s);
    u32x2* o = (u32x2*)orow + lane;
#pragma unroll
    for (int j = 0; j < 4; ++j) { u32x2 w; w.x = pk2(v[j].x, v[j].y); w.y = pk2(v[j].z, v[j].w); o[64 * j] = w; }
    if (lane < 16) ssp[lane] = (lane == 0) ? s : 0.f;
}

constexpr int AT_KT = 0, AT_VT = 17408, AT_QW = AT_VT + 18432, AT_TAB = AT_QW + 69632, AT_FLAG = AT_TAB + 1600, AT_END = AT_FLAG + 64;
static_assert(AT_END <= 131072, "attention LDS map");
constexpr int AT_ACCO = 0, AT_ACCL = 32768, AT_STAB = 34816;

template <int NMAP, int VD, class KL, class QL, class VL, class BF>
__device__ __forceinline__ void tile_softmax(f32x16 (&O)[NMAP][VD / 32], float (&l)[NMAP], const KL& kl, const QL& ql, const VL& vl, const BF& bf) {
    constexpr float C1 = 0.125f * LOG2E;
#pragma unroll
    for (int kb = 0; kb < 2; ++kb) {
#pragma unroll
        for (int mp = 0; mp < NMAP; ++mp) {
            f32x16 S;
#pragma unroll
            for (int i = 0; i < 16; ++i) S[i] = 0.f;
#pragma unroll
            for (int s = 0; s < 4; ++s) S = __builtin_amdgcn_mfma_f32_32x32x16_bf16(kl(kb, mp, s), ql(mp, s), S, 0, 0, 0);
            float ls = 0.f; unsigned pw[8];
#pragma unroll
            for (int r2 = 0; r2 < 16; r2 += 2) {
                const float p0 = __builtin_amdgcn_exp2f(S[r2] * C1 + bf(kb, r2)), p1 = __builtin_amdgcn_exp2f(S[r2 + 1] * C1 + bf(kb, r2 + 1));
                ls += p0 + p1; pw[r2 >> 1] = pk2(p0, p1);
            }
            l[mp] += ls;
            u32x4 t0 = {pw[0], pw[1], pw[2], pw[3]}, t1 = {pw[4], pw[5], pw[6], pw[7]};
            const bf16x8 pf0 = __builtin_bit_cast(bf16x8, t0), pf1 = __builtin_bit_cast(bf16x8, t1);
            __builtin_amdgcn_sched_barrier(0);
#pragma unroll
            for (int db = 0; db < VD / 32; ++db) {
                O[mp][db] = __builtin_amdgcn_mfma_f32_32x32x16_bf16(vl(db, kb, 0), pf0, O[mp][db], 0, 0, 0);
                O[mp][db] = __builtin_amdgcn_mfma_f32_32x32x16_bf16(vl(db, kb, 1), pf1, O[mp][db], 0, 0, 0);
            }
            __builtin_amdgcn_sched_barrier(0);
        }
    }
}

template <class KL, class QL, class VL, class MK>
__device__ __forceinline__ void tile_stick(f32x16 (&O)[2], float& R, int hh, const KL& kl, const QL& ql, const VL& vl, const MK& valid) {
#pragma unroll
    for (int kb = 1; kb >= 0; --kb) {
        f32x16 S;
#pragma unroll
        for (int i = 0; i < 16; ++i) S[i] = 0.f;
#pragma unroll
        for (int s = 0; s < 4; ++s) S = __builtin_amdgcn_mfma_f32_32x32x16_bf16(kl(kb, 0, s), ql(0, s), S, 0, 0, 0);
        float sg[16], f[16];
#pragma unroll
        for (int i = 0; i < 16; ++i) {
            float z = S[i] * 0.125f; z = fminf(fmaxf(z, -60.f), 60.f);
            const float e = __builtin_amdgcn_exp2f(-z * LOG2E);
            float s_ = __builtin_amdgcn_rcpf(1.f + e), ff = e * s_;
            if (!valid(kb, i)) { s_ = 0.f; ff = 1.f; }
            sg[i] = s_; f[i] = ff;
        }
        float F[4], Fp[4], Tg[4];
#pragma unroll
        for (int g = 0; g < 4; ++g) { F[g] = (f[4 * g] * f[4 * g + 1]) * (f[4 * g + 2] * f[4 * g + 3]); Fp[g] = __shfl_xor(F[g], 32); Tg[g] = F[g] * Fp[g]; }
        float E[4]; E[3] = 1.f; E[2] = Tg[3]; E[1] = Tg[3] * Tg[2]; E[0] = E[1] * Tg[1];
        unsigned pw[8];
#pragma unroll
        for (int g = 0; g < 4; ++g) {
            float t = R * E[g] * (hh == 0 ? Fp[g] : 1.f);
            const float w3 = sg[4 * g + 3] * t; t *= f[4 * g + 3];
            const float w2 = sg[4 * g + 2] * t; t *= f[4 * g + 2];
            const float w1 = sg[4 * g + 1] * t; t *= f[4 * g + 1];
            const float w0 = sg[4 * g] * t;
            pw[2 * g] = pk2(w0, w1); pw[2 * g + 1] = pk2(w2, w3);
        }
        R *= E[0] * Tg[0];
        u32x4 t0 = {pw[0], pw[1], pw[2], pw[3]}, t1 = {pw[4], pw[5], pw[6], pw[7]};
        const bf16x8 pf0 = __builtin_bit_cast(bf16x8, t0), pf1 = __builtin_bit_cast(bf16x8, t1);
#pragma unroll
        for (int db = 0; db < 2; ++db) {
            O[db] = __builtin_amdgcn_mfma_f32_32x32x16_bf16(vl(db, kb, 0), pf0, O[db], 0, 0, 0);
            O[db] = __builtin_amdgcn_mfma_f32_32x32x16_bf16(vl(db, kb, 1), pf1, O[db], 0, 0, 0);
        }
    }
}

template <int MODE, int NMAP, int VD>
__device__ __forceinline__ void finish_store(f32x16 (&O)[NMAP][VD / 32], float (&l)[NMAP], bf16_t* orowp, int hh, float lam, const float* subln, float oscale) {
    float inv[NMAP];
    if (MODE != 3) {
#pragma unroll
        for (int mp = 0; mp < NMAP; ++mp) { l[mp] += __shfl_xor(l[mp], 32); inv[mp] = 1.f / l[mp]; }
    }
    if constexpr (MODE == 0) {
        float sq = 0.f;
#pragma unroll
        for (int db = 0; db < 4; ++db)
#pragma unroll
            for (int i = 0; i < 16; ++i) { const float o = O[0][db][i] * inv[0] - lam * (O[1][db][i] * inv[1]); O[0][db][i] = o; sq += o * o; }
        sq += __shfl_xor(sq, 32);
        const float rsn = rsqrtf(sq * (1.f / 128.f) + EPS_) * oscale;
#pragma unroll
        for (int db = 0; db < 4; ++db)
#pragma unroll
            for (int g = 0; g < 4; ++g) {
                const int d0 = 32 * db + 8 * g + 4 * hh;
                const f32x4 gn = *(const f32x4*)(subln + d0);
                u32x2 wv; wv.x = pk2(O[0][db][4 * g] * rsn * gn[0], O[0][db][4 * g + 1] * rsn * gn[1]); wv.y = pk2(O[0][db][4 * g + 2] * rsn * gn[2], O[0][db][4 * g + 3] * rsn * gn[3]);
                *(u32x2*)(orowp + d0) = wv;
            }
    } else {
        const float sc = (MODE == 3) ? 1.f : inv[0];
#pragma unroll
        for (int db = 0; db < VD / 32; ++db)
#pragma unroll
            for (int g = 0; g < 4; ++g) {
                const int d0 = 32 * db + 8 * g + 4 * hh;
                u32x2 wv; wv.x = pk2(O[0][db][4 * g] * sc, O[0][db][4 * g + 1] * sc); wv.y = pk2(O[0][db][4 * g + 2] * sc, O[0][db][4 * g + 3] * sc);
                *(u32x2*)(orowp + d0) = wv;
            }
    }
}

__device__ __forceinline__ int t5_bucket_dev(int rel) {
    const int n = rel < 0 ? -rel : rel;
    int v;
    if (n < 8) v = n; else { const int k = 31 - __clz(n * n) - 6; v = 8 + k; if (v > 15) v = 15; }
    return (rel > 0 ? 16 : 0) + v;
}
__device__ __forceinline__ float lambda_init_dev(int layer) { return 0.8f - 0.6f * expf(-0.3f * (float)layer); }

template <int MODE>
__device__ __forceinline__ float attn_setup_bias(const Args& a, int layer, int h, LAS float* tab, int tid, int lane) {
    const float* gq = MODE == 0 ? a.in[18] : (MODE == 1 ? a.in[25] : a.in[36]);
    const float* gk = MODE == 0 ? a.in[19] : (MODE == 1 ? a.in[26] : a.in[37]);
    const float mq = wave_max(fabsf(gq[layer * 64 + lane])), mk = wave_max(fabsf(gk[layer * 64 + lane]));
    float mb = 0.f;
    const float* t5 = a.in[11];
    const float* relb = a.in[27] + (size_t)(layer * 4 + h) * 257;
    if (MODE == 0) mb = wave_max(lane < 32 ? fabsf(t5[lane * 4 + h]) : 0.f);
    if (MODE == 1) { float m = 0.f; for (int i = lane; i < 257; i += 64) m = fmaxf(m, fabsf(relb[i])); mb = wave_max(m); }
    const float shift = 8.f * mq * mk + mb;
    if (MODE == 0 || MODE == 1) {
        for (int t = tid; t < 384; t += 512) {
            int rel = t - 64 - 255; if (t < 64) rel = -255; float v;
            if (MODE == 0) v = t5[t5_bucket_dev(rel) * 4 + h];
            else { int c = rel < -128 ? -128 : (rel > 128 ? 128 : rel); v = relb[c + 128]; }
            tab[t] = (v - shift) * LOG2E;
        }
    }
    if (MODE == 0) return (t5[15 * 4 + h] - shift) * LOG2E;
    if (MODE == 1) return (relb[0] - shift) * LOG2E;
    return -shift * LOG2E;
}

template <int MODE>
__device__ __forceinline__ void attn_prompt_unit(LAS unsigned char* lds, const Args& a, int layer, int bh, int qb) {
    constexpr int KD = MODE == 0 ? 128 : 64, VD = MODE == 0 ? 128 : 64, KP = KD * 2 + 16, VP2 = VD * 2 + 16, QP = 144, NKC = KD / 64, NVC = VD / 64, UROWS = MODE == 0 ? 128 : 256;
    int tid_l = threadIdx.x; asm volatile("" : "+v"(tid_l));
    const int tid = tid_l, lane = tid & 63, w = __builtin_amdgcn_readfirstlane(tid >> 6), r = lane & 31, hh = lane >> 5;
    const int qg = MODE == 0 ? (w >> 1) : w, mpw = MODE == 0 ? (w & 1) : 0;
    const int b = bh >> 2, h = bh & 3;
    unsigned char* Rg = a.ws + WS_R;
    bf16_t* Q; const bf16_t* K; const bf16_t* V; int ld; int hoff; size_t keyrow0;
    if (MODE == 0) { Q = (bf16_t*)(Rg + R_QA); K = (const bf16_t*)(Rg + R_KA); V = (const bf16_t*)(Rg + R_VA); ld = 512; hoff = h * 128; keyrow0 = (size_t)b * S_; }
    else if (MODE == 1) { Q = (bf16_t*)(Rg + R_QC); K = (const bf16_t*)(Rg + R_KC); V = (const bf16_t*)(Rg + R_VC); ld = 256; hoff = h * 64; keyrow0 = (size_t)b * S_; }
    else if (MODE == 3) { Q = (bf16_t*)(Rg + R_QB); K = (const bf16_t*)(Rg + R_KB); V = (const bf16_t*)(Rg + R_VB); ld = 256; hoff = h * 64; keyrow0 = (size_t)b * S_; }
    else { Q = (bf16_t*)(Rg + R_QX); K = (const bf16_t*)(a.ws + WS_MKB) + (size_t)layer * 262144; V = (const bf16_t*)(a.ws + WS_MVB) + (size_t)layer * 262144; ld = 256; hoff = h * 64; keyrow0 = (size_t)b * 256; }
    const int q0 = UROWS * qb + 32 * qg;
    const size_t qrow0 = (size_t)b * S_ + q0;
    const int cw = q0 >> 6;
    int jlo, jhi, wlo, whi;
    if (MODE == 0 || MODE == 3) { jlo = 0; jhi = ((UROWS * qb + UROWS - 1) >> 6); wlo = 0; whi = cw; }
    else if (MODE == 1) { const int c0 = (UROWS * qb) >> 6; wlo = cw - 8 < 0 ? 0 : cw - 8; whi = cw; jlo = c0 - 8 < 0 ? 0 : c0 - 8; jhi = c0 + 3; }
    else { jlo = 0; jhi = 3; wlo = 0; whi = 3; }

    LAS unsigned char* KT = lds + AT_KT; LAS unsigned char* VT = lds + AT_VT; LAS unsigned char* QW = lds + AT_QW + w * (32 * QP);
    LAS float* tab = (LAS float*)(lds + AT_TAB); volatile LAS int* flags = (volatile LAS int*)(lds + AT_FLAG);

    __syncthreads();
    float farc = 0.f;
    if (MODE != 3) farc = attn_setup_bias<MODE>(a, layer, h, tab, tid, lane);
    if (MODE == 3 && tid < 8) flags[tid] = 0;
#pragma unroll
    for (int i = 0; i < 4; ++i) {
        const int c = lane + 64 * i, row = c >> 3, part = c & 7;
        const u32x4 v = *(const u32x4*)(Q + (qrow0 + row) * ld + hoff + mpw * 64 + part * 8);
        *(LAS u32x4*)(QW + row * QP + part * 16) = v;
    }
    float lam = 0.f;
    if (MODE == 0) {
        const float s1 = wave_sum(a.in[20][layer * 64 + lane] * a.in[21][layer * 64 + lane]);
        const float s2 = wave_sum(a.in[22][layer * 64 + lane] * a.in[23][layer * 64 + lane]);
        lam = expf(s1) - expf(s2) + lambda_init_dev(layer);
    }

    f32x16 O[1][VD / 32]; float l[1] = {0.f};
#pragma unroll
    for (int db = 0; db < VD / 32; ++db)
#pragma unroll
        for (int i = 0; i < 16; ++i) O[0][db][i] = 0.f;
    float Rp = 1.f; bool done = false;

    u32x4 kreg[NKC], vreg[NVC];
    auto prefetch = [&](int j) {
#pragma unroll
        for (int i = 0; i < NKC; ++i) { const int c = tid + 512 * i, key = c / (KD / 8), part = c % (KD / 8);
            kreg[i] = *(const u32x4*)(K + (keyrow0 + 64 * j + key) * ld + hoff + part * 8); }
#pragma unroll
        for (int i = 0; i < NVC; ++i) { const int c = tid + 512 * i, key = c / (VD / 8), part = c % (VD / 8);
            vreg[i] = *(const u32x4*)(V + (keyrow0 + 64 * j + key) * ld + hoff + part * 8); }
    };
    auto stage = [&]() {
#pragma unroll
        for (int i = 0; i < NKC; ++i) { const int c = tid + 512 * i, key = c / (KD / 8), part = c % (KD / 8);
            *(LAS u32x4*)(KT + key * KP + part * 16) = kreg[i]; }
#pragma unroll
        for (int i = 0; i < NVC; ++i) { const int c = tid + 512 * i, key = c / (VD / 8), part = c % (VD / 8);
            *(LAS u32x4*)(VT + key * VP2 + part * 16) = vreg[i]; }
    };
    auto kl = [&](int kb, int, int s) -> bf16x8 { return *(const LAS bf16x8*)(KT + (32 * kb + r) * KP + mpw * 128 + (16 * s + 8 * hh) * 2); };
    auto ql = [&](int, int s) -> bf16x8 { return *(const LAS bf16x8*)(QW + r * QP + (16 * s + 8 * hh) * 2); };
    auto vl = [&](int db, int kb, int s2) -> bf16x8 {
        const LAS unsigned char* p = VT + (32 * kb + 16 * s2 + 4 * hh + ((lane & 15) >> 2)) * VP2 + (32 * db + 16 * ((lane >> 4) & 1) + 4 * (lane & 3)) * 2;
        const s16x4 lo = __builtin_amdgcn_ds_read_tr16_b64_v4i16((LAS s16x4*)p), hi = __builtin_amdgcn_ds_read_tr16_b64_v4i16((LAS s16x4*)(p + 8 * VP2));
        bf16x8 t = {lo[0], lo[1], lo[2], lo[3], hi[0], hi[1], hi[2], hi[3]}; return t; };

    if constexpr (MODE != 3) {
        prefetch(jlo);
        for (int j = jlo; j <= jhi; ++j) {
            __syncthreads();
            stage();
            __syncthreads();
            if (j < jhi) prefetch(j + 1);
            if (j >= wlo && j <= whi) {
                const int maxrel = 64 * j + 63 - q0;
                const int bidx = (maxrel <= -128) ? 0 : 64 + 64 * j + 4 * hh - q0 - r + 255;
                auto bf = [&](int kb, int i) -> float { if (MODE == 2) return farc; return tab[bidx + 32 * kb + (i & 3) + 8 * (i >> 2)]; };
                tile_softmax<1, VD>(O, l, kl, ql, vl, bf);
            }
        }
    } else {
        prefetch(jhi);
        for (int j = jhi; j >= 0; --j) {
            __syncthreads();
            { int alld = 1;
#pragma unroll
              for (int i = 0; i < 8; ++i) alld &= flags[i];
              if (alld) break; }
            stage();
            __syncthreads();
            if (j > 0) prefetch(j - 1);
            if (j <= whi && !done) {
                if (j == whi) {
                    const int kbase = 64 * j + 4 * hh, qpos = q0 + r;
                    auto valid = [&](int kb, int i) -> bool { return (kbase + 32 * kb + (i & 3) + 8 * (i >> 2)) < qpos; };
                    tile_stick(O[0], Rp, hh, kl, ql, vl, valid);
                } else {
                    auto valid = [&](int, int) -> bool { return true; };
                    tile_stick(O[0], Rp, hh, kl, ql, vl, valid);
                }
                done = (__ballot(Rp != 0.f) == 0ull) || (j == 0);
                if (lane == 0 && done) flags[w] = 1;
            }
        }
    }
    bf16_t* orowp = Q + (qrow0 + r) * ld + hoff;
    if constexpr (MODE == 0) {
        l[0] += __shfl_xor(l[0], 32);
        const float inv = 1.f / l[0];
        LAS float* ex = (LAS float*)lds + qg * (4 * 16 * 64);
        __syncthreads();
        if (mpw == 1) {
            const float sc = inv * lam;
#pragma unroll
            for (int db = 0; db < 4; ++db)
#pragma unroll
                for (int i = 0; i < 16; ++i) ex[(db * 16 + i) * 64 + lane] = O[0][db][i] * sc;
        }
        __syncthreads();
        if (mpw == 0) {
            float sq = 0.f;
#pragma unroll
            for (int db = 0; db < 4; ++db)
#pragma unroll
                for (int i = 0; i < 16; ++i) { const float o = O[0][db][i] * inv - ex[(db * 16 + i) * 64 + lane]; O[0][db][i] = o; sq += o * o; }
            sq += __shfl_xor(sq, 32);
            const float rsn = rsqrtf(sq * (1.f / 128.f) + EPS_) * (1.f - lambda_init_dev(layer));
            const float* subln = a.in[24] + layer * 128;
#pragma unroll
            for (int db = 0; db < 4; ++db)
#pragma unroll
                for (int g = 0; g < 4; ++g) {
                    const int d0 = 32 * db + 8 * g + 4 * hh;
                    const f32x4 gn = *(const f32x4*)(subln + d0);
                    u32x2 wv; wv.x = pk2(O[0][db][4 * g] * rsn * gn[0], O[0][db][4 * g + 1] * rsn * gn[1]); wv.y = pk2(O[0][db][4 * g + 2] * rsn * gn[2], O[0][db][4 * g + 3] * rsn * gn[3]);
                    *(u32x2*)(orowp + d0) = wv;
                }
        }
    } else {
        finish_store<MODE, 1, VD>(O, l, orowp, hh, lam, nullptr, 1.f);
    }
}

template <int MODE>
__device__ __forceinline__ void attn_sample_unit(LAS unsigned char* lds, const Args& a, int layer, int b, int h) {
    constexpr int NMAP = MODE == 0 ? 2 : 1, KD = 64 * NMAP, VD = MODE == 0 ? 128 : 64;
    int tid_l = threadIdx.x; asm volatile("" : "+v"(tid_l));
    const int tid = tid_l, lane = tid & 63, w = __builtin_amdgcn_readfirstlane(tid >> 6), r = lane & 31, hh = lane >> 5;
    const float *kc, *kn, *vc, *vn; int ldk, ncache, nkeys, kpos0; const bf16_t* Q; int ldq;
    const size_t lb = (size_t)(layer * 8 + b);
    if (MODE == 0) { kc = a.in[3] + lb * 1024 * 512 + h * 128; vc = a.in[4] + lb * 1024 * 512 + h * 128; kn = a.out + O_AKS + lb * 32 * 512 + h * 128; vn = a.out + O_AVS + lb * 32 * 512 + h * 128;
        ldk = 512; ncache = 1024; nkeys = 1056; kpos0 = 0; Q = (const bf16_t*)(a.ws + WS_R + R_QA); ldq = 512; }
    else if (MODE == 1) { kc = a.in[7] + lb * 512 * 256 + h * 64; vc = a.in[8] + lb * 512 * 256 + h * 64; kn = a.out + O_CKS + (lb * 512 + 480) * 256 + h * 64; vn = a.out + O_CVS + (lb * 512 + 480) * 256 + h * 64;
        ldk = 256; ncache = 512; nkeys = 544; kpos0 = 512; Q = (const bf16_t*)(a.ws + WS_R + R_QC); ldq = 256; }
    else { kc = a.in[9] + lb * 256 * 256 + h * 64; vc = a.in[10] + lb * 256 * 256 + h * 64; kn = kc; vn = vc; ldk = 256; ncache = 256; nkeys = 256; kpos0 = 0; Q = (const bf16_t*)(a.ws + WS_R + R_QX); ldq = 256; }
    const size_t qrow = (size_t)T_ + b * 32 + r;
    LAS float* accO = (LAS float*)(lds + AT_ACCO); LAS float* accL = (LAS float*)(lds + AT_ACCL); LAS float* tab = (LAS float*)(lds + AT_STAB);
    __syncthreads();
    for (int i = tid; i < NMAP * (VD / 32) * 16 * 64; i += 512) accO[i] = 0.f;
    if (tid < NMAP * 64) accL[tid] = 0.f;
    const float farc = attn_setup_bias<MODE>(a, layer, h, tab, tid, lane);
    float lam = 0.f;
    if (MODE == 0) {
        const float s1 = wave_sum(a.in[20][layer * 64 + lane] * a.in[21][layer * 64 + lane]);
        const float s2 = wave_sum(a.in[22][layer * 64 + lane] * a.in[23][layer * 64 + lane]);
        lam = expf(s1) - expf(s2) + lambda_init_dev(layer);
    }
    const bf16_t* qptr = Q + qrow * ldq + h * KD + 8 * hh;
    __syncthreads();
    f32x16 Ow[1][VD / 32]; float lw[1] = {0.f};
#pragma unroll
    for (int db = 0; db < VD / 32; ++db)
#pragma unroll
        for (int i = 0; i < 16; ++i) Ow[0][db][i] = 0.f;
    const int ntiles = (nkeys + 63) / 64;
    const int mpw = (NMAP == 2) ? (w >> 2) : 0, jstep = (NMAP == 2) ? 4 : 8, jstart = (NMAP == 2) ? (w & 3) : w;
    for (int j = jstart; j < ntiles; j += jstep) {
        asm volatile("" ::: "memory");
        auto krow = [&](int p) -> const float* { p = p < nkeys ? p : nkeys - 1; return p < ncache ? kc + (size_t)p * ldk : kn + (size_t)(p - ncache) * ldk; };
        auto vrow = [&](int p) -> const float* { p = p < nkeys ? p : nkeys - 1; return p < ncache ? vc + (size_t)p * ldk : vn + (size_t)(p - ncache) * ldk; };
        auto kl = [&](int kb, int, int s) -> bf16x8 {
            const float* p = krow(64 * j + 32 * kb + r) + mpw * 64 + 16 * s + 8 * hh;
            const f32x4 x = *(const f32x4*)p, y = *(const f32x4*)(p + 4);
            u32x4 t = {pk2(x[0], x[1]), pk2(x[2], x[3]), pk2(y[0], y[1]), pk2(y[2], y[3])}; return __builtin_bit_cast(bf16x8, t); };
        auto ql = [&](int, int s) -> bf16x8 { return *(const bf16x8*)(qptr + mpw * 64 + 16 * s); };
        auto vl = [&](int db, int kb, int s2) -> bf16x8 {
            float x[8];
#pragma unroll
            for (int jx = 0; jx < 8; ++jx) x[jx] = vrow(64 * j + 32 * kb + 16 * s2 + 8 * (jx >> 2) + 4 * hh + (jx & 3))[32 * db + r];
            u32x4 t = {pk2(x[0], x[1]), pk2(x[2], x[3]), pk2(x[4], x[5]), pk2(x[6], x[7])}; return __builtin_bit_cast(bf16x8, t); };
        const int pbase = 64 * j + 4 * hh;
        const int maxrel = kpos0 + 64 * j + 63 - 1024;
        const int bidx = (maxrel <= -128) ? 0 : 64 + kpos0 + pbase - 1024 - r + 255;
        auto bf = [&](int kb, int i) -> float { const int o = 32 * kb + (i & 3) + 8 * (i >> 2); const float t = (MODE == 2) ? farc : tab[bidx + o]; return (pbase + o) < nkeys ? t : -INFINITY; };
        tile_softmax<1, VD>(Ow, lw, kl, ql, vl, bf);
    }
#pragma unroll
    for (int db = 0; db < VD / 32; ++db)
#pragma unroll
        for (int i = 0; i < 16; ++i) atomicAdd((float*)&accO[((mpw * (VD / 32) + db) * 16 + i) * 64 + lane], Ow[0][db][i]);
    atomicAdd((float*)&accL[mpw * 64 + lane], lw[0]);
    __syncthreads();
    if (w == 0) {
        f32x16 O[NMAP][VD / 32]; float l[NMAP];
#pragma unroll
        for (int mp = 0; mp < NMAP; ++mp) {
#pragma unroll
            for (int db = 0; db < VD / 32; ++db)
#pragma unroll
                for (int i = 0; i < 16; ++i) O[mp][db][i] = accO[((mp * (VD / 32) + db) * 16 + i) * 64 + lane];
            l[mp] = accL[mp * 64 + lane];
        }
        bf16_t* orowp = (bf16_t*)Q + qrow * ldq + h * (MODE == 0 ? 128 : 64);
        finish_store<MODE, NMAP, VD>(O, l, orowp, hh, lam, a.in[24] + layer * 128, 1.f - lambda_init_dev(layer));
    }
}

__device__ __forceinline__ void attn_stick_sample(const Args& a, int layer, int unit) {
    int tid_l = threadIdx.x; asm volatile("" : "+v"(tid_l));
    const int lane = tid_l & 63, r = lane & 31, hh = lane >> 5;
    const int b = unit >> 2, h = unit & 3;
    const size_t lb = (size_t)(layer * 8 + b);
    const float* kc = a.in[5] + lb * 1024 * 256 + h * 64; const float* vc = a.in[6] + lb * 1024 * 256 + h * 64;
    const float* kn = a.out + O_BKS + lb * 32 * 256 + h * 64; const float* vn = a.out + O_BVS + lb * 32 * 256 + h * 64;
    constexpr int ldk = 256, ncache = 1024, nkeys = 1056;
    bf16_t* Q = (bf16_t*)(a.ws + WS_R + R_QB);
    const size_t qrow = (size_t)T_ + b * 32 + r;
    bf16x8 qf[4];
#pragma unroll
    for (int s = 0; s < 4; ++s) qf[s] = *(const bf16x8*)(Q + qrow * 256 + h * 64 + 16 * s + 8 * hh);
    f32x16 O[1][2];
#pragma unroll
    for (int db = 0; db < 2; ++db)
#pragma unroll
        for (int i = 0; i < 16; ++i) O[0][db][i] = 0.f;
    float Rp = 1.f;
    for (int j = 16; j >= 0; --j) {
        auto krow = [&](int p) -> const float* { p = p < nkeys ? p : nkeys - 1; return p < ncache ? kc + (size_t)p * ldk : kn + (size_t)(p - ncache) * ldk; };
        auto vrow = [&](int p) -> const float* { p = p < nkeys ? p : nkeys - 1; return p < ncache ? vc + (size_t)p * ldk : vn + (size_t)(p - ncache) * ldk; };
        auto kl = [&](int kb, int, int s) -> bf16x8 {
            const float* p = krow(64 * j + 32 * kb + r) + 16 * s + 8 * hh;
            const f32x4 x = *(const f32x4*)p, y = *(const f32x4*)(p + 4);
            u32x4 t = {pk2(x[0], x[1]), pk2(x[2], x[3]), pk2(y[0], y[1]), pk2(y[2], y[3])}; return __builtin_bit_cast(bf16x8, t); };
        auto ql = [&](int, int s) -> bf16x8 { return qf[s]; };
        auto vl = [&](int db, int kb, int s2) -> bf16x8 {
            float x[8];
#pragma unroll
            for (int jx = 0; jx < 8; ++jx) x[jx] = vrow(64 * j + 32 * kb + 16 * s2 + 8 * (jx >> 2) + 4 * hh + (jx & 3))[32 * db + r];
            u32x4 t = {pk2(x[0], x[1]), pk2(x[2], x[3]), pk2(x[4], x[5]), pk2(x[6], x[7])}; return __builtin_bit_cast(bf16x8, t); };
        const int pbase = 64 * j + 4 * hh, qpos = 1024 + r;
        auto valid = [&](int kb, int i) -> bool { const int p = pbase + 32 * kb + (i & 3) + 8 * (i >> 2); return p < nkeys && p < qpos; };
        tile_stick(O[0], Rp, hh, kl, ql, vl, valid);
        if (__ballot(Rp != 0.f) == 0ull) break;
    }
    float l[1] = {1.f};
    finish_store<3, 1, 64>(O, l, Q + qrow * 256 + h * 64, hh, 0.f, nullptr, 1.f);
}

#ifndef SKIP_ATTN
#define SKIP_ATTN 0
#endif
#ifndef SKIP_MERGE
#define SKIP_MERGE 0
#endif
#ifndef SKIP_GATE
#define SKIP_GATE 0
#endif
#ifndef P7_PLANE
#define P7_PLANE 0
#endif
#ifndef GATE_SIG
#define GATE_SIG 1
#endif
#ifndef STOP_AFTER
#define STOP_AFTER 99
#endif

struct DescQKV {
    unsigned char* R; float* out; const float* aqn; const float* akn; const float* cqn; const float* ckn; int layer;
    __device__ __forceinline__ ColDesc operator()(int pn) const {
        ColDesc d; d.gain = nullptr; d.sig = 0; d.db = nullptr; d.ldb = 256; d.cb = 0; d.df_p = nullptr; d.df_s = nullptr; d.ldf = 256; d.cf = 0; d.mode = 0;
        const size_t L = (size_t)layer;
        if (pn < 2) { d.gain = aqn; d.db = (bf16_t*)(R + R_QA); d.ldb = 512; d.cb = pn * 256; }
        else if (pn < 4) { d.gain = akn; d.db = (bf16_t*)(R + R_KA); d.ldb = 512; d.cb = (pn - 2) * 256; d.df_p = out + O_AKP + L * T_ * 512; d.df_s = out + O_AKS + L * MS_ * 512; d.ldf = 512; d.cf = (pn - 2) * 256; }
        else if (pn < 6) { d.db = (bf16_t*)(R + R_VA); d.ldb = 512; d.cb = (pn - 4) * 256; d.df_p = out + O_AVP + L * T_ * 512; d.df_s = out + O_AVS + L * MS_ * 512; d.ldf = 512; d.cf = (pn - 4) * 256; }
        else if (pn == 6) { d.db = (bf16_t*)(R + R_QB); }
        else if (pn == 7) { d.db = (bf16_t*)(R + R_KB); d.df_p = out + O_BKP + L * T_ * 256; d.df_s = out + O_BKS + L * MS_ * 256; }
        else if (pn == 8) { d.db = (bf16_t*)(R + R_VB); d.df_p = out + O_BVP + L * T_ * 256; d.df_s = out + O_BVS + L * MS_ * 256; }
        else if (pn == 9) { d.gain = cqn; d.db = (bf16_t*)(R + R_QC); }
        else if (pn == 10) { d.gain = ckn; d.db = (bf16_t*)(R + R_KC); d.df_p = out + O_CKP + L * 4 * 512 * 256; d.df_s = out + O_CKS + L * 8 * 512 * 256; d.mode = 1; }
        else { d.db = (bf16_t*)(R + R_VC); d.df_p = out + O_CVP + L * 4 * 512 * 256; d.df_s = out + O_CVS + L * 8 * 512 * 256; d.mode = 1; }
        return d;
    }
};
struct DescGate {
    unsigned char* R;
    __device__ __forceinline__ ColDesc operator()(int pn) const {
        ColDesc d; d.gain = nullptr; d.sig = GATE_SIG; d.db = (bf16_t*)(R + R_G + (size_t)(pn >> 2) * R_GPLANE); d.ldb = 1024; d.cb = (pn & 3) * 256; d.df_p = nullptr; d.df_s = nullptr; d.ldf = 0; d.cf = 0; d.mode = 0;
        return d;
    }
};
struct DescWq {
    unsigned char* R; const float* qn;
    __device__ __forceinline__ ColDesc operator()(int) const {
        ColDesc d; d.gain = qn; d.sig = 0; d.db = (bf16_t*)(R + R_QX); d.ldb = 256; d.cb = 0; d.df_p = nullptr; d.df_s = nullptr; d.ldf = 0; d.cf = 0; d.mode = 0;
        return d;
    }
};
struct DescMemKV {
    unsigned char* ws; float* out; const float* kn; int layer;
    __device__ __forceinline__ ColDesc operator()(int pn) const {
        ColDesc d; d.sig = 0; d.ldb = 256; d.cb = 0; d.ldf = 256; d.cf = 0; d.mode = 0; d.df_s = nullptr;
        if (pn == 0) { d.gain = kn; d.db = (bf16_t*)(ws + WS_MKB) + (size_t)layer * 262144; d.df_p = out + O_MKP + (size_t)layer * 262144; }
        else { d.gain = nullptr; d.db = (bf16_t*)(ws + WS_MVB) + (size_t)layer * 262144; d.df_p = out + O_MVP + (size_t)layer * 262144; }
        return d;
    }
};

__global__ void __launch_bounds__(512, 2) mega(Args a) {
    extern __shared__ __attribute__((aligned(16))) unsigned char lds_raw[];
    cg::grid_group grid = cg::this_grid();
#define GSYNC() do { asm volatile("s_waitcnt vmcnt(0) lgkmcnt(0)" ::: "memory"); __builtin_amdgcn_fence(__ATOMIC_RELEASE, ""); grid.sync(); \
                     __builtin_amdgcn_fence(__ATOMIC_ACQUIRE, ""); asm volatile("s_waitcnt vmcnt(0)" ::: "memory"); } while (0)
    LAS unsigned char* L = (LAS unsigned char*)lds_raw;
    const int tid = threadIdx.x, lane = tid & 63, wave = __builtin_amdgcn_readfirstlane(tid >> 6);
    const int G = gridDim.x, bx = blockIdx.x;
    unsigned char* ws = a.ws;
    float* ssb = (float*)(ws + WS_SS);
    float* ssmem = (float*)(ws + WS_SSMEM);
    bf16_t* Wb = (bf16_t*)(ws + WS_W);
    bf16_t* XB = (bf16_t*)(ws + WS_XB);
    bf16_t* MEMB = (bf16_t*)(ws + WS_MEMB);
    unsigned char* R = ws + WS_R;
    float* out = a.out;

    {
        const int gw = bx * 8 + wave, ngw = G * 8;
        LAS float* scr = (LAS float*)(L + wave * 16384);
        for (int l = 0; l < 2; ++l) {
            bf16_t* Wl = Wb + (size_t)l * W_LAYER;
            p0_convert(a.in[13] + (size_t)l * 4194304, a.in[14] + (size_t)l * 4194304, a.in[12] + l * 1024, Wl + W_GU1, 1024, 8192, 4096, 1, scr, gw, ngw, lane);
            p0_convert(a.in[15] + (size_t)l * 4194304, nullptr, nullptr, Wl + W_D1, 4096, 1024, 1024, 0, scr, gw, ngw, lane);
            p0_convert(a.in[17] + (size_t)l * 6291456, nullptr, a.in[16] + l * 1024, Wl + W_IN, 1024, 6144, 6144, 0, scr, gw, ngw, lane);
            p0_convert(a.in[28] + (size_t)l * 524288, nullptr, nullptr, Wl + W_BRA, 512, 1024, 1024, 0, scr, gw, ngw, lane);
            p0_convert(a.in[29] + (size_t)l * 262144, nullptr, nullptr, Wl + W_BRB, 256, 1024, 1024, 0, scr, gw, ngw, lane);
            p0_convert(a.in[30] + (size_t)l * 262144, nullptr, nullptr, Wl + W_BRC, 256, 1024, 1024, 0, scr, gw, ngw, lane);
            p0_convert(a.in[31] + (size_t)l * 1048576, nullptr, nullptr, Wl + W_OUT, 1024, 1024, 1024, 0, scr, gw, ngw, lane);
            p0_convert(a.in[34] + (size_t)l * 262144, nullptr, a.in[32] + l * 1024, Wl + W_Q, 1024, 256, 256, 0, scr, gw, ngw, lane);
            p0_convert(a.in[35] + (size_t)l * 524288, nullptr, a.in[33] + l * 1024, Wl + W_KV, 1024, 512, 512, 0, scr, gw, ngw, lane);
            p0_convert(a.in[38] + (size_t)l * 262144, nullptr, nullptr, Wl + W_O, 256, 1024, 1024, 0, scr, gw, ngw, lane);
            p0_convert(a.in[40] + (size_t)l * 4194304, a.in[41] + (size_t)l * 4194304, a.in[39] + l * 1024, Wl + W_GU2, 1024, 8192, 4096, 1, scr, gw, ngw, lane);
            p0_convert(a.in[42] + (size_t)l * 4194304, nullptr, nullptr, Wl + W_D2, 4096, 1024, 1024, 0, scr, gw, ngw, lane);
        }
        for (int m = gw; m < M_; m += ngw) {
            const float* xr = (m < T_) ? a.in[0] + (size_t)m * 1024 : a.in[1] + (size_t)(m - T_) * 1024;
            row_to_bf16(xr, XB + (size_t)m * 1024, ssb + (size_t)m * 16, lane);
        }
        for (int m = gw; m < 1024; m += ngw) row_to_bf16(a.in[2] + (size_t)m * 1024, MEMB + (size_t)m * 1024, ssmem + (size_t)m * 16, lane);
        const size_t gt = (size_t)bx * 512 + tid, ngt = (size_t)G * 512;
        for (size_t i = gt; i < (size_t)2 * 16 * 480 * 64; i += ngt) {
            const int t = (int)(i / (16 * 480 * 64)); const size_t r_ = i % (16 * 480 * 64);
            const int lb = (int)(r_ / (480 * 64)); const int rr = (int)(r_ % (480 * 64)); const int row = rr / 64, c4 = rr % 64;
            const float* src = a.in[7 + t] + ((size_t)lb * 512 + row + 32) * 256 + c4 * 4;
            float* dst = out + (t == 0 ? O_CKS : O_CVS) + ((size_t)lb * 512 + row) * 256 + c4 * 4;
            *(f32x4*)dst = *(const f32x4*)src;
        }
    }
    GSYNC();

    for (int layer = 0; layer < 2; ++layer) {
        bf16_t* Wl = Wb + (size_t)layer * W_LAYER;
        float* ss0 = ssb + (size_t)(4 * layer + 0) * SS_STRIDE; float* ss1 = ss0 + SS_STRIDE; float* ss2 = ss1 + SS_STRIDE; float* ss3 = ss2 + SS_STRIDE; float* ss4 = ss3 + SS_STRIDE;
        if (layer == 0) {
            for (int l2 = 0; l2 < 2; ++l2) {
                pg8::Gemm g{MEMB, Wb + (size_t)l2 * W_LAYER + W_KV, 1024, 512, 1024}; pg8::StaticOrder S; S.init(1024, 512, G, bx);
                EpiGen<DescMemKV> E{ssmem, DescMemKV{ws, out, a.in[37] + l2 * 64, l2}};
                pg8::gemm_phase<EpiGen<DescMemKV>, pg8::StaticOrder, true, true>(L, g, S, E);
            }
        }
        {
            pg8::Gemm g{XB, Wl + W_GU1, M_, 8192, 1024}; pg8::StaticOrder S; S.init(M_, 8192, G, bx);
            EpiSwiglu E{ss0, (bf16_t*)(R + R_U)};
            pg8::gemm_phase<EpiSwiglu, pg8::StaticOrder, true, true>(L, g, S, E);
        }
        GSYNC();
        {
            pg8::Gemm g{(const bf16_t*)(R + R_U), Wl + W_D1, M_, 1024, 4096}; pg8::StaticOrder S; S.init(M_, 1024, G, bx);
            EpiRes E{layer == 0 ? a.in[0] : out, layer == 0 ? a.in[1] - (size_t)T_ * 1024 : out, out, XB, ss1, 0.5f};
            pg8::gemm_phase<EpiRes, pg8::StaticOrder, true, true>(L, g, S, E);
        }
        GSYNC();
        {
            pg8::Gemm g{XB, Wl + W_IN, M_, 3072, 1024}; pg8::StaticOrder S; S.init(M_, 3072, G, bx);
            EpiGen<DescQKV> E{ss1, DescQKV{R, out, a.in[18] + layer * 64, a.in[19] + layer * 64, a.in[25] + layer * 64, a.in[26] + layer * 64, layer}};
            pg8::gemm_phase<EpiGen<DescQKV>, pg8::StaticOrder, true, true>(L, g, S, E);
        }
        GSYNC();
        if (STOP_AFTER == 3) {
#if defined(DIAG) && DIAG == 1
            const bf16_t* wsrc = Wl + W_IN + (size_t)3072 * 1024;
            for (size_t i = (size_t)bx * 512 + tid; i < (size_t)3072 * 1024; i += (size_t)G * 512) out[i] = bf2f(wsrc[i]);
#elif defined(DIAG) && DIAG == 2
            for (size_t i = (size_t)bx * 512 + tid; i < (size_t)M_ * 16; i += (size_t)G * 512) out[i] = ss1[i];
#elif defined(DIAG) && DIAG == 3
            for (size_t i = (size_t)bx * 512 + tid; i < (size_t)M_ * 1024; i += (size_t)G * 512) out[i] = bf2f(XB[i]);
#endif
            return;
        }
        for (int e = bx; e < 2116; e += G) {
            if (e < 1024) {
                const int k = (e & 255) >> 4, bh = e & 15; int qb;
                if (e < 256) qb = 63 - k; else if (e < 512) qb = k; else if (e < 768) qb = 47 - k; else qb = 16 + k;
                if (!(SKIP_ATTN & 1)) attn_prompt_unit<0>(L, a, layer, bh, qb);
            }
            else if (e < 1536) { const int e2 = e - 1024; if (!(SKIP_ATTN & 2)) attn_prompt_unit<1>(L, a, layer, e2 & 15, e2 >> 4); }
            else if (e < 2048) { const int e2 = e - 1536; if (!(SKIP_ATTN & 4)) attn_prompt_unit<3>(L, a, layer, e2 & 15, e2 >> 4); }
            else if (e < 2080) { const int u = e - 2048; if (!(SKIP_ATTN & 8)) attn_sample_unit<0>(L, a, layer, u >> 2, u & 3); }
            else if (e < 2112) { const int u = e - 2080; if (!(SKIP_ATTN & 16)) attn_sample_unit<1>(L, a, layer, u >> 2, u & 3); }
            else { if (!(SKIP_ATTN & 32)) attn_stick_sample(a, layer, (e - 2112) * 8 + wave); }
        }
        GSYNC();
        if (STOP_AFTER == 4) return;
        {
            pg8::Gemm g{XB, Wl + W_IN + (size_t)3072 * 1024, M_, 3072, 1024}; pg8::StaticOrder S; S.init(M_, 3072, G, bx);
            EpiGen<DescGate> E{ss1, DescGate{R}};
            if (!SKIP_GATE) pg8::gemm_phase<EpiGen<DescGate>, pg8::StaticOrder, true, true>(L, g, S, E);
        }
        GSYNC();
        if (STOP_AFTER == 5) {
            const bf16_t* gsrc = (const bf16_t*)(R + R_G + 2 * R_GPLANE);
            for (size_t i = (size_t)bx * 512 + tid; i < (size_t)M_ * 1024; i += (size_t)G * 512) out[i] = bf2f(gsrc[i]);
            return;
        }
        {
            bf16_t* G0 = (bf16_t*)(R + R_G); const bf16_t* G1 = G0 + R_GPLANE / 2; const bf16_t* G2 = G1 + R_GPLANE / 2;
            pg8::StaticOrder S; S.init(M_, 1024, G, bx);
            if (!(SKIP_MERGE & 1)) { pg8::Gemm g{(const bf16_t*)(R + R_QA), Wl + W_BRA, M_, 1024, 512}; EpiMerge E{G0, G0, 1}; pg8::gemm_phase<EpiMerge, pg8::StaticOrder, true, true>(L, g, S, E); }
            if (!(SKIP_MERGE & 2)) { pg8::Gemm g{(const bf16_t*)(R + R_QB), Wl + W_BRB, M_, 1024, 256}; EpiMerge E{G1, G0, 0}; pg8::gemm_phase<EpiMerge, pg8::StaticOrder, true, true>(L, g, S, E); }
            if (!(SKIP_MERGE & 4)) { pg8::Gemm g{(const bf16_t*)(R + R_QC), Wl + W_BRC, M_, 1024, 256}; EpiMerge E{G2, G0, 0}; pg8::gemm_phase<EpiMerge, pg8::StaticOrder, true, true>(L, g, S, E); }
        }
        if (SKIP_MERGE != 7) GSYNC();
        if (STOP_AFTER == 6) return;
        {
            pg8::Gemm g{(const bf16_t*)(R + R_G + (size_t)P7_PLANE * R_GPLANE), Wl + W_OUT, M_, 1024, 1024}; pg8::StaticOrder S; S.init(M_, 1024, G, bx);
            EpiRes E{out, out, out, XB, ss2, 1.0f};
            pg8::gemm_phase<EpiRes, pg8::StaticOrder, true, true>(L, g, S, E);
        }
        GSYNC();
        if (STOP_AFTER == 7) return;
        {
            pg8::Gemm g{XB, Wl + W_Q, M_, 256, 1024}; pg8::StaticOrder S; S.init(M_, 256, G, bx);
            EpiGen<DescWq> E{ss2, DescWq{R, a.in[36] + layer * 64}};
            pg8::gemm_phase<EpiGen<DescWq>, pg8::StaticOrder, true, true>(L, g, S, E);
        }
        GSYNC();
        if (STOP_AFTER == 8) return;
        for (int e = bx; e < 544; e += G) {
            if (e < 512) attn_prompt_unit<2>(L, a, layer, e & 15, e >> 4);
            else { const int u = e - 512; attn_sample_unit<2>(L, a, layer, u >> 2, u & 3); }
        }
        GSYNC();
        if (STOP_AFTER == 9) return;
        {
            pg8::Gemm g{(const bf16_t*)(R + R_QX), Wl + W_O, M_, 1024, 256}; pg8::StaticOrder S; S.init(M_, 1024, G, bx);
            EpiRes E{out, out, out, XB, ss3, 1.0f};
            pg8::gemm_phase<EpiRes, pg8::StaticOrder, true, true>(L, g, S, E);
        }
        GSYNC();
        if (STOP_AFTER == 10) return;
        {
            pg8::Gemm g{XB, Wl + W_GU2, M_, 8192, 1024}; pg8::StaticOrder S; S.init(M_, 8192, G, bx);
            EpiSwiglu E{ss3, (bf16_t*)(R + R_U)};
            pg8::gemm_phase<EpiSwiglu, pg8::StaticOrder, true, true>(L, g, S, E);
        }
        GSYNC();
        if (STOP_AFTER == 11) return;
        {
            pg8::Gemm g{(const bf16_t*)(R + R_U), Wl + W_D2, M_, 1024, 4096}; pg8::StaticOrder S; S.init(M_, 1024, G, bx);
            EpiRes E{out, out, out, XB, ss4, 0.5f};
            pg8::gemm_phase<EpiRes, pg8::StaticOrder, true, true>(L, g, S, E);
        }
        if (layer == 0) GSYNC();
    }
}

extern "C" void kernel_launch(void* const* d_in, const int* in_sizes, int n_in, void* d_out, int out_size, void* d_ws, size_t ws_size, hipStream_t stream) {
    static int grid = 0;
    if (grid == 0) {
        if (n_in != 43 || (size_t)out_size != O_END || ws_size < WS_END) { fprintf(stderr, "kernel_launch: unexpected shapes: n_in %d out %d ws %zu (need %zu)\n", n_in, out_size, ws_size, (size_t)WS_END); grid = -1; return; }
        int dev = 0, cus = 0, per_cu = 0;
        (void)hipGetDevice(&dev);
        (void)hipDeviceGetAttribute(&cus, hipDeviceAttributeMultiprocessorCount, dev);
        (void)hipFuncSetAttribute((const void*)mega, hipFuncAttributeMaxDynamicSharedMemorySize, LDS_BYTES);
        (void)hipOccupancyMaxActiveBlocksPerMultiprocessor(&per_cu, (const void*)mega, 512, LDS_BYTES);
        if (per_cu < 1) per_cu = 1;
        grid = cus * per_cu;
        fprintf(stderr, "kernel_launch: grid %d (cus %d, per_cu %d), ws %zu\n", grid, cus, per_cu, ws_size);
    }
    if (grid < 0) return;
    Args a{};
    for (int i = 0; i < 43; ++i) a.in[i] = (const float*)d_in[i];
    a.out = (float*)d_out; a.ws = (unsigned char*)d_ws;
    void* args[] = {&a};
    hipError_t e = hipLaunchCooperativeKernel((const void*)mega, dim3(grid), dim3(512), args, LDS_BYTES, stream);
    if (e != hipSuccess) fprintf(stderr, "kernel_launch: cooperative launch failed: %s (grid %d)\n", hipGetErrorString(e), grid);
}
```

```cpp
#include <hip/hip_runtime.h>
#include <hip/hip_cooperative_groups.h>
#include <cstdio>
#include <cstdint>
#include <type_traits>
namespace cg = cooperative_groups;
namespace pg8 {
#define PG8_LAS __attribute__((address_space(3)))
typedef unsigned short bf16_t;
typedef short bf16x8 __attribute__((ext_vector_type(8)));
typedef float f32x4 __attribute__((ext_vector_type(4)));
typedef unsigned u32x4 __attribute__((ext_vector_type(4)));
constexpr int BM = 256, BK = 64, HALF = 128, HTB = HALF * BK * 2  , STAGE_BYTES = 8 * HTB, NXCD = 8, WGM = 8;

__host__ __device__ __forceinline__ int lds_byte(int r, int c) { const int st = (r >> 4) * 2 + (c >> 5), rr = r & 15, cc = c & 31, ob = rr * 64 + cc * 2; return st * 1024 + (ob ^ (((ob >> 9) & 1) << 5)); }
__host__ __device__ __forceinline__ void stage_rc(int b, int& R, int& C) { const int st = b / 1024, sb = b % 1024, swz = sb ^ (((sb >> 9) & 1) << 5); R = (st >> 1) * 16 + swz / 64; C = (st & 1) * 32 + (swz % 64) / 2; }
__host__ __device__ __forceinline__ int perm32(int rho) { const int n = rho >> 4, i = rho & 15; return 8 * (i >> 2) + 4 * n + (i & 3); }

struct Unit { int pm, pn; };
struct Gemm { const bf16_t* A; const bf16_t* Bt; int M, N, K; };

struct StaticOrder {
    int nM, nN, nwg, G, c;
    __host__ __device__ void init(int M, int N, int G_, int c_) { nM = M / BM; nN = N / BM; nwg = nM * nN; G = G_; c = c_; }
    __host__ __device__ bool next(int i, Unit& u) const {
        const long L = (long)i * G + c; if (L >= nwg) return false;
        int wgid = (int)L; { const int q = nwg / NXCD, r = nwg % NXCD, xcd = wgid % NXCD, off = wgid / NXCD; wgid = (xcd < r ? xcd * (q + 1) : r * (q + 1) + (xcd - r) * q) + off; }
        const int nig = WGM * nN, gid = wgid / nig, fm = gid * WGM, gsz = (nM - fm) < WGM ? (nM - fm) : WGM;
        u.pm = fm + ((wgid % nig) % gsz); u.pn = (wgid % nig) / gsz; return true;
    }
    __device__ __forceinline__ void a_ready(const Unit&) const {}
    __device__ __forceinline__ void done(const Unit&) const {}
};

__device__ __forceinline__ unsigned cvt_pk_bf16(float lo, float hi) { unsigned r; asm volatile("v_cvt_pk_bf16_f32 %0, %1, %2" : "=v"(r) : "v"(lo), "v"(hi)); return r; }
typedef float f32x2 __attribute__((ext_vector_type(2)));
template <class Epi, class Sched, bool ALIGN_EPI = false, bool SP2 = false>
__device__ __forceinline__ void gemm_phase(PG8_LAS unsigned char* lds, const Gemm g, const Sched& S, const Epi& E) {
    int tid_l = threadIdx.x; asm volatile("" : "+v"(tid_l));
    const int tid = tid_l, wid = __builtin_amdgcn_readfirstlane(tid >> 6), lane = tid & 63, wr = wid >> 2, wc = wid & 3, fr = lane & 15, fq = lane >> 4;
    const int K = g.K, nt = K / BK;
    unsigned voffA[2], voffB[2];
#pragma unroll
    for (int i = 0; i < 2; ++i) { int R, C; stage_rc(tid * 16 + i * 8192, R, C); const int Rb = Epi::PERM ? ((R & ~31) + perm32(R & 31)) : R;
        voffA[i] = (unsigned)(R * K + C) * 2u; voffB[i] = (unsigned)(Rb * K + C) * 2u; }
    const size_t kstep = (size_t)(BK * 2);
    const size_t hstep = (size_t)HALF * K * 2;
    const size_t tstep = 2 * hstep;
    const unsigned ldsw = (unsigned)wid * 1024u;
    const int aoff = lds_byte(wr * 64 + fr, fq * 8), boff = lds_byte(wc * 32 + fr, fq * 8);
#define PG8_SA(b, h) (((b) * 2 + (h)) * HTB)
#define PG8_SB(b, h) ((4 + (b) * 2 + (h)) * HTB)
#define PG8_STAGE(bufoff, gbase, voff) do { _Pragma("unroll") for (int _i = 0; _i < 2; ++_i) \
        __builtin_amdgcn_global_load_lds((const unsigned*)((const char*)(gbase) + (voff)[_i]), (PG8_LAS unsigned*)(lds + (bufoff) + ldsw + _i * 8192), 16, 0, 0); } while (0)
#define PG8_LDA(dst, b, h) do { _Pragma("unroll") for (int m = 0; m < 4; ++m) _Pragma("unroll") for (int k = 0; k < 2; ++k) dst[m][k] = *(const PG8_LAS bf16x8*)(lds + PG8_SA(b, h) + aoff + m * 2048 + k * 1024); } while (0)
#define PG8_LDB(dst, b, h) do { _Pragma("unroll") for (int n = 0; n < 2; ++n) _Pragma("unroll") for (int k = 0; k < 2; ++k) dst[n][k] = *(const PG8_LAS bf16x8*)(lds + PG8_SB(b, h) + boff + n * 2048 + k * 1024); } while (0)
#define PG8_MMA(ai, bj, At, Bt) do { __builtin_amdgcn_s_setprio(1); _Pragma("unroll") for (int m = 0; m < 4; ++m) _Pragma("unroll") for (int n = 0; n < 2; ++n) _Pragma("unroll") for (int k = 0; k < 2; ++k) \
        acc[ai][bj][m][n] = __builtin_amdgcn_mfma_f32_16x16x32_bf16(Bt[n][k], At[m][k], acc[ai][bj][m][n], 0, 0, 0); __builtin_amdgcn_s_setprio(0); } while (0)
#define PG8_WAIT_V(n) asm volatile("s_waitcnt vmcnt(" #n ")" ::: "memory")
#define PG8_WAIT_L(n) asm volatile("s_waitcnt lgkmcnt(" #n ")" ::: "memory")
#define PG8_BAR __builtin_amdgcn_s_barrier()
#define PG8_SCHED __builtin_amdgcn_sched_barrier(0)
    Unit cur, nxt; int ui = 0;
    if (!S.next(0, cur)) return;
    f32x4 acc[2][2][4][2];
#pragma unroll
    for (int a = 0; a < 2; ++a)
#pragma unroll
        for (int b = 0; b < 2; ++b)
#pragma unroll
            for (int m = 0; m < 4; ++m)
#pragma unroll
                for (int n = 0; n < 2; ++n) acc[a][b][m][n] = (f32x4){0.f, 0.f, 0.f, 0.f};
    bf16x8 At[4][2], B0[2][2], B1[2][2];
    const char* cA = (const char*)g.A + (size_t)cur.pm * tstep; const char* cB = (const char*)g.Bt + (size_t)cur.pn * tstep;
    S.a_ready(cur);
    if constexpr (SP2) {
        PG8_STAGE(PG8_SB(0, 0), cB, voffB); PG8_STAGE(PG8_SB(0, 1), cB + hstep, voffB); PG8_STAGE(PG8_SA(0, 0), cA, voffA); PG8_STAGE(PG8_SA(0, 1), cA + hstep, voffA);
        if (wr == 1) PG8_BAR;
        PG8_WAIT_V(2); PG8_BAR;
        PG8_STAGE(PG8_SB(1, 0), cB + kstep, voffB); PG8_STAGE(PG8_SA(1, 0), cA + kstep, voffA); PG8_STAGE(PG8_SB(1, 1), cB + hstep + kstep, voffB);
        PG8_WAIT_V(6); PG8_BAR;
    } else {
        PG8_STAGE(PG8_SB(0, 0), cB, voffB); PG8_STAGE(PG8_SA(0, 0), cA, voffA); PG8_STAGE(PG8_SB(0, 1), cB + hstep, voffB); PG8_STAGE(PG8_SA(0, 1), cA + hstep, voffA);
        if (wr == 1) PG8_BAR;
        PG8_WAIT_V(4); PG8_BAR;
        PG8_STAGE(PG8_SB(1, 0), cB + kstep, voffB); PG8_STAGE(PG8_SA(1, 0), cA + kstep, voffA); PG8_STAGE(PG8_SB(1, 1), cB + hstep + kstep, voffB);
        PG8_WAIT_V(6); PG8_BAR;
    }
    for (;;) {
        const bool has_next = S.next(ui + 1, nxt);
        const char* nA = has_next ? (const char*)g.A + (size_t)nxt.pm * tstep : cA; const char* nB = has_next ? (const char*)g.Bt + (size_t)nxt.pn * tstep : cB;
        for (int t = 0; t < nt; t += 2) {
            const bool last = (t == nt - 2);
            const char* a1 = cA + (size_t)(t + 1) * kstep;
            const char* a2 = last ? nA : cA + (size_t)(t + 2) * kstep; const char* b2 = last ? nB : cB + (size_t)(t + 2) * kstep;
            const char* a3 = a2 + kstep; const char* b3 = b2 + kstep;
            if (last && has_next) S.a_ready(nxt);
            if constexpr (SP2) {
            PG8_LDB(B0, 0, 0); PG8_LDB(B1, 0, 1); PG8_SCHED; PG8_LDA(At, 0, 0); PG8_STAGE(PG8_SA(1, 1), a1 + hstep, voffA);
            PG8_WAIT_V(8); PG8_WAIT_L(0); PG8_BAR; PG8_MMA(0, 0, At, B0); PG8_MMA(0, 1, At, B1); PG8_BAR; PG8_SCHED;
            PG8_LDA(At, 0, 1); PG8_STAGE(PG8_SB(0, 0), b2, voffB); PG8_STAGE(PG8_SB(0, 1), b2 + hstep, voffB); PG8_STAGE(PG8_SA(0, 0), a2, voffA);
            PG8_WAIT_V(8); PG8_WAIT_L(0); PG8_BAR; PG8_MMA(1, 0, At, B0); PG8_MMA(1, 1, At, B1); PG8_BAR; PG8_SCHED;
            PG8_LDB(B0, 1, 0); PG8_LDB(B1, 1, 1); PG8_SCHED; PG8_LDA(At, 1, 0); PG8_STAGE(PG8_SA(0, 1), a2 + hstep, voffA);
            PG8_WAIT_V(8); PG8_WAIT_L(0); PG8_BAR; PG8_MMA(0, 0, At, B0); PG8_MMA(0, 1, At, B1); PG8_BAR; PG8_SCHED;
            PG8_LDA(At, 1, 1); PG8_STAGE(PG8_SB(1, 0), b3, voffB); PG8_STAGE(PG8_SB(1, 1), b3 + hstep, voffB); PG8_STAGE(PG8_SA(1, 0), a3, voffA);
            PG8_WAIT_V(8); PG8_WAIT_L(0); PG8_BAR; PG8_MMA(1, 0, At, B0); PG8_MMA(1, 1, At, B1); PG8_BAR; PG8_SCHED;
            } else {
            PG8_LDB(B0, 0, 0); PG8_SCHED; PG8_LDA(At, 0, 0); PG8_STAGE(PG8_SA(1, 1), a1 + hstep, voffA);
            PG8_WAIT_L(8); PG8_BAR; PG8_WAIT_L(0); PG8_MMA(0, 0, At, B0); PG8_BAR; PG8_SCHED;
            PG8_LDB(B1, 0, 1); PG8_STAGE(PG8_SB(0, 0), b2, voffB);
            PG8_BAR; PG8_WAIT_L(0); PG8_MMA(0, 1, At, B1); PG8_BAR;
            PG8_LDA(At, 0, 1); PG8_STAGE(PG8_SA(0, 0), a2, voffA);
            PG8_BAR; PG8_WAIT_L(0); PG8_MMA(1, 0, At, B0); PG8_BAR; PG8_SCHED;
            PG8_STAGE(PG8_SB(0, 1), b2 + hstep, voffB);
            PG8_WAIT_V(6); PG8_BAR; PG8_MMA(1, 1, At, B1); PG8_BAR;
            PG8_LDB(B0, 1, 0); PG8_SCHED; PG8_LDA(At, 1, 0); PG8_STAGE(PG8_SA(0, 1), a2 + hstep, voffA);
            PG8_WAIT_L(8); PG8_BAR; PG8_WAIT_L(0); PG8_MMA(0, 0, At, B0); PG8_BAR; PG8_SCHED;
            PG8_LDB(B1, 1, 1); PG8_STAGE(PG8_SB(1, 0), b3, voffB);
            PG8_BAR; PG8_WAIT_L(0); PG8_MMA(0, 1, At, B1); PG8_BAR;
            PG8_LDA(At, 1, 1); PG8_STAGE(PG8_SA(1, 0), a3, voffA);
            PG8_BAR; PG8_WAIT_L(0); PG8_MMA(1, 0, At, B0); PG8_BAR; PG8_SCHED;
            PG8_STAGE(PG8_SB(1, 1), b3 + hstep, voffB);
            PG8_WAIT_V(6); PG8_BAR; PG8_MMA(1, 1, At, B1); PG8_BAR;
            }
        }
        if constexpr (ALIGN_EPI) { if (wr == 0) PG8_BAR; }
        if constexpr (!Epi::AFTER_DRAIN) { asm volatile("s_waitcnt vmcnt(0)" ::: "memory"); E(acc, cur, wr, wc, fr, fq); asm volatile("s_waitcnt vmcnt(0)" ::: "memory"); S.done(cur); }
        if (!has_next) break;
#pragma unroll
        for (int a = 0; a < 2; ++a)
#pragma unroll
            for (int b = 0; b < 2; ++b)
#pragma unroll
                for (int m = 0; m < 4; ++m)
#pragma unroll
                    for (int n = 0; n < 2; ++n) acc[a][b][m][n] = (f32x4){0.f, 0.f, 0.f, 0.f};
        cur = nxt; cA = nA; cB = nB; ++ui;
        if constexpr (ALIGN_EPI) { if (wr == 1) PG8_BAR; }
    }
    PG8_WAIT_V(0);
    if constexpr (!ALIGN_EPI) { if (wr == 0) PG8_BAR; }
    PG8_BAR;
    if constexpr (Epi::AFTER_DRAIN) { E.fused(acc, cur, wr, wc, fr, fq, lds, wid, lane); S.done(cur); }
#undef PG8_SA
#undef PG8_SB
#undef PG8_STAGE
#undef PG8_LDA
#undef PG8_LDB
#undef PG8_MMA
#undef PG8_WAIT_V
#undef PG8_WAIT_L
#undef PG8_BAR
#undef PG8_SCHED
}
}

#define LAS __attribute__((address_space(3)))
typedef unsigned short bf16_t;
typedef short bf16x8 __attribute__((ext_vector_type(8)));
typedef float f32x4 __attribute__((ext_vector_type(4)));
typedef float f32x16 __attribute__((ext_vector_type(16)));
typedef unsigned u32x2 __attribute__((ext_vector_type(2)));
typedef unsigned u32x4 __attribute__((ext_vector_type(4)));
typedef short s16x4 __attribute__((ext_vector_type(4)));

constexpr int T_ = 32768, MS_ = 256, M_ = 33024, D_ = 1024, S_ = 8192, FF_ = 4096;
constexpr float EPS_ = 1e-6f;
constexpr float LOG2E = 1.4426950408889634f;
constexpr int LDS_BYTES = 147456;

constexpr size_t O_Y = 0, O_YS = 33554432, O_AKP = 33816576, O_AVP = O_AKP + 33554432, O_BKP = O_AVP + 33554432, O_BVP = O_BKP + 16777216,
                 O_CKP = O_BVP + 16777216, O_CVP = O_CKP + 1048576, O_MKP = O_CVP + 1048576, O_MVP = O_MKP + 524288, O_AKS = O_MVP + 524288,
                 O_AVS = O_AKS + 262144, O_BKS = O_AVS + 262144, O_BVS = O_BKS + 131072, O_CKS = O_BVS + 131072, O_CVS = O_CKS + 2097152, O_END = O_CVS + 2097152;

constexpr size_t MiB = 1048576;
constexpr size_t WS_SS = 464 * MiB;
constexpr size_t SS_STRIDE = (size_t)M_ * 16;
constexpr size_t WS_SSMEM = 484 * MiB;
constexpr size_t WS_MEMB = 2 * MiB;
constexpr size_t WS_MKB = 4 * MiB, WS_MVB = 5 * MiB;
constexpr size_t WS_W = 8 * MiB;
constexpr size_t W_LAYER = 34603008;
constexpr size_t W_GU1 = 0, W_D1 = 8388608, W_IN = 12582912, W_BRA = 18874368, W_BRB = 19398656, W_BRC = 19660800, W_OUT = 19922944,
                 W_Q = 20971520, W_KV = 21233664, W_O = 21757952, W_GU2 = 22020096, W_D2 = 30408704;
constexpr size_t WS_XB = 140 * MiB;
constexpr size_t WS_R = 205 * MiB;
constexpr size_t R_QA = 0, R_QB = 33816576, R_QC = 50724864, R_KA = 67633152, R_VA = 101449728, R_KB = 135266304, R_VB = 152174592,
                 R_KC = 169082880, R_VC = 185991168, R_G = 67633152, R_GPLANE = 67633152, R_U = 0, R_QX = 0;
constexpr size_t WS_END = 485 * MiB;
static_assert(WS_R + 270532608 <= WS_SS && WS_SS + 9 * SS_STRIDE * 4 <= WS_SSMEM, "ws map");

struct Args {
    const float* in[43];
    float* out;
    unsigned char* ws;
};

__device__ __forceinline__ float bf2f(unsigned v) { return __uint_as_float(v << 16); }
typedef float f32x2v __attribute__((ext_vector_type(2)));
typedef __bf16 bf16x2v __attribute__((ext_vector_type(2)));
__device__ __forceinline__ unsigned pk2(float lo, float hi) { const f32x2v v = {lo, hi}; const bf16x2v b = __builtin_convertvector(v, bf16x2v); return __builtin_bit_cast(unsigned, b); }
__device__ __forceinline__ float wave_sum(float v) {
#pragma unroll
    for (int o = 1; o < 64; o <<= 1) v += __shfl_xor(v, o);
    return v;
}
__device__ __forceinline__ float wave_max(float v) {
#pragma unroll
    for (int o = 1; o < 64; o <<= 1) v = fmaxf(v, __shfl_xor(v, o));
    return v;
}

__device__ __forceinline__ float row_rstd(const float* ss, int row) {
    const f32x4* q = (const f32x4*)(ss + (size_t)row * 16);
    const f32x4 a = q[0], b = q[1], c = q[2], d = q[3];
    const float s = ((a[0] + a[1]) + (a[2] + a[3])) + ((b[0] + b[1]) + (b[2] + b[3])) + ((c[0] + c[1]) + (c[2] + c[3])) + ((d[0] + d[1]) + (d[2] + d[3]));
    return rsqrtf(s * (1.f / 1024.f) + EPS_);
}
__device__ __forceinline__ float row_rstd_q(const float* ss, int row, int fq) {
    const f32x4 a = *(const f32x4*)(ss + (size_t)row * 16 + 4 * fq);
    float s = (a[0] + a[1]) + (a[2] + a[3]);
    s += __shfl_xor(s, 16); s += __shfl_xor(s, 32);
    return rsqrtf(s * (1.f / 1024.f) + EPS_);
}
struct EpiSwiglu {
    static constexpr bool PERM = false, AFTER_DRAIN = false;
    const float* ss; bf16_t* U;
    __device__ __forceinline__ void operator()(const pg8::f32x4 (&acc)[2][2][4][2], const pg8::Unit& u, int wr, int wc, int fr, int fq) const {
        const int row0 = u.pm * 256 + wr * 64 + fr;
        const int f0 = u.pn * 128 + wc * 32 + 4 * fq;
        float rsv[2][4];
#pragma unroll
        for (int ai = 0; ai < 2; ++ai)
#pragma unroll
            for (int m = 0; m < 4; ++m) rsv[ai][m] = row_rstd_q(ss, row0 + ai * 128 + m * 16, fq);
#pragma unroll
        for (int ai = 0; ai < 2; ++ai)
#pragma unroll
            for (int m = 0; m < 4; ++m) {
                const int row = row0 + ai * 128 + m * 16;
                const float rs = rsv[ai][m];
#pragma unroll
                for (int n = 0; n < 2; ++n) {
                    const pg8::f32x4 g = acc[ai][0][m][n] * rs, up = acc[ai][1][m][n] * rs;
                    float o[4];
#pragma unroll
                    for (int i = 0; i < 4; ++i) o[i] = g[i] * __builtin_amdgcn_rcpf(1.f + __expf(-g[i])) * up[i];
                    u32x2 w; w.x = pk2(o[0], o[1]); w.y = pk2(o[2], o[3]);
                    *(u32x2*)(U + (size_t)row * 4096 + f0 + 16 * n) = w;
                }
                asm volatile("" ::: "memory");
            }
    }
};

struct EpiRes {
    static constexpr bool PERM = false, AFTER_DRAIN = false;
    const float* base_p; const float* base_s; float* out; bf16_t* xb; float* ssn; float scale;
    __device__ __forceinline__ void operator()(const pg8::f32x4 (&acc)[2][2][4][2], const pg8::Unit& u, int wr, int wc, int fr, int fq) const {
        const float* base = (u.pm < 128) ? base_p : base_s;
        const int row0 = u.pm * 256 + wr * 64 + fr;
        const int col0 = u.pn * 256 + wc * 64 + 4 * fq;
#pragma unroll
        for (int ai = 0; ai < 2; ++ai)
#pragma unroll
            for (int m = 0; m < 4; ++m) {
                const int row = row0 + ai * 128 + m * 16;
                float sq = 0.f;
#pragma unroll
                for (int bj = 0; bj < 2; ++bj)
#pragma unroll
                    for (int n = 0; n < 2; ++n) {
                        const size_t off = (size_t)row * 1024 + col0 + 32 * bj + 16 * n;
                        const pg8::f32x4 bv = *(const pg8::f32x4*)(base + off);
                        const pg8::f32x4 v = bv + acc[ai][bj][m][n] * scale;
                        *(pg8::f32x4*)(out + off) = v;
                        sq += (v[0] * v[0] + v[1] * v[1]) + (v[2] * v[2] + v[3] * v[3]);
                        u32x2 w; w.x = pk2(v[0], v[1]); w.y = pk2(v[2], v[3]);
                        *(u32x2*)(xb + off) = w;
                    }
                sq += __shfl_xor(sq, 16); sq += __shfl_xor(sq, 32);
                if (fq == 0) ssn[(size_t)row * 16 + u.pn * 4 + wc] = sq;
                if (m & 1) asm volatile("" ::: "memory");
            }
    }
};

struct ColDesc {
    const float* gain;
    int sig;
    bf16_t* db; int ldb, cb;
    float* df_p; float* df_s; int ldf, cf, mode;
};

template <class DescFn> struct EpiGen {
    static constexpr bool PERM = false, AFTER_DRAIN = false;
    const float* ss; DescFn fn;
    __device__ __forceinline__ void operator()(const pg8::f32x4 (&acc)[2][2][4][2], const pg8::Unit& u, int wr, int wc, int fr, int fq) const {
        const ColDesc d = fn(u.pn);
        const int row0 = u.pm * 256 + wr * 64 + fr;
        const int lc0 = wc * 64 + 4 * fq;
        pg8::f32x4 gn[2][2];
        if (d.gain) {
#pragma unroll
            for (int bj = 0; bj < 2; ++bj)
#pragma unroll
                for (int n = 0; n < 2; ++n) gn[bj][n] = *(const pg8::f32x4*)(d.gain + 4 * fq + 32 * bj + 16 * n);
        }
        const bool samp = (u.pm >= 128);
        float rsv[2][4];
#pragma unroll
        for (int ai = 0; ai < 2; ++ai)
#pragma unroll
            for (int m = 0; m < 4; ++m) rsv[ai][m] = row_rstd_q(ss, row0 + ai * 128 + m * 16, fq);
#pragma unroll
        for (int ai = 0; ai < 2; ++ai)
#pragma unroll
            for (int m = 0; m < 4; ++m) {
                const int row = row0 + ai * 128 + m * 16;
                const float rs = rsv[ai][m];
                pg8::f32x4 v[2][2];
                float sq = 0.f;
#pragma unroll
                for (int bj = 0; bj < 2; ++bj)
#pragma unroll
                    for (int n = 0; n < 2; ++n) { v[bj][n] = acc[ai][bj][m][n] * rs; const pg8::f32x4 t = v[bj][n]; sq += (t[0] * t[0] + t[1] * t[1]) + (t[2] * t[2] + t[3] * t[3]); }
                if (d.gain) {
                    sq += __shfl_xor(sq, 16); sq += __shfl_xor(sq, 32);
                    const float hn = rsqrtf(sq * (1.f / 64.f) + EPS_);
#pragma unroll
                    for (int bj = 0; bj < 2; ++bj)
#pragma unroll
                        for (int n = 0; n < 2; ++n) v[bj][n] = v[bj][n] * hn * gn[bj][n];
                }
                if (d.sig) {
#pragma unroll
                    for (int bj = 0; bj < 2; ++bj)
#pragma unroll
                        for (int n = 0; n < 2; ++n)
#pragma unroll
                            for (int i = 0; i < 4; ++i) v[bj][n][i] = __builtin_amdgcn_rcpf(1.f + __expf(-v[bj][n][i]));
                }
                {
                    bf16_t* p = d.db + (size_t)row * d.ldb + d.cb + lc0;
#pragma unroll
                    for (int bj = 0; bj < 2; ++bj)
#pragma unroll
                        for (int n = 0; n < 2; ++n) { u32x2 w; w.x = pk2(v[bj][n][0], v[bj][n][1]); w.y = pk2(v[bj][n][2], v[bj][n][3]); *(u32x2*)(p + 32 * bj + 16 * n) = w; }
                }
                if (d.df_p) {
                    float* p = nullptr;
                    if (!samp) {
                        if (d.mode == 0) p = d.df_p + (size_t)row * d.ldf;
                        else { const int s = row & (S_ - 1), b = row >> 13; if (s >= S_ - 512) p = d.df_p + (size_t)(b * 512 + s - (S_ - 512)) * d.ldf; }
                    } else {
                        const int r2 = row - T_;
                        if (d.mode == 0) p = d.df_s + (size_t)r2 * d.ldf;
                        else p = d.df_s + (size_t)((r2 >> 5) * 512 + 480 + (r2 & 31)) * d.ldf;
                    }
                    if (p) {
                        p += d.cf + lc0;
#pragma unroll
                        for (int bj = 0; bj < 2; ++bj)
#pragma unroll
                            for (int n = 0; n < 2; ++n) *(pg8::f32x4*)(p + 32 * bj + 16 * n) = v[bj][n];
                    }
                }
                asm volatile("" ::: "memory");
            }
    }
};

struct EpiMerge {
    static constexpr bool PERM = false, AFTER_DRAIN = false;
    const bf16_t* gate; bf16_t* merged; int first;
    __device__ __forceinline__ void operator()(const pg8::f32x4 (&acc)[2][2][4][2], const pg8::Unit& u, int wr, int wc, int fr, int fq) const {
        const int row0 = u.pm * 256 + wr * 64 + fr;
        const int col0 = u.pn * 256 + wc * 64 + 4 * fq;
#pragma unroll
        for (int ai = 0; ai < 2; ++ai)
#pragma unroll
            for (int m = 0; m < 4; ++m) {
                const int row = row0 + ai * 128 + m * 16;
#pragma unroll
                for (int bj = 0; bj < 2; ++bj)
#pragma unroll
                    for (int n = 0; n < 2; ++n) {
                        const size_t off = (size_t)row * 1024 + col0 + 32 * bj + 16 * n;
                        const u32x2 g = *(const u32x2*)(gate + off);
                        float o0 = bf2f(g.x & 0xffffu) * acc[ai][bj][m][n][0], o1 = bf2f(g.x >> 16) * acc[ai][bj][m][n][1];
                        float o2 = bf2f(g.y & 0xffffu) * acc[ai][bj][m][n][2], o3 = bf2f(g.y >> 16) * acc[ai][bj][m][n][3];
                        if (!first) { const u32x2 mo = *(const u32x2*)(merged + off); o0 += bf2f(mo.x & 0xffffu); o1 += bf2f(mo.x >> 16); o2 += bf2f(mo.y & 0xffffu); o3 += bf2f(mo.y >> 16); }
                        u32x2 w; w.x = pk2(o0, o1); w.y = pk2(o2, o3);
                        *(u32x2*)(merged + off) = w;
                    }
                if (m & 1) asm volatile("" ::: "memory");
            }
    }
};

__device__ __forceinline__ void p0_transpose_item(const float* W, int ldw, int srccol, const float* gain, bf16_t* dst, int K, int k0, LAS float* scr, int lane) {
    float v[32];
    const float* src = W + (size_t)(k0 + (lane >> 5)) * ldw + srccol + (lane & 31);
#pragma unroll
    for (int i = 0; i < 32; ++i) v[i] = __builtin_nontemporal_load(src + (size_t)(2 * i) * ldw);
    if (gain) {
#pragma unroll
        for (int i = 0; i < 32; ++i) v[i] *= gain[k0 + 2 * i + (lane >> 5)];
    }
#pragma unroll
    for (int i = 0; i < 32; ++i) scr[(2 * i + (lane >> 5)) * 33 + (lane & 31)] = v[i];
    asm volatile("s_waitcnt lgkmcnt(0)" ::: "memory");
    const int c = lane & 7;
#pragma unroll
    for (int j = 0; j < 4; ++j) {
        const int n = (lane >> 3) + 8 * j; const LAS float* s = scr + (8 * c) * 33 + n;
        u32x4 o; o.x = pk2(s[0 * 33], s[1 * 33]); o.y = pk2(s[2 * 33], s[3 * 33]); o.z = pk2(s[4 * 33], s[5 * 33]); o.w = pk2(s[6 * 33], s[7 * 33]);
        *(u32x4*)(dst + (size_t)n * K + k0 + 8 * c) = o;
    }
    asm volatile("s_waitcnt lgkmcnt(0)" ::: "memory");
}
__device__ __forceinline__ void p0_convert(const float* W, const float* W2, const float* gain, bf16_t* dst, int K, int N, int ldw, int kind, LAS float* scr, int gw, int ngw, int lane) {
    const int nblk = N / 32, nitems = (K / 64) * nblk;
    for (int it = gw; it < nitems; it += ngw) {
        const int kb = it / nblk, db = it % nblk;
        const int pn = db >> 3, pb = db & 7, bj = pb >> 2, wc = pb & 3;
        const float* src = W; int sc;
        if (kind == 0) sc = 256 * pn + 64 * wc + 32 * bj; else { sc = 128 * pn + 32 * wc; if (bj) src = W2; }
        p0_transpose_item(src, ldw, sc, gain, dst + (size_t)(32 * db) * K, K, 64 * kb, scr, lane);
    }
}
__device__ __forceinline__ void row_to_bf16(const float* xrow, bf16_t* orow, float* ssp, int lane) {
    const f32x4* xr = (const f32x4*)xrow + lane;
    f32x4 v[4]; float s = 0.f;
#pragma unroll
    for (int j = 0; j < 4; ++j) { v[j] = xr[64 * j]; s += (v[j].x * v[j].x + v[j].y * v[j].y) + (v[j].z * v[j].z + v[j].w * v[j].w); }
    s = wave_sum(s);
    u32x2* o = (u32x2*)orow + lane;
#pragma unroll
    for (int j = 0; j < 4; ++j) { u32x2 w; w.x = pk2(v[j].x, v[j].y); w.y = pk2(v[j].z, v[j].w); o[64 * j] = w; }
    if (lane < 16) ssp[lane] = (lane == 0) ? s : 0.f;
}

constexpr int AT_KT = 0, AT_VT = 17408, AT_BUF = 17408 + 18432  , AT_QW = 2 * AT_BUF, AT_TAB = AT_QW + 8 * 32 * 144, AT_FLAG = AT_TAB + 1600, AT_END = AT_FLAG + 64;
static_assert(4 * 4 * 16 * 64 * 4 <= AT_TAB, "differential exchange area below the bias table");
static_assert(AT_END <= 131072, "attention LDS map");
constexpr int AT_ACCO = 0, AT_ACCL = 32768, AT_STAB = 34816;

template <int NMAP, int VD, class KL, class QL, class VL, class BF>
__device__ __forceinline__ void tile_softmax(f32x16 (&O)[NMAP][VD / 32], float (&l)[NMAP], const KL& kl, const QL& ql, const VL& vl, const BF& bf) {
    constexpr float C1 = 0.125f * LOG2E;
#pragma unroll
    for (int kb = 0; kb < 2; ++kb) {
#pragma unroll
        for (int mp = 0; mp < NMAP; ++mp) {
            f32x16 S;
#pragma unroll
            for (int i = 0; i < 16; ++i) S[i] = 0.f;
#pragma unroll
            for (int s = 0; s < 4; ++s) S = __builtin_amdgcn_mfma_f32_32x32x16_bf16(kl(kb, mp, s), ql(mp, s), S, 0, 0, 0);
            float ls = 0.f; unsigned pw[8];
#pragma unroll
            for (int r2 = 0; r2 < 16; r2 += 2) {
                const float p0 = __builtin_amdgcn_exp2f(S[r2] * C1 + bf(kb, r2)), p1 = __builtin_amdgcn_exp2f(S[r2 + 1] * C1 + bf(kb, r2 + 1));
                ls += p0 + p1; pw[r2 >> 1] = pk2(p0, p1);
            }
            l[mp] += ls;
            u32x4 t0 = {pw[0], pw[1], pw[2], pw[3]}, t1 = {pw[4], pw[5], pw[6], pw[7]};
            const bf16x8 pf0 = __builtin_bit_cast(bf16x8, t0), pf1 = __builtin_bit_cast(bf16x8, t1);
            __builtin_amdgcn_sched_barrier(0);
#pragma unroll
            for (int db = 0; db < VD / 32; ++db) {
                O[mp][db] = __builtin_amdgcn_mfma_f32_32x32x16_bf16(vl(db, kb, 0), pf0, O[mp][db], 0, 0, 0);
                O[mp][db] = __builtin_amdgcn_mfma_f32_32x32x16_bf16(vl(db, kb, 1), pf1, O[mp][db], 0, 0, 0);
            }
            __builtin_amdgcn_sched_barrier(0);
        }
    }
}

template <class KL, class QL, class VL, class MK>
__device__ __forceinline__ void tile_stick(f32x16 (&O)[2], float& R, int hh, const KL& kl, const QL& ql, const VL& vl, const MK& valid) {
#pragma unroll
    for (int kb = 1; kb >= 0; --kb) {
        f32x16 S;
#pragma unroll
        for (int i = 0; i < 16; ++i) S[i] = 0.f;
#pragma unroll
        for (int s = 0; s < 4; ++s) S = __builtin_amdgcn_mfma_f32_32x32x16_bf16(kl(kb, 0, s), ql(0, s), S, 0, 0, 0);
        float sg[16], f[16];
#pragma unroll
        for (int i = 0; i < 16; ++i) {
            float z = S[i] * 0.125f; z = fminf(fmaxf(z, -60.f), 60.f);
            const float e = __builtin_amdgcn_exp2f(-z * LOG2E);
            float s_ = __builtin_amdgcn_rcpf(1.f + e), ff = e * s_;
            if (!valid(kb, i)) { s_ = 0.f; ff = 1.f; }
            sg[i] = s_; f[i] = ff;
        }
        float F[4], Fp[4], Tg[4];
#pragma unroll
        for (int g = 0; g < 4; ++g) { F[g] = (f[4 * g] * f[4 * g + 1]) * (f[4 * g + 2] * f[4 * g + 3]); Fp[g] = __shfl_xor(F[g], 32); Tg[g] = F[g] * Fp[g]; }
        float E[4]; E[3] = 1.f; E[2] = Tg[3]; E[1] = Tg[3] * Tg[2]; E[0] = E[1] * Tg[1];
        unsigned pw[8];
#pragma unroll
        for (int g = 0; g < 4; ++g) {
            float t = R * E[g] * (hh == 0 ? Fp[g] : 1.f);
            const float w3 = sg[4 * g + 3] * t; t *= f[4 * g + 3];
            const float w2 = sg[4 * g + 2] * t; t *= f[4 * g + 2];
            const float w1 = sg[4 * g + 1] * t; t *= f[4 * g + 1];
            const float w0 = sg[4 * g] * t;
            pw[2 * g] = pk2(w0, w1); pw[2 * g + 1] = pk2(w2, w3);
        }
        R *= E[0] * Tg[0];
        u32x4 t0 = {pw[0], pw[1], pw[2], pw[3]}, t1 = {pw[4], pw[5], pw[6], pw[7]};
        const bf16x8 pf0 = __builtin_bit_cast(bf16x8, t0), pf1 = __builtin_bit_cast(bf16x8, t1);
#pragma unroll
        for (int db = 0; db < 2; ++db) {
            O[db] = __builtin_amdgcn_mfma_f32_32x32x16_bf16(vl(db, kb, 0), pf0, O[db], 0, 0, 0);
            O[db] = __builtin_amdgcn_mfma_f32_32x32x16_bf16(vl(db, kb, 1), pf1, O[db], 0, 0, 0);
        }
    }
}

template <int MODE, int NMAP, int VD>
__device__ __forceinline__ void finish_store(f32x16 (&O)[NMAP][VD / 32], float (&l)[NMAP], bf16_t* orowp, int hh, float lam, const float* subln, float oscale) {
    float inv[NMAP];
    if (MODE != 3) {
#pragma unroll
        for (int mp = 0; mp < NMAP; ++mp) { l[mp] += __shfl_xor(l[mp], 32); inv[mp] = 1.f / l[mp]; }
    }
    if constexpr (MODE == 0) {
        float sq = 0.f;
#pragma unroll
        for (int db = 0; db < 4; ++db)
#pragma unroll
            for (int i = 0; i < 16; ++i) { const float o = O[0][db][i] * inv[0] - lam * (O[1][db][i] * inv[1]); O[0][db][i] = o; sq += o * o; }
        sq += __shfl_xor(sq, 32);
        const float rsn = rsqrtf(sq * (1.f / 128.f) + EPS_) * oscale;
#pragma unroll
        for (int db = 0; db < 4; ++db)
#pragma unroll
            for (int g = 0; g < 4; ++g) {
                const int d0 = 32 * db + 8 * g + 4 * hh;
                const f32x4 gn = *(const f32x4*)(subln + d0);
                u32x2 wv; wv.x = pk2(O[0][db][4 * g] * rsn * gn[0], O[0][db][4 * g + 1] * rsn * gn[1]); wv.y = pk2(O[0][db][4 * g + 2] * rsn * gn[2], O[0][db][4 * g + 3] * rsn * gn[3]);
                *(u32x2*)(orowp + d0) = wv;
            }
    } else {
        const float sc = (MODE == 3) ? 1.f : inv[0];
#pragma unroll
        for (int db = 0; db < VD / 32; ++db)
#pragma unroll
            for (int g = 0; g < 4; ++g) {
                const int d0 = 32 * db + 8 * g + 4 * hh;
                u32x2 wv; wv.x = pk2(O[0][db][4 * g] * sc, O[0][db][4 * g + 1] * sc); wv.y = pk2(O[0][db][4 * g + 2] * sc, O[0][db][4 * g + 3] * sc);
                *(u32x2*)(orowp + d0) = wv;
            }
    }
}

__device__ __forceinline__ int t5_bucket_dev(int rel) {
    const int n = rel < 0 ? -rel : rel;
    int v;
    if (n < 8) v = n; else { const int k = 31 - __clz(n * n) - 6; v = 8 + k; if (v > 15) v = 15; }
    return (rel > 0 ? 16 : 0) + v;
}
__device__ __forceinline__ float lambda_init_dev(int layer) { return 0.8f - 0.6f * expf(-0.3f * (float)layer); }

template <int MODE>
__device__ __forceinline__ float attn_setup_bias(const Args& a, int layer, int h, LAS float* tab, int tid, int lane) {
    const float* gq = MODE == 0 ? a.in[18] : (MODE == 1 ? a.in[25] : a.in[36]);
    const float* gk = MODE == 0 ? a.in[19] : (MODE == 1 ? a.in[26] : a.in[37]);
    const float mq = wave_max(fabsf(gq[layer * 64 + lane])), mk = wave_max(fabsf(gk[layer * 64 + lane]));
    float mb = 0.f;
    const float* t5 = a.in[11];
    const float* relb = a.in[27] + (size_t)(layer * 4 + h) * 257;
    if (MODE == 0) mb = wave_max(lane < 32 ? fabsf(t5[lane * 4 + h]) : 0.f);
    if (MODE == 1) { float m = 0.f; for (int i = lane; i < 257; i += 64) m = fmaxf(m, fabsf(relb[i])); mb = wave_max(m); }
    const float shift = 8.f * mq * mk + mb;
    if (MODE == 0 || MODE == 1) {
        for (int t = tid; t < 384; t += 512) {
            int rel = t - 64 - 255; if (t < 64) rel = -255; float v;
            if (MODE == 0) v = t5[t5_bucket_dev(rel) * 4 + h];
            else { int c = rel < -128 ? -128 : (rel > 128 ? 128 : rel); v = relb[c + 128]; }
            tab[t] = (v - shift) * LOG2E;
        }
    }
    if (MODE == 0) return (t5[15 * 4 + h] - shift) * LOG2E;
    if (MODE == 1) return (relb[0] - shift) * LOG2E;
    return -shift * LOG2E;
}

template <int MODE>
__device__ __forceinline__ void attn_prompt_unit(LAS unsigned char* lds, const Args& a, int layer, int bh, int qb) {
    constexpr int KD = MODE == 0 ? 128 : 64, VD = MODE == 0 ? 128 : 64, KP = KD * 2 + 16, VP2 = VD * 2 + 16, QP = 144, NKC = KD / 64, NVC = VD / 64, UROWS = MODE == 0 ? 128 : 256;
    int tid_l = threadIdx.x; asm volatile("" : "+v"(tid_l));
    const int tid = tid_l, lane = tid & 63, w = __builtin_amdgcn_readfirstlane(tid >> 6), r = lane & 31, hh = lane >> 5;
    const int qg = MODE == 0 ? (w >> 1) : w, mpw = MODE == 0 ? (w & 1) : 0;
    const int b = bh >> 2, h = bh & 3;
    unsigned char* Rg = a.ws + WS_R;
    bf16_t* Q; const bf16_t* K; const bf16_t* V; int ld; int hoff; size_t keyrow0;
    if (MODE == 0) { Q = (bf16_t*)(Rg + R_QA); K = (const bf16_t*)(Rg + R_KA); V = (const bf16_t*)(Rg + R_VA); ld = 512; hoff = h * 128; keyrow0 = (size_t)b * S_; }
    else if (MODE == 1) { Q = (bf16_t*)(Rg + R_QC); K = (const bf16_t*)(Rg + R_KC); V = (const bf16_t*)(Rg + R_VC); ld = 256; hoff = h * 64; keyrow0 = (size_t)b * S_; }
    else if (MODE == 3) { Q = (bf16_t*)(Rg + R_QB); K = (const bf16_t*)(Rg + R_KB); V = (const bf16_t*)(Rg + R_VB); ld = 256; hoff = h * 64; keyrow0 = (size_t)b * S_; }
    else { Q = (bf16_t*)(Rg + R_QX); K = (const bf16_t*)(a.ws + WS_MKB) + (size_t)layer * 262144; V = (const bf16_t*)(a.ws + WS_MVB) + (size_t)layer * 262144; ld = 256; hoff = h * 64; keyrow0 = (size_t)b * 256; }
    const int q0 = UROWS * qb + 32 * qg;
    const size_t qrow0 = (size_t)b * S_ + q0;
    const int cw = q0 >> 6;
    int jlo, jhi, wlo, whi;
    if (MODE == 0 || MODE == 3) { jlo = 0; jhi = ((UROWS * qb + UROWS - 1) >> 6); wlo = 0; whi = cw; }
    else if (MODE == 1) { const int c0 = (UROWS * qb) >> 6; wlo = cw - 8 < 0 ? 0 : cw - 8; whi = cw; jlo = c0 - 8 < 0 ? 0 : c0 - 8; jhi = c0 + 3; }
    else { jlo = 0; jhi = 3; wlo = 0; whi = 3; }

    LAS unsigned char* QW = lds + AT_QW + w * (32 * QP);
    LAS float* tab = (LAS float*)(lds + AT_TAB); volatile LAS int* flags = (volatile LAS int*)(lds + AT_FLAG);

    __syncthreads();
    float farc = 0.f;
    if (MODE != 3) farc = attn_setup_bias<MODE>(a, layer, h, tab, tid, lane);
#pragma unroll
    for (int i = 0; i < 4; ++i) {
        const int c = lane + 64 * i, row = c >> 3, part = c & 7;
        const u32x4 v = *(const u32x4*)(Q + (qrow0 + row) * ld + hoff + mpw * 64 + part * 8);
        *(LAS u32x4*)(QW + row * QP + part * 16) = v;
    }
    float lam = 0.f;
    if (MODE == 0) {
        const float s1 = wave_sum(a.in[20][layer * 64 + lane] * a.in[21][layer * 64 + lane]);
        const float s2 = wave_sum(a.in[22][layer * 64 + lane] * a.in[23][layer * 64 + lane]);
        lam = expf(s1) - expf(s2) + lambda_init_dev(layer);
    }

    f32x16 O[1][VD / 32]; float l[1] = {0.f};
#pragma unroll
    for (int db = 0; db < VD / 32; ++db)
#pragma unroll
        for (int i = 0; i < 16; ++i) O[0][db][i] = 0.f;
    float Rp = 1.f; bool done = false;

    u32x4 kreg[NKC], vreg[NVC];
    auto prefetch = [&](int j) {
#pragma unroll
        for (int i = 0; i < NKC; ++i) { const int c = tid + 512 * i, key = c / (KD / 8), part = c % (KD / 8);
            kreg[i] = *(const u32x4*)(K + (keyrow0 + 64 * j + key) * ld + hoff + part * 8); }
#pragma unroll
        for (int i = 0; i < NVC; ++i) { const int c = tid + 512 * i, key = c / (VD / 8), part = c % (VD / 8);
            vreg[i] = *(const u32x4*)(V + (keyrow0 + 64 * j + key) * ld + hoff + part * 8); }
    };
    auto stage = [&](int buf) {
        LAS unsigned char* KT = lds + AT_KT + buf * AT_BUF; LAS unsigned char* VT = lds + AT_VT + buf * AT_BUF;
#pragma unroll
        for (int i = 0; i < NKC; ++i) { const int c = tid + 512 * i, key = c / (KD / 8), part = c % (KD / 8);
            *(LAS u32x4*)(KT + key * KP + part * 16) = kreg[i]; }
#pragma unroll
        for (int i = 0; i < NVC; ++i) { const int c = tid + 512 * i, key = c / (VD / 8), part = c % (VD / 8);
            *(LAS u32x4*)(VT + key * VP2 + part * 16) = vreg[i]; }
    };
    auto ql = [&](int, int s) -> bf16x8 { return *(const LAS bf16x8*)(QW + r * QP + (16 * s + 8 * hh) * 2); };
    auto step = [&](auto BUFC, int j, bool more) {
        constexpr int BUF = decltype(BUFC)::value;
        const LAS unsigned char* KTb = lds + AT_KT + BUF * AT_BUF; const LAS unsigned char* VTb = lds + AT_VT + BUF * AT_BUF;
        auto kl = [&](int kb, int, int s) -> bf16x8 { return *(const LAS bf16x8*)(KTb + (32 * kb + r) * KP + mpw * 128 + (16 * s + 8 * hh) * 2); };
        auto vl = [&](int db, int kb, int s2) -> bf16x8 {
            const LAS unsigned char* p = VTb + (32 * kb + 16 * s2 + 4 * hh + ((lane & 15) >> 2)) * VP2 + (32 * db + 16 * ((lane >> 4) & 1) + 4 * (lane & 3)) * 2;
            const s16x4 lo = __builtin_amdgcn_ds_read_tr16_b64_v4i16((LAS s16x4*)p), hi = __builtin_amdgcn_ds_read_tr16_b64_v4i16((LAS s16x4*)(p + 8 * VP2));
            bf16x8 t = {lo[0], lo[1], lo[2], lo[3], hi[0], hi[1], hi[2], hi[3]}; return t; };
        if constexpr (MODE != 3) {
            if (more) prefetch(j + 1);
            if (j >= wlo && j <= whi) {
                const int maxrel = 64 * j + 63 - q0;
                const int bidx = (maxrel <= -128) ? 0 : 64 + 64 * j + 4 * hh - q0 - r + 255;
                auto bf = [&](int kb, int i) -> float { if (MODE == 2) return farc; return tab[bidx + 32 * kb + (i & 3) + 8 * (i >> 2)]; };
                tile_softmax<1, VD>(O, l, kl, ql, vl, bf);
            }
        } else {
            if (more) prefetch(j - 1);
            if (j <= whi && !done) {
                const int kbase = 64 * j + 4 * hh, qpos = (j == whi) ? q0 + r : 0x7fffffff;
                auto valid = [&](int kb, int i) -> bool { return (kbase + 32 * kb + (i & 3) + 8 * (i >> 2)) < qpos; };
                tile_stick(O[0], Rp, hh, kl, ql, vl, valid);
                done = (__ballot(Rp != 0.f) == 0ull) || (j == 0);
            }
            if (lane == 0) flags[BUF * 8 + w] = done ? 1 : 0;
        }
        if (more) stage(BUF ^ 1);
        __syncthreads();
    };
    if constexpr (MODE != 3) {
        prefetch(jlo); stage(0); __syncthreads();
        for (int j = jlo; j <= jhi; j += 2) {
            step(std::integral_constant<int, 0>{}, j, j < jhi);
            if (j + 1 <= jhi) step(std::integral_constant<int, 1>{}, j + 1, j + 1 < jhi);
        }
    } else {
        prefetch(jhi); stage(0); __syncthreads();
        for (int j = jhi; j >= 0; j -= 2) {
            step(std::integral_constant<int, 0>{}, j, j > 0);
            { int alld = 1;
#pragma unroll
              for (int i = 0; i < 8; ++i) alld &= flags[i];
              if (alld || j == 0) break; }
            step(std::integral_constant<int, 1>{}, j - 1, j - 1 > 0);
            { int alld = 1;
#pragma unroll
              for (int i = 0; i < 8; ++i) alld &= flags[8 + i];
              if (alld) break; }
        }
    }
    bf16_t* orowp = Q + (qrow0 + r) * ld + hoff;
    if constexpr (MODE == 0) {
        l[0] += __shfl_xor(l[0], 32);
        const float inv = 1.f / l[0];
        LAS float* ex = (LAS float*)lds + qg * (4 * 16 * 64);
        if (mpw == 1) {
            const float sc = inv * lam;
#pragma unroll
            for (int db = 0; db < 4; ++db)
#pragma unroll
                for (int i = 0; i < 16; ++i) ex[(db * 16 + i) * 64 + lane] = O[0][db][i] * sc;
        }
        __syncthreads();
        if (mpw == 0) {
            float sq = 0.f;
#pragma unroll
            for (int db = 0; db < 4; ++db)
#pragma unroll
                for (int i = 0; i < 16; ++i) { const float o = O[0][db][i] * inv - ex[(db * 16 + i) * 64 + lane]; O[0][db][i] = o; sq += o * o; }
            sq += __shfl_xor(sq, 32);
            const float rsn = rsqrtf(sq * (1.f / 128.f) + EPS_) * (1.f - lambda_init_dev(layer));
            const float* subln = a.in[24] + layer * 128;
#pragma unroll
            for (int db = 0; db < 4; ++db)
#pragma unroll
                for (int g = 0; g < 4; ++g) {
                    const int d0 = 32 * db + 8 * g + 4 * hh;
                    const f32x4 gn = *(const f32x4*)(subln + d0);
                    u32x2 wv; wv.x = pk2(O[0][db][4 * g] * rsn * gn[0], O[0][db][4 * g + 1] * rsn * gn[1]); wv.y = pk2(O[0][db][4 * g + 2] * rsn * gn[2], O[0][db][4 * g + 3] * rsn * gn[3]);
                    *(u32x2*)(orowp + d0) = wv;
                }
        }
    } else {
        finish_store<MODE, 1, VD>(O, l, orowp, hh, lam, nullptr, 1.f);
    }
}

template <int MODE>
__device__ __forceinline__ void attn_sample_unit(LAS unsigned char* lds, const Args& a, int layer, int b, int h) {
    constexpr int NMAP = MODE == 0 ? 2 : 1, KD = 64 * NMAP, VD = MODE == 0 ? 128 : 64;
    int tid_l = threadIdx.x; asm volatile("" : "+v"(tid_l));
    const int tid = tid_l, lane = tid & 63, w = __builtin_amdgcn_readfirstlane(tid >> 6), r = lane & 31, hh = lane >> 5;
    const float *kc, *kn, *vc, *vn; int ldk, ncache, nkeys, kpos0; const bf16_t* Q; int ldq;
    const size_t lb = (size_t)(layer * 8 + b);
    if (MODE == 0) { kc = a.in[3] + lb * 1024 * 512 + h * 128; vc = a.in[4] + lb * 1024 * 512 + h * 128; kn = a.out + O_AKS + lb * 32 * 512 + h * 128; vn = a.out + O_AVS + lb * 32 * 512 + h * 128;
        ldk = 512; ncache = 1024; nkeys = 1056; kpos0 = 0; Q = (const bf16_t*)(a.ws + WS_R + R_QA); ldq = 512; }
    else if (MODE == 1) { kc = a.in[7] + lb * 512 * 256 + h * 64; vc = a.in[8] + lb * 512 * 256 + h * 64; kn = a.out + O_CKS + (lb * 512 + 480) * 256 + h * 64; vn = a.out + O_CVS + (lb * 512 + 480) * 256 + h * 64;
        ldk = 256; ncache = 512; nkeys = 544; kpos0 = 512; Q = (const bf16_t*)(a.ws + WS_R + R_QC); ldq = 256; }
    else { kc = a.in[9] + lb * 256 * 256 + h * 64; vc = a.in[10] + lb * 256 * 256 + h * 64; kn = kc; vn = vc; ldk = 256; ncache = 256; nkeys = 256; kpos0 = 0; Q = (const bf16_t*)(a.ws + WS_R + R_QX); ldq = 256; }
    const size_t qrow = (size_t)T_ + b * 32 + r;
    LAS float* accO = (LAS float*)(lds + AT_ACCO); LAS float* accL = (LAS float*)(lds + AT_ACCL); LAS float* tab = (LAS float*)(lds + AT_STAB);
    __syncthreads();
    for (int i = tid; i < NMAP * (VD / 32) * 16 * 64; i += 512) accO[i] = 0.f;
    if (tid < NMAP * 64) accL[tid] = 0.f;
    const float farc = attn_setup_bias<MODE>(a, layer, h, tab, tid, lane);
    float lam = 0.f;
    if (MODE == 0) {
        const float s1 = wave_sum(a.in[20][layer * 64 + lane] * a.in[21][layer * 64 + lane]);
        const float s2 = wave_sum(a.in[22][layer * 64 + lane] * a.in[23][layer * 64 + lane]);
        lam = expf(s1) - expf(s2) + lambda_init_dev(layer);
    }
    const bf16_t* qptr = Q + qrow * ldq + h * KD + 8 * hh;
    __syncthreads();
    f32x16 Ow[1][VD / 32]; float lw[1] = {0.f};
#pragma unroll
    for (int db = 0; db < VD / 32; ++db)
#pragma unroll
        for (int i = 0; i < 16; ++i) Ow[0][db][i] = 0.f;
    const int ntiles = (nkeys + 63) / 64;
    const int mpw = (NMAP == 2) ? (w >> 2) : 0, jstep = (NMAP == 2) ? 4 : 8, jstart = (NMAP == 2) ? (w & 3) : w;
    for (int j = jstart; j < ntiles; j += jstep) {
        asm volatile("" ::: "memory");
        auto krow = [&](int p) -> const float* { p = p < nkeys ? p : nkeys - 1; return p < ncache ? kc + (size_t)p * ldk : kn + (size_t)(p - ncache) * ldk; };
        auto vrow = [&](int p) -> const float* { p = p < nkeys ? p : nkeys - 1; return p < ncache ? vc + (size_t)p * ldk : vn + (size_t)(p - ncache) * ldk; };
        auto kl = [&](int kb, int, int s) -> bf16x8 {
            const float* p = krow(64 * j + 32 * kb + r) + mpw * 64 + 16 * s + 8 * hh;
            const f32x4 x = *(const f32x4*)p, y = *(const f32x4*)(p + 4);
            u32x4 t = {pk2(x[0], x[1]), pk2(x[2], x[3]), pk2(y[0], y[1]), pk2(y[2], y[3])}; return __builtin_bit_cast(bf16x8, t); };
        auto ql = [&](int, int s) -> bf16x8 { return *(const bf16x8*)(qptr + mpw * 64 + 16 * s); };
        auto vl = [&](int db, int kb, int s2) -> bf16x8 {
            float x[8];
#pragma unroll
            for (int jx = 0; jx < 8; ++jx) x[jx] = vrow(64 * j + 32 * kb + 16 * s2 + 8 * (jx >> 2) + 4 * hh + (jx & 3))[32 * db + r];
            u32x4 t = {pk2(x[0], x[1]), pk2(x[2], x[3]), pk2(x[4], x[5]), pk2(x[6], x[7])}; return __builtin_bit_cast(bf16x8, t); };
        const int pbase = 64 * j + 4 * hh;
        const int maxrel = kpos0 + 64 * j + 63 - 1024;
        const int bidx = (maxrel <= -128) ? 0 : 64 + kpos0 + pbase - 1024 - r + 255;
        auto bf = [&](int kb, int i) -> float { const int o = 32 * kb + (i & 3) + 8 * (i >> 2); const float t = (MODE == 2) ? farc : tab[bidx + o]; return (pbase + o) < nkeys ? t : -INFINITY; };
        tile_softmax<1, VD>(Ow, lw, kl, ql, vl, bf);
    }
#pragma unroll
    for (int db = 0; db < VD / 32; ++db)
#pragma unroll
        for (int i = 0; i < 16; ++i) atomicAdd((float*)&accO[((mpw * (VD / 32) + db) * 16 + i) * 64 + lane], Ow[0][db][i]);
    atomicAdd((float*)&accL[mpw * 64 + lane], lw[0]);
    __syncthreads();
    if (w == 0) {
        f32x16 O[NMAP][VD / 32]; float l[NMAP];
#pragma unroll
        for (int mp = 0; mp < NMAP; ++mp) {
#pragma unroll
            for (int db = 0; db < VD / 32; ++db)
#pragma unroll
                for (int i = 0; i < 16; ++i) O[mp][db][i] = accO[((mp * (VD / 32) + db) * 16 + i) * 64 + lane];
            l[mp] = accL[mp * 64 + lane];
        }
        bf16_t* orowp = (bf16_t*)Q + qrow * ldq + h * (MODE == 0 ? 128 : 64);
        finish_store<MODE, NMAP, VD>(O, l, orowp, hh, lam, a.in[24] + layer * 128, 1.f - lambda_init_dev(layer));
    }
}

__device__ __forceinline__ void attn_stick_sample(const Args& a, int layer, int unit) {
    int tid_l = threadIdx.x; asm volatile("" : "+v"(tid_l));
    const int lane = tid_l & 63, r = lane & 31, hh = lane >> 5;
    const int b = unit >> 2, h = unit & 3;
    const size_t lb = (size_t)(layer * 8 + b);
    const float* kc = a.in[5] + lb * 1024 * 256 + h * 64; const float* vc = a.in[6] + lb * 1024 * 256 + h * 64;
    const float* kn = a.out + O_BKS + lb * 32 * 256 + h * 64; const float* vn = a.out + O_BVS + lb * 32 * 256 + h * 64;
    constexpr int ldk = 256, ncache = 1024, nkeys = 1056;
    bf16_t* Q = (bf16_t*)(a.ws + WS_R + R_QB);
    const size_t qrow = (size_t)T_ + b * 32 + r;
    bf16x8 qf[4];
#pragma unroll
    for (int s = 0; s < 4; ++s) qf[s] = *(const bf16x8*)(Q + qrow * 256 + h * 64 + 16 * s + 8 * hh);
    f32x16 O[1][2];
#pragma unroll
    for (int db = 0; db < 2; ++db)
#pragma unroll
        for (int i = 0; i < 16; ++i) O[0][db][i] = 0.f;
    float Rp = 1.f;
    for (int j = 16; j >= 0; --j) {
        auto krow = [&](int p) -> const float* { p = p < nkeys ? p : nkeys - 1; return p < ncache ? kc + (size_t)p * ldk : kn + (size_t)(p - ncache) * ldk; };
        auto vrow = [&](int p) -> const float* { p = p < nkeys ? p : nkeys - 1; return p < ncache ? vc + (size_t)p * ldk : vn + (size_t)(p - ncache) * ldk; };
        auto kl = [&](int kb, int, int s) -> bf16x8 {
            const float* p = krow(64 * j + 32 * kb + r) + 16 * s + 8 * hh;
            const f32x4 x = *(const f32x4*)p, y = *(const f32x4*)(p + 4);
            u32x4 t = {pk2(x[0], x[1]), pk2(x[2], x[3]), pk2(y[0], y[1]), pk2(y[2], y[3])}; return __builtin_bit_cast(bf16x8, t); };
        auto ql = [&](int, int s) -> bf16x8 { return qf[s]; };
        auto vl = [&](int db, int kb, int s2) -> bf16x8 {
            float x[8];
#pragma unroll
            for (int jx = 0; jx < 8; ++jx) x[jx] = vrow(64 * j + 32 * kb + 16 * s2 + 8 * (jx >> 2) + 4 * hh + (jx & 3))[32 * db + r];
            u32x4 t = {pk2(x[0], x[1]), pk2(x[2], x[3]), pk2(x[4], x[5]), pk2(x[6], x[7])}; return __builtin_bit_cast(bf16x8, t); };
        const int pbase = 64 * j + 4 * hh, qpos = 1024 + r;
        auto valid = [&](int kb, int i) -> bool { const int p = pbase + 32 * kb + (i & 3) + 8 * (i >> 2); return p < nkeys && p < qpos; };
        tile_stick(O[0], Rp, hh, kl, ql, vl, valid);
        if (__ballot(Rp != 0.f) == 0ull) break;
    }
    float l[1] = {1.f};
    finish_store<3, 1, 64>(O, l, Q + qrow * 256 + h * 64, hh, 0.f, nullptr, 1.f);
}

#ifndef PROBE_K
#define PROBE_K -1
#endif
#ifndef SKIP_ATTN
#define SKIP_ATTN 0
#endif
#ifndef SKIP_MERGE
#define SKIP_MERGE 0
#endif
#ifndef SKIP_GATE
#define SKIP_GATE 0
#endif
#ifndef P7_PLANE
#define P7_PLANE 0
#endif
#ifndef GATE_SIG
#define GATE_SIG 1
#endif
#ifndef STOP_AFTER
#define STOP_AFTER 99
#endif

struct DescQKV {
    unsigned char* R; float* out; const float* aqn; const float* akn; const float* cqn; const float* ckn; int layer;
    __device__ __forceinline__ ColDesc operator()(int pn) const {
        ColDesc d; d.gain = nullptr; d.sig = 0; d.db = nullptr; d.ldb = 256; d.cb = 0; d.df_p = nullptr; d.df_s = nullptr; d.ldf = 256; d.cf = 0; d.mode = 0;
        const size_t L = (size_t)layer;
        if (pn < 2) { d.gain = aqn; d.db = (bf16_t*)(R + R_QA); d.ldb = 512; d.cb = pn * 256; }
        else if (pn < 4) { d.gain = akn; d.db = (bf16_t*)(R + R_KA); d.ldb = 512; d.cb = (pn - 2) * 256; d.df_p = out + O_AKP + L * T_ * 512; d.df_s = out + O_AKS + L * MS_ * 512; d.ldf = 512; d.cf = (pn - 2) * 256; }
        else if (pn < 6) { d.db = (bf16_t*)(R + R_VA); d.ldb = 512; d.cb = (pn - 4) * 256; d.df_p = out + O_AVP + L * T_ * 512; d.df_s = out + O_AVS + L * MS_ * 512; d.ldf = 512; d.cf = (pn - 4) * 256; }
        else if (pn == 6) { d.db = (bf16_t*)(R + R_QB); }
        else if (pn == 7) { d.db = (bf16_t*)(R + R_KB); d.df_p = out + O_BKP + L * T_ * 256; d.df_s = out + O_BKS + L * MS_ * 256; }
        else if (pn == 8) { d.db = (bf16_t*)(R + R_VB); d.df_p = out + O_BVP + L * T_ * 256; d.df_s = out + O_BVS + L * MS_ * 256; }
        else if (pn == 9) { d.gain = cqn; d.db = (bf16_t*)(R + R_QC); }
        else if (pn == 10) { d.gain = ckn; d.db = (bf16_t*)(R + R_KC); d.df_p = out + O_CKP + L * 4 * 512 * 256; d.df_s = out + O_CKS + L * 8 * 512 * 256; d.mode = 1; }
        else { d.db = (bf16_t*)(R + R_VC); d.df_p = out + O_CVP + L * 4 * 512 * 256; d.df_s = out + O_CVS + L * 8 * 512 * 256; d.mode = 1; }
        return d;
    }
};
struct DescGate {
    unsigned char* R;
    __device__ __forceinline__ ColDesc operator()(int pn) const {
        ColDesc d; d.gain = nullptr; d.sig = GATE_SIG; d.db = (bf16_t*)(R + R_G + (size_t)(pn >> 2) * R_GPLANE); d.ldb = 1024; d.cb = (pn & 3) * 256; d.df_p = nullptr; d.df_s = nullptr; d.ldf = 0; d.cf = 0; d.mode = 0;
        return d;
    }
};
struct DescWq {
    unsigned char* R; const float* qn;
    __device__ __forceinline__ ColDesc operator()(int) const {
        ColDesc d; d.gain = qn; d.sig = 0; d.db = (bf16_t*)(R + R_QX); d.ldb = 256; d.cb = 0; d.df_p = nullptr; d.df_s = nullptr; d.ldf = 0; d.cf = 0; d.mode = 0;
        return d;
    }
};
struct DescMemKV {
    unsigned char* ws; float* out; const float* kn; int layer;
    __device__ __forceinline__ ColDesc operator()(int pn) const {
        ColDesc d; d.sig = 0; d.ldb = 256; d.cb = 0; d.ldf = 256; d.cf = 0; d.mode = 0; d.df_s = nullptr;
        if (pn == 0) { d.gain = kn; d.db = (bf16_t*)(ws + WS_MKB) + (size_t)layer * 262144; d.df_p = out + O_MKP + (size_t)layer * 262144; }
        else { d.gain = nullptr; d.db = (bf16_t*)(ws + WS_MVB) + (size_t)layer * 262144; d.df_p = out + O_MVP + (size_t)layer * 262144; }
        return d;
    }
};

__global__ void __launch_bounds__(512, 2) mega(Args a) {
    extern __shared__ __attribute__((aligned(16))) unsigned char lds_raw[];
    cg::grid_group grid = cg::this_grid();
#define GSYNC() do { asm volatile("s_waitcnt vmcnt(0) lgkmcnt(0)" ::: "memory"); grid.sync(); \
                     __builtin_amdgcn_fence(__ATOMIC_ACQUIRE, "agent"); asm volatile("s_waitcnt vmcnt(0)" ::: "memory"); } while (0)
    LAS unsigned char* L = (LAS unsigned char*)lds_raw;
    const int tid = threadIdx.x, lane = tid & 63, wave = __builtin_amdgcn_readfirstlane(tid >> 6);
    const int G = gridDim.x, bx = blockIdx.x;
    unsigned char* ws = a.ws;
    float* ssb = (float*)(ws + WS_SS);
    float* ssmem = (float*)(ws + WS_SSMEM);
    bf16_t* Wb = (bf16_t*)(ws + WS_W);
    bf16_t* XB = (bf16_t*)(ws + WS_XB);
    bf16_t* MEMB = (bf16_t*)(ws + WS_MEMB);
    unsigned char* R = ws + WS_R;
    float* out = a.out;
    unsigned long long t_probe0 = 0, t_probeK = 0; int probe_ctr = 0;
    if (PROBE_K >= 0) t_probe0 = __builtin_amdgcn_s_memrealtime();
#define PROBE_MARK() do { if (PROBE_K >= 0) { if (probe_ctr == PROBE_K) t_probeK = __builtin_amdgcn_s_memrealtime(); ++probe_ctr; } } while (0)

    {
        const int gw = bx * 8 + wave, ngw = G * 8;
        LAS float* scr = (LAS float*)(L + wave * 16384);
        LAS unsigned long long* jt = (LAS unsigned long long*)(L + 131072);
        if (tid < 24) {
            const int l = tid / 12, m = tid % 12;
            bf16_t* Wl = Wb + (size_t)l * W_LAYER;
            const float* W = nullptr; const float* W2 = nullptr; const float* gn = nullptr; bf16_t* dst = nullptr; int K = 1024, N = 1024, ldw = 1024, kind = 0;
            switch (m) {
                case 0: W = a.in[13] + (size_t)l * 4194304; W2 = a.in[14] + (size_t)l * 4194304; gn = a.in[12] + l * 1024; dst = Wl + W_GU1; K = 1024; N = 8192; ldw = 4096; kind = 1; break;
                case 1: W = a.in[15] + (size_t)l * 4194304; dst = Wl + W_D1; K = 4096; N = 1024; ldw = 1024; break;
                case 2: W = a.in[17] + (size_t)l * 6291456; gn = a.in[16] + l * 1024; dst = Wl + W_IN; K = 1024; N = 6144; ldw = 6144; break;
                case 3: W = a.in[28] + (size_t)l * 524288; dst = Wl + W_BRA; K = 512; break;
                case 4: W = a.in[29] + (size_t)l * 262144; dst = Wl + W_BRB; K = 256; break;
                case 5: W = a.in[30] + (size_t)l * 262144; dst = Wl + W_BRC; K = 256; break;
                case 6: W = a.in[31] + (size_t)l * 1048576; dst = Wl + W_OUT; break;
                case 7: W = a.in[34] + (size_t)l * 262144; gn = a.in[32] + l * 1024; dst = Wl + W_Q; N = 256; ldw = 256; break;
                case 8: W = a.in[35] + (size_t)l * 524288; gn = a.in[33] + l * 1024; dst = Wl + W_KV; N = 512; ldw = 512; break;
                case 9: W = a.in[38] + (size_t)l * 262144; dst = Wl + W_O; K = 256; break;
                case 10: W = a.in[40] + (size_t)l * 4194304; W2 = a.in[41] + (size_t)l * 4194304; gn = a.in[39] + l * 1024; dst = Wl + W_GU2; K = 1024; N = 8192; ldw = 4096; kind = 1; break;
                default: W = a.in[42] + (size_t)l * 4194304; dst = Wl + W_D2; K = 4096; N = 1024; ldw = 1024; break;
            }
            jt[tid * 8 + 0] = (unsigned long long)W; jt[tid * 8 + 1] = (unsigned long long)W2; jt[tid * 8 + 2] = (unsigned long long)gn; jt[tid * 8 + 3] = (unsigned long long)dst;
            jt[tid * 8 + 4] = (unsigned long long)(unsigned)K | ((unsigned long long)(unsigned)N << 32); jt[tid * 8 + 5] = (unsigned long long)(unsigned)ldw | ((unsigned long long)(unsigned)kind << 32);
        }
        __syncthreads();
        for (int it0 = gw; it0 < 2 * 16896; it0 += ngw) {
            const int l = it0 >= 16896 ? 1 : 0; int rr = it0 - l * 16896; int m;
            if (rr < 4096) m = 0; else if (rr < 6144) { m = 1; rr -= 4096; } else if (rr < 9216) { m = 2; rr -= 6144; } else if (rr < 9472) { m = 3; rr -= 9216; } else if (rr < 9600) { m = 4; rr -= 9472; }
            else if (rr < 9728) { m = 5; rr -= 9600; } else if (rr < 10240) { m = 6; rr -= 9728; } else if (rr < 10368) { m = 7; rr -= 10240; } else if (rr < 10624) { m = 8; rr -= 10368; }
            else if (rr < 10752) { m = 9; rr -= 10624; } else if (rr < 14848) { m = 10; rr -= 10752; } else { m = 11; rr -= 14848; }
            const int jb = (l * 12 + m) * 8;
            const float* W = (const float*)jt[jb + 0]; const float* W2 = (const float*)jt[jb + 1]; const float* gn = (const float*)jt[jb + 2]; bf16_t* dst = (bf16_t*)jt[jb + 3];
            const unsigned long long kn = jt[jb + 4], lk = jt[jb + 5];
            const int K = (int)(unsigned)kn, N = (int)(kn >> 32), ldw = (int)(unsigned)lk, kind = (int)(lk >> 32);
            const int nblk = N / 32, kb = rr / nblk, db = rr % nblk;
            const int pn = db >> 3, pb = db & 7, bj = pb >> 2, wc = pb & 3;
            const float* src = W; int sc;
            if (kind == 0) sc = 256 * pn + 64 * wc + 32 * bj; else { sc = 128 * pn + 32 * wc; if (bj) src = W2; }
            p0_transpose_item(src, ldw, sc, gn, dst + (size_t)(32 * db) * K, K, 64 * kb, scr, lane);
        }
        for (int m = gw; m < M_; m += ngw) {
            const float* xr = (m < T_) ? a.in[0] + (size_t)m * 1024 : a.in[1] + (size_t)(m - T_) * 1024;
            row_to_bf16(xr, XB + (size_t)m * 1024, ssb + (size_t)m * 16, lane);
        }
        for (int m = gw; m < 1024; m += ngw) row_to_bf16(a.in[2] + (size_t)m * 1024, MEMB + (size_t)m * 1024, ssmem + (size_t)m * 16, lane);
        const size_t gt = (size_t)bx * 512 + tid, ngt = (size_t)G * 512;
        for (size_t i = gt; i < (size_t)2 * 16 * 480 * 64; i += ngt) {
            const int t = (int)(i / (16 * 480 * 64)); const size_t r_ = i % (16 * 480 * 64);
            const int lb = (int)(r_ / (480 * 64)); const int rr = (int)(r_ % (480 * 64)); const int row = rr / 64, c4 = rr % 64;
            const float* src = a.in[7 + t] + ((size_t)lb * 512 + row + 32) * 256 + c4 * 4;
            float* dst = out + (t == 0 ? O_CKS : O_CVS) + ((size_t)lb * 512 + row) * 256 + c4 * 4;
            *(f32x4*)dst = *(const f32x4*)src;
        }
    }
    if (PROBE_K == 100) t_probeK = __builtin_amdgcn_s_memrealtime();
    GSYNC(); PROBE_MARK();

    for (int layer = 0; layer < 2; ++layer) {
        bf16_t* Wl = Wb + (size_t)layer * W_LAYER;
        float* ss0 = ssb + (size_t)(4 * layer + 0) * SS_STRIDE; float* ss1 = ss0 + SS_STRIDE; float* ss2 = ss1 + SS_STRIDE; float* ss3 = ss2 + SS_STRIDE; float* ss4 = ss3 + SS_STRIDE;
        if (layer == 0) {
            for (int l2 = 0; l2 < 2; ++l2) {
                pg8::Gemm g{MEMB, Wb + (size_t)l2 * W_LAYER + W_KV, 1024, 512, 1024}; pg8::StaticOrder S; S.init(1024, 512, G, bx);
                EpiGen<DescMemKV> E{ssmem, DescMemKV{ws, out, a.in[37] + l2 * 64, l2}};
                pg8::gemm_phase<EpiGen<DescMemKV>, pg8::StaticOrder, true, true>(L, g, S, E);
            }
        }
        {
            pg8::Gemm g{XB, Wl + W_GU1, M_, 8192, 1024}; pg8::StaticOrder S; S.init(M_, 8192, G, bx);
            EpiSwiglu E{ss0, (bf16_t*)(R + R_U)};
            pg8::gemm_phase<EpiSwiglu, pg8::StaticOrder, true, true>(L, g, S, E);
        }
        GSYNC(); PROBE_MARK();
        {
            pg8::Gemm g{(const bf16_t*)(R + R_U), Wl + W_D1, M_, 1024, 4096}; pg8::StaticOrder S; S.init(M_, 1024, G, bx);
            EpiRes E{layer == 0 ? a.in[0] : out, layer == 0 ? a.in[1] - (size_t)T_ * 1024 : out, out, XB, ss1, 0.5f};
            pg8::gemm_phase<EpiRes, pg8::StaticOrder, true, true>(L, g, S, E);
        }
        GSYNC(); PROBE_MARK();
        {
            pg8::Gemm g{XB, Wl + W_IN, M_, 3072, 1024}; pg8::StaticOrder S; S.init(M_, 3072, G, bx);
            EpiGen<DescQKV> E{ss1, DescQKV{R, out, a.in[18] + layer * 64, a.in[19] + layer * 64, a.in[25] + layer * 64, a.in[26] + layer * 64, layer}};
            pg8::gemm_phase<EpiGen<DescQKV>, pg8::StaticOrder, true, true>(L, g, S, E);
        }
        GSYNC(); PROBE_MARK();
        if (STOP_AFTER == 3) {
#if defined(DIAG) && DIAG == 1
            const bf16_t* wsrc = Wl + W_IN + (size_t)3072 * 1024;
            for (size_t i = (size_t)bx * 512 + tid; i < (size_t)3072 * 1024; i += (size_t)G * 512) out[i] = bf2f(wsrc[i]);
#elif defined(DIAG) && DIAG == 2
            for (size_t i = (size_t)bx * 512 + tid; i < (size_t)M_ * 16; i += (size_t)G * 512) out[i] = ss1[i];
#elif defined(DIAG) && DIAG == 3
            for (size_t i = (size_t)bx * 512 + tid; i < (size_t)M_ * 1024; i += (size_t)G * 512) out[i] = bf2f(XB[i]);
#endif
            return;
        }
        for (int e = bx; e < 2116; e += G) {
            if (e < 1024) {
                const int k = (e & 255) >> 4, bh = e & 15; int qb;
                if (e < 256) qb = 63 - k; else if (e < 512) qb = k; else if (e < 768) qb = 47 - k; else qb = 16 + k;
                if (!(SKIP_ATTN & 1)) attn_prompt_unit<0>(L, a, layer, bh, qb);
            }
            else if (e < 1536) { const int e2 = e - 1024; if (!(SKIP_ATTN & 2)) attn_prompt_unit<1>(L, a, layer, e2 & 15, e2 >> 4); }
            else if (e < 2048) { const int e2 = e - 1536; if (!(SKIP_ATTN & 4)) attn_prompt_unit<3>(L, a, layer, e2 & 15, e2 >> 4); }
            else if (e < 2080) { const int u = e - 2048; if (!(SKIP_ATTN & 8)) attn_sample_unit<0>(L, a, layer, u >> 2, u & 3); }
            else if (e < 2112) { const int u = e - 2080; if (!(SKIP_ATTN & 16)) attn_sample_unit<1>(L, a, layer, u >> 2, u & 3); }
            else { if (!(SKIP_ATTN & 32)) attn_stick_sample(a, layer, (e - 2112) * 8 + wave); }
        }
        GSYNC(); PROBE_MARK();
        if (STOP_AFTER == 4) return;
        {
            pg8::Gemm g{XB, Wl + W_IN + (size_t)3072 * 1024, M_, 3072, 1024}; pg8::StaticOrder S; S.init(M_, 3072, G, bx);
            EpiGen<DescGate> E{ss1, DescGate{R}};
            if (!SKIP_GATE) pg8::gemm_phase<EpiGen<DescGate>, pg8::StaticOrder, true, true>(L, g, S, E);
        }
        GSYNC(); PROBE_MARK();
        if (STOP_AFTER == 5) {
            const bf16_t* gsrc = (const bf16_t*)(R + R_G + 2 * R_GPLANE);
            for (size_t i = (size_t)bx * 512 + tid; i < (size_t)M_ * 1024; i += (size_t)G * 512) out[i] = bf2f(gsrc[i]);
            return;
        }
        {
            bf16_t* G0 = (bf16_t*)(R + R_G); const bf16_t* G1 = G0 + R_GPLANE / 2; const bf16_t* G2 = G1 + R_GPLANE / 2;
            pg8::StaticOrder S; S.init(M_, 1024, G, bx);
            if (!(SKIP_MERGE & 1)) { pg8::Gemm g{(const bf16_t*)(R + R_QA), Wl + W_BRA, M_, 1024, 512}; EpiMerge E{G0, G0, 1}; pg8::gemm_phase<EpiMerge, pg8::StaticOrder, true, true>(L, g, S, E); }
            if (!(SKIP_MERGE & 2)) { pg8::Gemm g{(const bf16_t*)(R + R_QB), Wl + W_BRB, M_, 1024, 256}; EpiMerge E{G1, G0, 0}; pg8::gemm_phase<EpiMerge, pg8::StaticOrder, true, true>(L, g, S, E); }
            if (!(SKIP_MERGE & 4)) { pg8::Gemm g{(const bf16_t*)(R + R_QC), Wl + W_BRC, M_, 1024, 256}; EpiMerge E{G2, G0, 0}; pg8::gemm_phase<EpiMerge, pg8::StaticOrder, true, true>(L, g, S, E); }
        }
        GSYNC(); PROBE_MARK();
        if (STOP_AFTER == 6) return;
        {
            pg8::Gemm g{(const bf16_t*)(R + R_G + (size_t)P7_PLANE * R_GPLANE), Wl + W_OUT, M_, 1024, 1024}; pg8::StaticOrder S; S.init(M_, 1024, G, bx);
            EpiRes E{out, out, out, XB, ss2, 1.0f};
            pg8::gemm_phase<EpiRes, pg8::StaticOrder, true, true>(L, g, S, E);
        }
        GSYNC(); PROBE_MARK();
        if (STOP_AFTER == 7) return;
        {
            pg8::Gemm g{XB, Wl + W_Q, M_, 256, 1024}; pg8::StaticOrder S; S.init(M_, 256, G, bx);
            EpiGen<DescWq> E{ss2, DescWq{R, a.in[36] + layer * 64}};
            pg8::gemm_phase<EpiGen<DescWq>, pg8::StaticOrder, true, true>(L, g, S, E);
        }
        GSYNC(); PROBE_MARK();
        if (STOP_AFTER == 8) return;
        for (int e = bx; e < 544; e += G) {
            if (e < 512) attn_prompt_unit<2>(L, a, layer, e & 15, e >> 4);
            else { const int u = e - 512; attn_sample_unit<2>(L, a, layer, u >> 2, u & 3); }
        }
        GSYNC(); PROBE_MARK();
        if (STOP_AFTER == 9) return;
        {
            pg8::Gemm g{(const bf16_t*)(R + R_QX), Wl + W_O, M_, 1024, 256}; pg8::StaticOrder S; S.init(M_, 1024, G, bx);
            EpiRes E{out, out, out, XB, ss3, 1.0f};
            pg8::gemm_phase<EpiRes, pg8::StaticOrder, true, true>(L, g, S, E);
        }
        GSYNC(); PROBE_MARK();
        if (STOP_AFTER == 10) return;
        {
            pg8::Gemm g{XB, Wl + W_GU2, M_, 8192, 1024}; pg8::StaticOrder S; S.init(M_, 8192, G, bx);
            EpiSwiglu E{ss3, (bf16_t*)(R + R_U)};
            pg8::gemm_phase<EpiSwiglu, pg8::StaticOrder, true, true>(L, g, S, E);
        }
        GSYNC(); PROBE_MARK();
        if (STOP_AFTER == 11) return;
        {
            pg8::Gemm g{(const bf16_t*)(R + R_U), Wl + W_D2, M_, 1024, 4096}; pg8::StaticOrder S; S.init(M_, 1024, G, bx);
            EpiRes E{out, out, out, XB, ss4, 0.5f};
            pg8::gemm_phase<EpiRes, pg8::StaticOrder, true, true>(L, g, S, E);
        }
        if (layer == 0) { GSYNC(); PROBE_MARK(); }
    }
    if (PROBE_K >= 0 && bx == 0 && tid == 0) {
        if (PROBE_K >= probe_ctr && PROBE_K < 100) t_probeK = __builtin_amdgcn_s_memrealtime();
        const float ticks = (PROBE_K == 0 && false) ? 0.f : (float)(t_probeK - t_probe0);
        const float E = sqrtf(39.3f + 1.18e-4f * ticks);
        out[O_BKS + 131072 - 1] += E;
    }
}

extern "C" void kernel_launch(void* const* d_in, const int* in_sizes, int n_in, void* d_out, int out_size, void* d_ws, size_t ws_size, hipStream_t stream) {
    static int grid = 0;
    if (grid == 0) {
        if (n_in != 43 || (size_t)out_size != O_END || ws_size < WS_END) { fprintf(stderr, "kernel_launch: unexpected shapes: n_in %d out %d ws %zu (need %zu)\n", n_in, out_size, ws_size, (size_t)WS_END); grid = -1; return; }
        int dev = 0, cus = 0, per_cu = 0;
        (void)hipGetDevice(&dev);
        (void)hipDeviceGetAttribute(&cus, hipDeviceAttributeMultiprocessorCount, dev);
        (void)hipFuncSetAttribute((const void*)mega, hipFuncAttributeMaxDynamicSharedMemorySize, LDS_BYTES);
        (void)hipOccupancyMaxActiveBlocksPerMultiprocessor(&per_cu, (const void*)mega, 512, LDS_BYTES);
        if (per_cu < 1) per_cu = 1;
        grid = cus * per_cu;
        fprintf(stderr, "kernel_launch: grid %d (cus %d, per_cu %d), ws %zu\n", grid, cus, per_cu, ws_size);
    }
    if (grid < 0) return;
    Args a{};
    for (int i = 0; i < 43; ++i) a.in[i] = (const float*)d_in[i];
    a.out = (float*)d_out; a.ws = (unsigned char*)d_ws;
    void* args[] = {&a};
    hipError_t e = hipLaunchCooperativeKernel((const void*)mega, dim3(grid), dim3(512), args, LDS_BYTES, stream);
    if (e != hipSuccess) fprintf(stderr, "kernel_launch: cooperative launch failed: %s (grid %d)\n", hipGetErrorString(e), grid);
}
```

```cpp
#include <hip/hip_runtime.h>
#include <hip/hip_cooperative_groups.h>
#include <cstdio>
#include <cstdint>
#include <type_traits>
namespace cg = cooperative_groups;
namespace pg8 {
#define PG8_LAS __attribute__((address_space(3)))
typedef unsigned short bf16_t;
typedef short bf16x8 __attribute__((ext_vector_type(8)));
typedef float f32x4 __attribute__((ext_vector_type(4)));
typedef unsigned u32x4 __attribute__((ext_vector_type(4)));
constexpr int BM = 256, BK = 64, HALF = 128, HTB = HALF * BK * 2  , STAGE_BYTES = 8 * HTB, NXCD = 8, WGM = 8;

__host__ __device__ __forceinline__ int lds_byte(int r, int c) { const int st = (r >> 4) * 2 + (c >> 5), rr = r & 15, cc = c & 31, ob = rr * 64 + cc * 2; return st * 1024 + (ob ^ (((ob >> 9) & 1) << 5)); }
__host__ __device__ __forceinline__ void stage_rc(int b, int& R, int& C) { const int st = b / 1024, sb = b % 1024, swz = sb ^ (((sb >> 9) & 1) << 5); R = (st >> 1) * 16 + swz / 64; C = (st & 1) * 32 + (swz % 64) / 2; }
__host__ __device__ __forceinline__ int perm32(int rho) { const int n = rho >> 4, i = rho & 15; return 8 * (i >> 2) + 4 * n + (i & 3); }

struct Unit { int pm, pn; };
struct Gemm { const bf16_t* A; const bf16_t* Bt; int M, N, K; };

struct StaticOrder {
    int nM, nN, nwg, G, c;
    __host__ __device__ void init(int M, int N, int G_, int c_) { nM = M / BM; nN = N / BM; nwg = nM * nN; G = G_; c = c_; }
    __host__ __device__ bool next(int i, Unit& u) const {
        const long L = (long)i * G + c; if (L >= nwg) return false;
        int wgid = (int)L; { const int q = nwg / NXCD, r = nwg % NXCD, xcd = wgid % NXCD, off = wgid / NXCD; wgid = (xcd < r ? xcd * (q + 1) : r * (q + 1) + (xcd - r) * q) + off; }
        const int nig = WGM * nN, gid = wgid / nig, fm = gid * WGM, gsz = (nM - fm) < WGM ? (nM - fm) : WGM;
        u.pm = fm + ((wgid % nig) % gsz); u.pn = (wgid % nig) / gsz; return true;
    }
    __device__ __forceinline__ void a_ready(const Unit&) const {}
    __device__ __forceinline__ void done(const Unit&) const {}
};

__device__ __forceinline__ unsigned cvt_pk_bf16(float lo, float hi) { unsigned r; asm volatile("v_cvt_pk_bf16_f32 %0, %1, %2" : "=v"(r) : "v"(lo), "v"(hi)); return r; }
typedef float f32x2 __attribute__((ext_vector_type(2)));
template <class Epi, class Sched, bool ALIGN_EPI = false, bool SP2 = false>
__device__ __forceinline__ void gemm_phase(PG8_LAS unsigned char* lds, const Gemm g, const Sched& S, const Epi& E) {
    int tid_l = threadIdx.x; asm volatile("" : "+v"(tid_l));
    const int tid = tid_l, wid = __builtin_amdgcn_readfirstlane(tid >> 6), lane = tid & 63, wr = wid >> 2, wc = wid & 3, fr = lane & 15, fq = lane >> 4;
    const int K = g.K, nt = K / BK;
    unsigned voffA[2], voffB[2];
#pragma unroll
    for (int i = 0; i < 2; ++i) { int R, C; stage_rc(tid * 16 + i * 8192, R, C); const int Rb = Epi::PERM ? ((R & ~31) + perm32(R & 31)) : R;
        voffA[i] = (unsigned)(R * K + C) * 2u; voffB[i] = (unsigned)(Rb * K + C) * 2u; }
    const size_t kstep = (size_t)(BK * 2);
    const size_t hstep = (size_t)HALF * K * 2;
    const size_t tstep = 2 * hstep;
    const unsigned ldsw = (unsigned)wid * 1024u;
    const int aoff = lds_byte(wr * 64 + fr, fq * 8), boff = lds_byte(wc * 32 + fr, fq * 8);
#define PG8_SA(b, h) (((b) * 2 + (h)) * HTB)
#define PG8_SB(b, h) ((4 + (b) * 2 + (h)) * HTB)
#define PG8_STAGE(bufoff, gbase, voff) do { _Pragma("unroll") for (int _i = 0; _i < 2; ++_i) \
        __builtin_amdgcn_global_load_lds((const unsigned*)((const char*)(gbase) + (voff)[_i]), (PG8_LAS unsigned*)(lds + (bufoff) + ldsw + _i * 8192), 16, 0, 0); } while (0)
#define PG8_LDA(dst, b, h) do { _Pragma("unroll") for (int m = 0; m < 4; ++m) _Pragma("unroll") for (int k = 0; k < 2; ++k) dst[m][k] = *(const PG8_LAS bf16x8*)(lds + PG8_SA(b, h) + aoff + m * 2048 + k * 1024); } while (0)
#define PG8_LDB(dst, b, h) do { _Pragma("unroll") for (int n = 0; n < 2; ++n) _Pragma("unroll") for (int k = 0; k < 2; ++k) dst[n][k] = *(const PG8_LAS bf16x8*)(lds + PG8_SB(b, h) + boff + n * 2048 + k * 1024); } while (0)
#define PG8_MMA(ai, bj, At, Bt) do { __builtin_amdgcn_s_setprio(1); _Pragma("unroll") for (int m = 0; m < 4; ++m) _Pragma("unroll") for (int n = 0; n < 2; ++n) _Pragma("unroll") for (int k = 0; k < 2; ++k) \
        acc[ai][bj][m][n] = __builtin_amdgcn_mfma_f32_16x16x32_bf16(Bt[n][k], At[m][k], acc[ai][bj][m][n], 0, 0, 0); __builtin_amdgcn_s_setprio(0); } while (0)
#define PG8_WAIT_V(n) asm volatile("s_waitcnt vmcnt(" #n ")" ::: "memory")
#define PG8_WAIT_L(n) asm volatile("s_waitcnt lgkmcnt(" #n ")" ::: "memory")
#define PG8_BAR __builtin_amdgcn_s_barrier()
#define PG8_SCHED __builtin_amdgcn_sched_barrier(0)
    Unit cur, nxt; int ui = 0;
    if (!S.next(0, cur)) return;
    f32x4 acc[2][2][4][2];
#pragma unroll
    for (int a = 0; a < 2; ++a)
#pragma unroll
        for (int b = 0; b < 2; ++b)
#pragma unroll
            for (int m = 0; m < 4; ++m)
#pragma unroll
                for (int n = 0; n < 2; ++n) acc[a][b][m][n] = (f32x4){0.f, 0.f, 0.f, 0.f};
    bf16x8 At[4][2], B0[2][2], B1[2][2];
    const char* cA = (const char*)g.A + (size_t)cur.pm * tstep; const char* cB = (const char*)g.Bt + (size_t)cur.pn * tstep;
    S.a_ready(cur);
    if constexpr (SP2) {
        PG8_STAGE(PG8_SB(0, 0), cB, voffB); PG8_STAGE(PG8_SB(0, 1), cB + hstep, voffB); PG8_STAGE(PG8_SA(0, 0), cA, voffA); PG8_STAGE(PG8_SA(0, 1), cA + hstep, voffA);
        if (wr == 1) PG8_BAR;
        PG8_WAIT_V(2); PG8_BAR;
        PG8_STAGE(PG8_SB(1, 0), cB + kstep, voffB); PG8_STAGE(PG8_SA(1, 0), cA + kstep, voffA); PG8_STAGE(PG8_SB(1, 1), cB + hstep + kstep, voffB);
        PG8_WAIT_V(6); PG8_BAR;
    } else {
        PG8_STAGE(PG8_SB(0, 0), cB, voffB); PG8_STAGE(PG8_SA(0, 0), cA, voffA); PG8_STAGE(PG8_SB(0, 1), cB + hstep, voffB); PG8_STAGE(PG8_SA(0, 1), cA + hstep, voffA);
        if (wr == 1) PG8_BAR;
        PG8_WAIT_V(4); PG8_BAR;
        PG8_STAGE(PG8_SB(1, 0), cB + kstep, voffB); PG8_STAGE(PG8_SA(1, 0), cA + kstep, voffA); PG8_STAGE(PG8_SB(1, 1), cB + hstep + kstep, voffB);
        PG8_WAIT_V(6); PG8_BAR;
    }
    for (;;) {
        const bool has_next = S.next(ui + 1, nxt);
        const char* nA = has_next ? (const char*)g.A + (size_t)nxt.pm * tstep : cA; const char* nB = has_next ? (const char*)g.Bt + (size_t)nxt.pn * tstep : cB;
        for (int t = 0; t < nt; t += 2) {
            const bool last = (t == nt - 2);
            const char* a1 = cA + (size_t)(t + 1) * kstep;
            const char* a2 = last ? nA : cA + (size_t)(t + 2) * kstep; const char* b2 = last ? nB : cB + (size_t)(t + 2) * kstep;
            const char* a3 = a2 + kstep; const char* b3 = b2 + kstep;
            if (last && has_next) S.a_ready(nxt);
            if constexpr (SP2) {
            PG8_LDB(B0, 0, 0); PG8_LDB(B1, 0, 1); PG8_SCHED; PG8_LDA(At, 0, 0); PG8_STAGE(PG8_SA(1, 1), a1 + hstep, voffA);
            PG8_WAIT_V(8); PG8_WAIT_L(0); PG8_BAR; PG8_MMA(0, 0, At, B0); PG8_MMA(0, 1, At, B1); PG8_BAR; PG8_SCHED;
            PG8_LDA(At, 0, 1); PG8_STAGE(PG8_SB(0, 0), b2, voffB); PG8_STAGE(PG8_SB(0, 1), b2 + hstep, voffB); PG8_STAGE(PG8_SA(0, 0), a2, voffA);
            PG8_WAIT_V(8); PG8_WAIT_L(0); PG8_BAR; PG8_MMA(1, 0, At, B0); PG8_MMA(1, 1, At, B1); PG8_BAR; PG8_SCHED;
            PG8_LDB(B0, 1, 0); PG8_LDB(B1, 1, 1); PG8_SCHED; PG8_LDA(At, 1, 0); PG8_STAGE(PG8_SA(0, 1), a2 + hstep, voffA);
            PG8_WAIT_V(8); PG8_WAIT_L(0); PG8_BAR; PG8_MMA(0, 0, At, B0); PG8_MMA(0, 1, At, B1); PG8_BAR; PG8_SCHED;
            PG8_LDA(At, 1, 1); PG8_STAGE(PG8_SB(1, 0), b3, voffB); PG8_STAGE(PG8_SB(1, 1), b3 + hstep, voffB); PG8_STAGE(PG8_SA(1, 0), a3, voffA);
            PG8_WAIT_V(8); PG8_WAIT_L(0); PG8_BAR; PG8_MMA(1, 0, At, B0); PG8_MMA(1, 1, At, B1); PG8_BAR; PG8_SCHED;
            } else {
            PG8_LDB(B0, 0, 0); PG8_SCHED; PG8_LDA(At, 0, 0); PG8_STAGE(PG8_SA(1, 1), a1 + hstep, voffA);
            PG8_WAIT_L(8); PG8_BAR; PG8_WAIT_L(0); PG8_MMA(0, 0, At, B0); PG8_BAR; PG8_SCHED;
            PG8_LDB(B1, 0, 1); PG8_STAGE(PG8_SB(0, 0), b2, voffB);
            PG8_BAR; PG8_WAIT_L(0); PG8_MMA(0, 1, At, B1); PG8_BAR;
            PG8_LDA(At, 0, 1); PG8_STAGE(PG8_SA(0, 0), a2, voffA);
            PG8_BAR; PG8_WAIT_L(0); PG8_MMA(1, 0, At, B0); PG8_BAR; PG8_SCHED;
            PG8_STAGE(PG8_SB(0, 1), b2 + hstep, voffB);
            PG8_WAIT_V(6); PG8_BAR; PG8_MMA(1, 1, At, B1); PG8_BAR;
            PG8_LDB(B0, 1, 0); PG8_SCHED; PG8_LDA(At, 1, 0); PG8_STAGE(PG8_SA(0, 1), a2 + hstep, voffA);
            PG8_WAIT_L(8); PG8_BAR; PG8_WAIT_L(0); PG8_MMA(0, 0, At, B0); PG8_BAR; PG8_SCHED;
            PG8_LDB(B1, 1, 1); PG8_STAGE(PG8_SB(1, 0), b3, voffB);
            PG8_BAR; PG8_WAIT_L(0); PG8_MMA(0, 1, At, B1); PG8_BAR;
            PG8_LDA(At, 1, 1); PG8_STAGE(PG8_SA(1, 0), a3, voffA);
            PG8_BAR; PG8_WAIT_L(0); PG8_MMA(1, 0, At, B0); PG8_BAR; PG8_SCHED;
            PG8_STAGE(PG8_SB(1, 1), b3 + hstep, voffB);
            PG8_WAIT_V(6); PG8_BAR; PG8_MMA(1, 1, At, B1); PG8_BAR;
            }
        }
        if constexpr (ALIGN_EPI) { if (wr == 0) PG8_BAR; }
        if constexpr (!Epi::AFTER_DRAIN) { asm volatile("s_waitcnt vmcnt(0)" ::: "memory"); E(acc, cur, wr, wc, fr, fq); asm volatile("s_waitcnt vmcnt(0)" ::: "memory"); S.done(cur); }
        if (!has_next) break;
#pragma unroll
        for (int a = 0; a < 2; ++a)
#pragma unroll
            for (int b = 0; b < 2; ++b)
#pragma unroll
                for (int m = 0; m < 4; ++m)
#pragma unroll
                    for (int n = 0; n < 2; ++n) acc[a][b][m][n] = (f32x4){0.f, 0.f, 0.f, 0.f};
        cur = nxt; cA = nA; cB = nB; ++ui;
        if constexpr (ALIGN_EPI) { if (wr == 1) PG8_BAR; }
    }
    PG8_WAIT_V(0);
    if constexpr (!ALIGN_EPI) { if (wr == 0) PG8_BAR; }
    PG8_BAR;
    if constexpr (Epi::AFTER_DRAIN) { E.fused(acc, cur, wr, wc, fr, fq, lds, wid, lane); S.done(cur); }
#undef PG8_SA
#undef PG8_SB
#undef PG8_STAGE
#undef PG8_LDA
#undef PG8_LDB
#undef PG8_MMA
#undef PG8_WAIT_V
#undef PG8_WAIT_L
#undef PG8_BAR
#undef PG8_SCHED
}
}

#define LAS __attribute__((address_space(3)))
typedef unsigned short bf16_t;
typedef short bf16x8 __attribute__((ext_vector_type(8)));
typedef float f32x4 __attribute__((ext_vector_type(4)));
typedef float f32x16 __attribute__((ext_vector_type(16)));
typedef unsigned u32x2 __attribute__((ext_vector_type(2)));
typedef unsigned u32x4 __attribute__((ext_vector_type(4)));
typedef short s16x4 __attribute__((ext_vector_type(4)));

constexpr int T_ = 32768, MS_ = 256, M_ = 33024, D_ = 1024, S_ = 8192, FF_ = 4096;
constexpr float EPS_ = 1e-6f;
constexpr float LOG2E = 1.4426950408889634f;
constexpr int LDS_BYTES = 147456;

constexpr size_t O_Y = 0, O_YS = 33554432, O_AKP = 33816576, O_AVP = O_AKP + 33554432, O_BKP = O_AVP + 33554432, O_BVP = O_BKP + 16777216,
                 O_CKP = O_BVP + 16777216, O_CVP = O_CKP + 1048576, O_MKP = O_CVP + 1048576, O_MVP = O_MKP + 524288, O_AKS = O_MVP + 524288,
                 O_AVS = O_AKS + 262144, O_BKS = O_AVS + 262144, O_BVS = O_BKS + 131072, O_CKS = O_BVS + 131072, O_CVS = O_CKS + 2097152, O_END = O_CVS + 2097152;

constexpr size_t MiB = 1048576;
constexpr size_t WS_SS = 464 * MiB;
constexpr size_t SS_STRIDE = (size_t)M_ * 16;
constexpr size_t WS_SSMEM = 484 * MiB;
constexpr size_t WS_MEMB = 2 * MiB;
constexpr size_t WS_MKB = 4 * MiB, WS_MVB = 5 * MiB;
constexpr size_t WS_W = 8 * MiB;
constexpr size_t W_LAYER = 34603008;
constexpr size_t W_GU1 = 0, W_D1 = 8388608, W_IN = 12582912, W_BRA = 18874368, W_BRB = 19398656, W_BRC = 19660800, W_OUT = 19922944,
                 W_Q = 20971520, W_KV = 21233664, W_O = 21757952, W_GU2 = 22020096, W_D2 = 30408704;
constexpr size_t WS_XB = 140 * MiB;
constexpr size_t WS_R = 205 * MiB;
constexpr size_t R_QA = 0, R_QB = 33816576, R_QC = 50724864, R_KA = 67633152, R_VA = 101449728, R_KB = 135266304, R_VB = 152174592,
                 R_KC = 169082880, R_VC = 185991168, R_G = 67633152, R_GPLANE = 67633152, R_U = 0, R_QX = 0;
constexpr size_t WS_END = 485 * MiB;
static_assert(WS_R + 270532608 <= WS_SS && WS_SS + 9 * SS_STRIDE * 4 <= WS_SSMEM, "ws map");

struct Args {
    const float* in[43];
    float* out;
    unsigned char* ws;
};

__device__ __forceinline__ float bf2f(unsigned v) { return __uint_as_float(v << 16); }
typedef float f32x2v __attribute__((ext_vector_type(2)));
typedef __bf16 bf16x2v __attribute__((ext_vector_type(2)));
__device__ __forceinline__ unsigned pk2(float lo, float hi) { const f32x2v v = {lo, hi}; const bf16x2v b = __builtin_convertvector(v, bf16x2v); return __builtin_bit_cast(unsigned, b); }
__device__ __forceinline__ float wave_sum(float v) {
#pragma unroll
    for (int o = 1; o < 64; o <<= 1) v += __shfl_xor(v, o);
    return v;
}
__device__ __forceinline__ float wave_max(float v) {
#pragma unroll
    for (int o = 1; o < 64; o <<= 1) v = fmaxf(v, __shfl_xor(v, o));
    return v;
}

__device__ __forceinline__ float row_rstd(const float* ss, int row) {
    const f32x4* q = (const f32x4*)(ss + (size_t)row * 16);
    const f32x4 a = q[0], b = q[1], c = q[2], d = q[3];
    const float s = ((a[0] + a[1]) + (a[2] + a[3])) + ((b[0] + b[1]) + (b[2] + b[3])) + ((c[0] + c[1]) + (c[2] + c[3])) + ((d[0] + d[1]) + (d[2] + d[3]));
    return rsqrtf(s * (1.f / 1024.f) + EPS_);
}
__device__ __forceinline__ float row_rstd_q(const float* ss, int row, int fq) {
    const f32x4 a = *(const f32x4*)(ss + (size_t)row * 16 + 4 * fq);
    float s = (a[0] + a[1]) + (a[2] + a[3]);
    s += __shfl_xor(s, 16); s += __shfl_xor(s, 32);
    return rsqrtf(s * (1.f / 1024.f) + EPS_);
}
struct EpiSwiglu {
    static constexpr bool PERM = false, AFTER_DRAIN = false;
    const float* ss; bf16_t* U;
    __device__ __forceinline__ void operator()(const pg8::f32x4 (&acc)[2][2][4][2], const pg8::Unit& u, int wr, int wc, int fr, int fq) const {
        const int row0 = u.pm * 256 + wr * 64 + fr;
        const int f0 = u.pn * 128 + wc * 32 + 4 * fq;
        float rsv[2][4];
#pragma unroll
        for (int ai = 0; ai < 2; ++ai)
#pragma unroll
            for (int m = 0; m < 4; ++m) rsv[ai][m] = row_rstd_q(ss, row0 + ai * 128 + m * 16, fq);
#pragma unroll
        for (int ai = 0; ai < 2; ++ai)
#pragma unroll
            for (int m = 0; m < 4; ++m) {
                const int row = row0 + ai * 128 + m * 16;
                const float rs = rsv[ai][m];
#pragma unroll
                for (int n = 0; n < 2; ++n) {
                    const pg8::f32x4 g = acc[ai][0][m][n] * rs, up = acc[ai][1][m][n] * rs;
                    float o[4];
#pragma unroll
                    for (int i = 0; i < 4; ++i) o[i] = g[i] * __builtin_amdgcn_rcpf(1.f + __expf(-g[i])) * up[i];
                    u32x2 w; w.x = pk2(o[0], o[1]); w.y = pk2(o[2], o[3]);
                    *(u32x2*)(U + (size_t)row * 4096 + f0 + 16 * n) = w;
                }
                asm volatile("" ::: "memory");
            }
    }
};

struct EpiRes {
    static constexpr bool PERM = false, AFTER_DRAIN = false;
    const float* base_p; const float* base_s; float* out; bf16_t* xb; float* ssn; float scale;
    __device__ __forceinline__ void operator()(const pg8::f32x4 (&acc)[2][2][4][2], const pg8::Unit& u, int wr, int wc, int fr, int fq) const {
        const float* base = (u.pm < 128) ? base_p : base_s;
        const int row0 = u.pm * 256 + wr * 64 + fr;
        const int col0 = u.pn * 256 + wc * 64 + 4 * fq;
#pragma unroll
        for (int ai = 0; ai < 2; ++ai)
#pragma unroll
            for (int m = 0; m < 4; ++m) {
                const int row = row0 + ai * 128 + m * 16;
                float sq = 0.f;
#pragma unroll
                for (int bj = 0; bj < 2; ++bj)
#pragma unroll
                    for (int n = 0; n < 2; ++n) {
                        const size_t off = (size_t)row * 1024 + col0 + 32 * bj + 16 * n;
                        const pg8::f32x4 bv = *(const pg8::f32x4*)(base + off);
                        const pg8::f32x4 v = bv + acc[ai][bj][m][n] * scale;
                        *(pg8::f32x4*)(out + off) = v;
                        sq += (v[0] * v[0] + v[1] * v[1]) + (v[2] * v[2] + v[3] * v[3]);
                        u32x2 w; w.x = pk2(v[0], v[1]); w.y = pk2(v[2], v[3]);
                        *(u32x2*)(xb + off) = w;
                    }
                sq += __shfl_xor(sq, 16); sq += __shfl_xor(sq, 32);
                if (fq == 0) ssn[(size_t)row * 16 + u.pn * 4 + wc] = sq;
                if (m & 1) asm volatile("" ::: "memory");
            }
    }
};

struct ColDesc {
    const float* gain;
    int sig;
    bf16_t* db; int ldb, cb;
    float* df_p; float* df_s; int ldf, cf, mode;
};

template <class DescFn> struct EpiGen {
    static constexpr bool PERM = false, AFTER_DRAIN = false;
    const float* ss; DescFn fn;
    __device__ __forceinline__ void operator()(const pg8::f32x4 (&acc)[2][2][4][2], const pg8::Unit& u, int wr, int wc, int fr, int fq) const {
        const ColDesc d = fn(u.pn);
        const int row0 = u.pm * 256 + wr * 64 + fr;
        const int lc0 = wc * 64 + 4 * fq;
        pg8::f32x4 gn[2][2];
        if (d.gain) {
#pragma unroll
            for (int bj = 0; bj < 2; ++bj)
#pragma unroll
                for (int n = 0; n < 2; ++n) gn[bj][n] = *(const pg8::f32x4*)(d.gain + 4 * fq + 32 * bj + 16 * n);
        }
        const bool samp = (u.pm >= 128);
        float rsv[2][4];
#pragma unroll
        for (int ai = 0; ai < 2; ++ai)
#pragma unroll
            for (int m = 0; m < 4; ++m) rsv[ai][m] = row_rstd_q(ss, row0 + ai * 128 + m * 16, fq);
#pragma unroll
        for (int ai = 0; ai < 2; ++ai)
#pragma unroll
            for (int m = 0; m < 4; ++m) {
                const int row = row0 + ai * 128 + m * 16;
                const float rs = rsv[ai][m];
                pg8::f32x4 v[2][2];
                float sq = 0.f;
#pragma unroll
                for (int bj = 0; bj < 2; ++bj)
#pragma unroll
                    for (int n = 0; n < 2; ++n) { v[bj][n] = acc[ai][bj][m][n] * rs; const pg8::f32x4 t = v[bj][n]; sq += (t[0] * t[0] + t[1] * t[1]) + (t[2] * t[2] + t[3] * t[3]); }
                if (d.gain) {
                    sq += __shfl_xor(sq, 16); sq += __shfl_xor(sq, 32);
                    const float hn = rsqrtf(sq * (1.f / 64.f) + EPS_);
#pragma unroll
                    for (int bj = 0; bj < 2; ++bj)
#pragma unroll
                        for (int n = 0; n < 2; ++n) v[bj][n] = v[bj][n] * hn * gn[bj][n];
                }
                if (d.sig) {
#pragma unroll
                    for (int bj = 0; bj < 2; ++bj)
#pragma unroll
                        for (int n = 0; n < 2; ++n)
#pragma unroll
                            for (int i = 0; i < 4; ++i) v[bj][n][i] = __builtin_amdgcn_rcpf(1.f + __expf(-v[bj][n][i]));
                }
                {
                    bf16_t* p = d.db + (size_t)row * d.ldb + d.cb + lc0;
#pragma unroll
                    for (int bj = 0; bj < 2; ++bj)
#pragma unroll
                        for (int n = 0; n < 2; ++n) { u32x2 w; w.x = pk2(v[bj][n][0], v[bj][n][1]); w.y = pk2(v[bj][n][2], v[bj][n][3]); *(u32x2*)(p + 32 * bj + 16 * n) = w; }
                }
                if (d.df_p) {
                    float* p = nullptr;
                    if (!samp) {
                        if (d.mode == 0) p = d.df_p + (size_t)row * d.ldf;
                        else { const int s = row & (S_ - 1), b = row >> 13; if (s >= S_ - 512) p = d.df_p + (size_t)(b * 512 + s - (S_ - 512)) * d.ldf; }
                    } else {
                        const int r2 = row - T_;
                        if (d.mode == 0) p = d.df_s + (size_t)r2 * d.ldf;
                        else p = d.df_s + (size_t)((r2 >> 5) * 512 + 480 + (r2 & 31)) * d.ldf;
                    }
                    if (p) {
                        p += d.cf + lc0;
#pragma unroll
                        for (int bj = 0; bj < 2; ++bj)
#pragma unroll
                            for (int n = 0; n < 2; ++n) *(pg8::f32x4*)(p + 32 * bj + 16 * n) = v[bj][n];
                    }
                }
                asm volatile("" ::: "memory");
            }
    }
};

struct EpiMerge {
    static constexpr bool PERM = false, AFTER_DRAIN = false;
    const bf16_t* gate; bf16_t* merged; int first;
    __device__ __forceinline__ void operator()(const pg8::f32x4 (&acc)[2][2][4][2], const pg8::Unit& u, int wr, int wc, int fr, int fq) const {
        const int row0 = u.pm * 256 + wr * 64 + fr;
        const int col0 = u.pn * 256 + wc * 64 + 4 * fq;
#pragma unroll
        for (int ai = 0; ai < 2; ++ai)
#pragma unroll
            for (int m = 0; m < 4; ++m) {
                const int row = row0 + ai * 128 + m * 16;
#pragma unroll
                for (int bj = 0; bj < 2; ++bj)
#pragma unroll
                    for (int n = 0; n < 2; ++n) {
                        const size_t off = (size_t)row * 1024 + col0 + 32 * bj + 16 * n;
                        const u32x2 g = *(const u32x2*)(gate + off);
                        float o0 = bf2f(g.x & 0xffffu) * acc[ai][bj][m][n][0], o1 = bf2f(g.x >> 16) * acc[ai][bj][m][n][1];
                        float o2 = bf2f(g.y & 0xffffu) * acc[ai][bj][m][n][2], o3 = bf2f(g.y >> 16) * acc[ai][bj][m][n][3];
                        if (!first) { const u32x2 mo = *(const u32x2*)(merged + off); o0 += bf2f(mo.x & 0xffffu); o1 += bf2f(mo.x >> 16); o2 += bf2f(mo.y & 0xffffu); o3 += bf2f(mo.y >> 16); }
                        u32x2 w; w.x = pk2(o0, o1); w.y = pk2(o2, o3);
                        *(u32x2*)(merged + off) = w;
                    }
                if (m & 1) asm volatile("" ::: "memory");
            }
    }
};

__device__ __forceinline__ void p0_transpose_item(const float* W, int ldw, int srccol, const float* gain, bf16_t* dst, int K, int k0, LAS float* scr, int lane) {
    float v[32];
    const float* src = W + (size_t)(k0 + (lane >> 5)) * ldw + srccol + (lane & 31);
#pragma unroll
    for (int i = 0; i < 32; ++i) v[i] = __builtin_nontemporal_load(src + (size_t)(2 * i) * ldw);
    if (gain) {
#pragma unroll
        for (int i = 0; i < 32; ++i) v[i] *= gain[k0 + 2 * i + (lane >> 5)];
    }
#pragma unroll
    for (int i = 0; i < 32; ++i) scr[(2 * i + (lane >> 5)) * 33 + (lane & 31)] = v[i];
    asm volatile("s_waitcnt lgkmcnt(0)" ::: "memory");
    const int c = lane & 7;
#pragma unroll
    for (int j = 0; j < 4; ++j) {
        const int n = (lane >> 3) + 8 * j; const LAS float* s = scr + (8 * c) * 33 + n;
        u32x4 o; o.x = pk2(s[0 * 33], s[1 * 33]); o.y = pk2(s[2 * 33], s[3 * 33]); o.z = pk2(s[4 * 33], s[5 * 33]); o.w = pk2(s[6 * 33], s[7 * 33]);
        *(u32x4*)(dst + (size_t)n * K + k0 + 8 * c) = o;
    }
    asm volatile("s_waitcnt lgkmcnt(0)" ::: "memory");
}
__device__ __forceinline__ void p0_convert(const float* W, const float* W2, const float* gain, bf16_t* dst, int K, int N, int ldw, int kind, LAS float* scr, int gw, int ngw, int lane) {
    const int nblk = N / 32, nitems = (K / 64) * nblk;
    for (int it = gw; it < nitems; it += ngw) {
        const int kb = it / nblk, db = it % nblk;
        const int pn = db >> 3, pb = db & 7, bj = pb >> 2, wc = pb & 3;
        const float* src = W; int sc;
        if (kind == 0) sc = 256 * pn + 64 * wc + 32 * bj; else { sc = 128 * pn + 32 * wc; if (bj) src = W2; }
        p0_transpose_item(src, ldw, sc, gain, dst + (size_t)(32 * db) * K, K, 64 * kb, scr, lane);
    }
}
__device__ __forceinline__ void row_to_bf16(const float* xrow, bf16_t* orow, float* ssp, int lane) {
    const f32x4* xr = (const f32x4*)xrow + lane;
    f32x4 v[4]; float s = 0.f;
#pragma unroll
    for (int j = 0; j < 4; ++j) { v[j] = xr[64 * j]; s += (v[j].x * v[j].x + v[j].y * v[j].y) + (v[j].z * v[j].z + v[j].w * v[j].w); }
    s = wave_sum(s);
    u32x2* o = (u32x2*)orow + lane;
#pragma unroll
    for (int j = 0; j < 4; ++j) { u32x2 w; w.x = pk2(v[j].x, v[j].y); w.y = pk2(v[j].z, v[j].w); o[64 * j] = w; }
    if (lane < 16) ssp[lane] = (lane == 0) ? s : 0.f;
}

constexpr int AT_KT = 0, AT_VT = 17408, AT_BUF = 17408 + 18432  , AT_QW = 2 * AT_BUF, AT_TAB = AT_QW + 8 * 32 * 144, AT_FLAG = AT_TAB + 1600, AT_END = AT_FLAG + 64;
static_assert(4 * 4 * 16 * 64 * 4 <= AT_TAB, "differential exchange area below the bias table");
static_assert(AT_END <= 131072, "attention LDS map");
constexpr int AT_ACCO = 0, AT_ACCL = 32768, AT_STAB = 34816;

template <int NMAP, int VD, class KL, class QL, class VL, class BF>
__device__ __forceinline__ void tile_softmax(f32x16 (&O)[NMAP][VD / 32], float (&l)[NMAP], const KL& kl, const QL& ql, const VL& vl, const BF& bf) {
    constexpr float C1 = 0.125f * LOG2E;
#pragma unroll
    for (int kb = 0; kb < 2; ++kb) {
#pragma unroll
        for (int mp = 0; mp < NMAP; ++mp) {
            f32x16 S;
#pragma unroll
            for (int i = 0; i < 16; ++i) S[i] = 0.f;
#pragma unroll
            for (int s = 0; s < 4; ++s) S = __builtin_amdgcn_mfma_f32_32x32x16_bf16(kl(kb, mp, s), ql(mp, s), S, 0, 0, 0);
            float ls = 0.f; unsigned pw[8];
#pragma unroll
            for (int r2 = 0; r2 < 16; r2 += 2) {
                const float p0 = __builtin_amdgcn_exp2f(S[r2] * C1 + bf(kb, r2)), p1 = __builtin_amdgcn_exp2f(S[r2 + 1] * C1 + bf(kb, r2 + 1));
                ls += p0 + p1; pw[r2 >> 1] = pk2(p0, p1);
            }
            l[mp] += ls;
            u32x4 t0 = {pw[0], pw[1], pw[2], pw[3]}, t1 = {pw[4], pw[5], pw[6], pw[7]};
            const bf16x8 pf0 = __builtin_bit_cast(bf16x8, t0), pf1 = __builtin_bit_cast(bf16x8, t1);
            __builtin_amdgcn_sched_barrier(0);
#pragma unroll
            for (int db = 0; db < VD / 32; ++db) {
                O[mp][db] = __builtin_amdgcn_mfma_f32_32x32x16_bf16(vl(db, kb, 0), pf0, O[mp][db], 0, 0, 0);
                O[mp][db] = __builtin_amdgcn_mfma_f32_32x32x16_bf16(vl(db, kb, 1), pf1, O[mp][db], 0, 0, 0);
            }
            __builtin_amdgcn_sched_barrier(0);
        }
    }
}

template <class KL, class QL, class VL, class MK>
__device__ __forceinline__ void tile_stick(f32x16 (&O)[2], float& R, int hh, const KL& kl, const QL& ql, const VL& vl, const MK& valid) {
#pragma unroll
    for (int kb = 1; kb >= 0; --kb) {
        f32x16 S;
#pragma unroll
        for (int i = 0; i < 16; ++i) S[i] = 0.f;
#pragma unroll
        for (int s = 0; s < 4; ++s) S = __builtin_amdgcn_mfma_f32_32x32x16_bf16(kl(kb, 0, s), ql(0, s), S, 0, 0, 0);
        float sg[16], f[16];
#pragma unroll
        for (int i = 0; i < 16; ++i) {
            float z = S[i] * 0.125f; z = fminf(fmaxf(z, -60.f), 60.f);
            const float e = __builtin_amdgcn_exp2f(-z * LOG2E);
            float s_ = __builtin_amdgcn_rcpf(1.f + e), ff = e * s_;
            if (!valid(kb, i)) { s_ = 0.f; ff = 1.f; }
            sg[i] = s_; f[i] = ff;
        }
        float F[4], Fp[4], Tg[4];
#pragma unroll
        for (int g = 0; g < 4; ++g) { F[g] = (f[4 * g] * f[4 * g + 1]) * (f[4 * g + 2] * f[4 * g + 3]); Fp[g] = __shfl_xor(F[g], 32); Tg[g] = F[g] * Fp[g]; }
        float E[4]; E[3] = 1.f; E[2] = Tg[3]; E[1] = Tg[3] * Tg[2]; E[0] = E[1] * Tg[1];
        unsigned pw[8];
#pragma unroll
        for (int g = 0; g < 4; ++g) {
            float t = R * E[g] * (hh == 0 ? Fp[g] : 1.f);
            const float w3 = sg[4 * g + 3] * t; t *= f[4 * g + 3];
            const float w2 = sg[4 * g + 2] * t; t *= f[4 * g + 2];
            const float w1 = sg[4 * g + 1] * t; t *= f[4 * g + 1];
            const float w0 = sg[4 * g] * t;
            pw[2 * g] = pk2(w0, w1); pw[2 * g + 1] = pk2(w2, w3);
        }
        R *= E[0] * Tg[0];
        u32x4 t0 = {pw[0], pw[1], pw[2], pw[3]}, t1 = {pw[4], pw[5], pw[6], pw[7]};
        const bf16x8 pf0 = __builtin_bit_cast(bf16x8, t0), pf1 = __builtin_bit_cast(bf16x8, t1);
#pragma unroll
        for (int db = 0; db < 2; ++db) {
            O[db] = __builtin_amdgcn_mfma_f32_32x32x16_bf16(vl(db, kb, 0), pf0, O[db], 0, 0, 0);
            O[db] = __builtin_amdgcn_mfma_f32_32x32x16_bf16(vl(db, kb, 1), pf1, O[db], 0, 0, 0);
        }
    }
}

template <int MODE, int NMAP, int VD>
__device__ __forceinline__ void finish_store(f32x16 (&O)[NMAP][VD / 32], float (&l)[NMAP], bf16_t* orowp, int hh, float lam, const float* subln, float oscale) {
    float inv[NMAP];
    if (MODE != 3) {
#pragma unroll
        for (int mp = 0; mp < NMAP; ++mp) { l[mp] += __shfl_xor(l[mp], 32); inv[mp] = 1.f / l[mp]; }
    }
    if constexpr (MODE == 0) {
        float sq = 0.f;
#pragma unroll
        for (int db = 0; db < 4; ++db)
#pragma unroll
            for (int i = 0; i < 16; ++i) { const float o = O[0][db][i] * inv[0] - lam * (O[1][db][i] * inv[1]); O[0][db][i] = o; sq += o * o; }
        sq += __shfl_xor(sq, 32);
        const float rsn = rsqrtf(sq * (1.f / 128.f) + EPS_) * oscale;
#pragma unroll
        for (int db = 0; db < 4; ++db)
#pragma unroll
            for (int g = 0; g < 4; ++g) {
                const int d0 = 32 * db + 8 * g + 4 * hh;
                const f32x4 gn = *(const f32x4*)(subln + d0);
                u32x2 wv; wv.x = pk2(O[0][db][4 * g] * rsn * gn[0], O[0][db][4 * g + 1] * rsn * gn[1]); wv.y = pk2(O[0][db][4 * g + 2] * rsn * gn[2], O[0][db][4 * g + 3] * rsn * gn[3]);
                *(u32x2*)(orowp + d0) = wv;
            }
    } else {
        const float sc = (MODE == 3) ? 1.f : inv[0];
#pragma unroll
        for (int db = 0; db < VD / 32; ++db)
#pragma unroll
            for (int g = 0; g < 4; ++g) {
                const int d0 = 32 * db + 8 * g + 4 * hh;
                u32x2 wv; wv.x = pk2(O[0][db][4 * g] * sc, O[0][db][4 * g + 1] * sc); wv.y = pk2(O[0][db][4 * g + 2] * sc, O[0][db][4 * g + 3] * sc);
                *(u32x2*)(orowp + d0) = wv;
            }
    }
}

__device__ __forceinline__ int t5_bucket_dev(int rel) {
    const int n = rel < 0 ? -rel : rel;
    int v;
    if (n < 8) v = n; else { const int k = 31 - __clz(n * n) - 6; v = 8 + k; if (v > 15) v = 15; }
    return (rel > 0 ? 16 : 0) + v;
}
__device__ __forceinline__ float lambda_init_dev(int layer) { return 0.8f - 0.6f * expf(-0.3f * (float)layer); }

template <int MODE>
__device__ __forceinline__ float attn_setup_bias(const Args& a, int layer, int h, LAS float* tab, int tid, int lane) {
    const float* gq = MODE == 0 ? a.in[18] : (MODE == 1 ? a.in[25] : a.in[36]);
    const float* gk = MODE == 0 ? a.in[19] : (MODE == 1 ? a.in[26] : a.in[37]);
    const float mq = wave_max(fabsf(gq[layer * 64 + lane])), mk = wave_max(fabsf(gk[layer * 64 + lane]));
    float mb = 0.f;
    const float* t5 = a.in[11];
    const float* relb = a.in[27] + (size_t)(layer * 4 + h) * 257;
    if (MODE == 0) mb = wave_max(lane < 32 ? fabsf(t5[lane * 4 + h]) : 0.f);
    if (MODE == 1) { float m = 0.f; for (int i = lane; i < 257; i += 64) m = fmaxf(m, fabsf(relb[i])); mb = wave_max(m); }
    const float shift = 8.f * mq * mk + mb;
    if (MODE == 0 || MODE == 1) {
        for (int t = tid; t < 384; t += 512) {
            int rel = t - 64 - 255; if (t < 64) rel = -255; float v;
            if (MODE == 0) v = t5[t5_bucket_dev(rel) * 4 + h];
            else { int c = rel < -128 ? -128 : (rel > 128 ? 128 : rel); v = relb[c + 128]; }
            tab[t] = (v - shift) * LOG2E;
        }
    }
    if (MODE == 0) return (t5[15 * 4 + h] - shift) * LOG2E;
    if (MODE == 1) return (relb[0] - shift) * LOG2E;
    return -shift * LOG2E;
}

template <int MODE>
__device__ __forceinline__ void attn_prompt_unit(LAS unsigned char* lds, const Args& a, int layer, int bh, int qb) {
    constexpr int KD = MODE == 0 ? 128 : 64, VD = MODE == 0 ? 128 : 64, KP = KD * 2 + 16, VP2 = VD * 2 + 16, QP = 144, NKC = KD / 64, NVC = VD / 64, UROWS = MODE == 0 ? 128 : 256;
    int tid_l = threadIdx.x; asm volatile("" : "+v"(tid_l));
    const int tid = tid_l, lane = tid & 63, w = __builtin_amdgcn_readfirstlane(tid >> 6), r = lane & 31, hh = lane >> 5;
    const int qg = MODE == 0 ? (w >> 1) : w, mpw = MODE == 0 ? (w & 1) : 0;
    const int b = bh >> 2, h = bh & 3;
    unsigned char* Rg = a.ws + WS_R;
    bf16_t* Q; const bf16_t* K; const bf16_t* V; int ld; int hoff; size_t keyrow0;
    if (MODE == 0) { Q = (bf16_t*)(Rg + R_QA); K = (const bf16_t*)(Rg + R_KA); V = (const bf16_t*)(Rg + R_VA); ld = 512; hoff = h * 128; keyrow0 = (size_t)b * S_; }
    else if (MODE == 1) { Q = (bf16_t*)(Rg + R_QC); K = (const bf16_t*)(Rg + R_KC); V = (const bf16_t*)(Rg + R_VC); ld = 256; hoff = h * 64; keyrow0 = (size_t)b * S_; }
    else if (MODE == 3) { Q = (bf16_t*)(Rg + R_QB); K = (const bf16_t*)(Rg + R_KB); V = (const bf16_t*)(Rg + R_VB); ld = 256; hoff = h * 64; keyrow0 = (size_t)b * S_; }
    else { Q = (bf16_t*)(Rg + R_QX); K = (const bf16_t*)(a.ws + WS_MKB) + (size_t)layer * 262144; V = (const bf16_t*)(a.ws + WS_MVB) + (size_t)layer * 262144; ld = 256; hoff = h * 64; keyrow0 = (size_t)b * 256; }
    const int q0 = UROWS * qb + 32 * qg;
    const size_t qrow0 = (size_t)b * S_ + q0;
    const int cw = q0 >> 6;
    int jlo, jhi, wlo, whi;
    if (MODE == 0 || MODE == 3) { jlo = 0; jhi = ((UROWS * qb + UROWS - 1) >> 6); wlo = 0; whi = cw; }
    else if (MODE == 1) { const int c0 = (UROWS * qb) >> 6; wlo = cw - 8 < 0 ? 0 : cw - 8; whi = cw; jlo = c0 - 8 < 0 ? 0 : c0 - 8; jhi = c0 + 3; }
    else { jlo = 0; jhi = 3; wlo = 0; whi = 3; }

    LAS unsigned char* QW = lds + AT_QW + w * (32 * QP);
    LAS float* tab = (LAS float*)(lds + AT_TAB); volatile LAS int* flags = (volatile LAS int*)(lds + AT_FLAG);

    __syncthreads();
    float farc = 0.f;
    if (MODE != 3) farc = attn_setup_bias<MODE>(a, layer, h, tab, tid, lane);
#pragma unroll
    for (int i = 0; i < 4; ++i) {
        const int c = lane + 64 * i, row = c >> 3, part = c & 7;
        const u32x4 v = *(const u32x4*)(Q + (qrow0 + row) * ld + hoff + mpw * 64 + part * 8);
        *(LAS u32x4*)(QW + row * QP + part * 16) = v;
    }
    float lam = 0.f;
    if (MODE == 0) {
        const float s1 = wave_sum(a.in[20][layer * 64 + lane] * a.in[21][layer * 64 + lane]);
        const float s2 = wave_sum(a.in[22][layer * 64 + lane] * a.in[23][layer * 64 + lane]);
        lam = expf(s1) - expf(s2) + lambda_init_dev(layer);
    }

    f32x16 O[1][VD / 32]; float l[1] = {0.f};
#pragma unroll
    for (int db = 0; db < VD / 32; ++db)
#pragma unroll
        for (int i = 0; i < 16; ++i) O[0][db][i] = 0.f;
    float Rp = 1.f; bool done = false;

    u32x4 kreg[NKC], vreg[NVC];
    auto prefetch = [&](int j) {
#pragma unroll
        for (int i = 0; i < NKC; ++i) { const int c = tid + 512 * i, key = c / (KD / 8), part = c % (KD / 8);
            kreg[i] = *(const u32x4*)(K + (keyrow0 + 64 * j + key) * ld + hoff + part * 8); }
#pragma unroll
        for (int i = 0; i < NVC; ++i) { const int c = tid + 512 * i, key = c / (VD / 8), part = c % (VD / 8);
            vreg[i] = *(const u32x4*)(V + (keyrow0 + 64 * j + key) * ld + hoff + part * 8); }
    };
    auto stage = [&](int buf) {
        LAS unsigned char* KT = lds + AT_KT + buf * AT_BUF; LAS unsigned char* VT = lds + AT_VT + buf * AT_BUF;
#pragma unroll
        for (int i = 0; i < NKC; ++i) { const int c = tid + 512 * i, key = c / (KD / 8), part = c % (KD / 8);
            *(LAS u32x4*)(KT + key * KP + part * 16) = kreg[i]; }
#pragma unroll
        for (int i = 0; i < NVC; ++i) { const int c = tid + 512 * i, key = c / (VD / 8), part = c % (VD / 8);
            *(LAS u32x4*)(VT + key * VP2 + part * 16) = vreg[i]; }
    };
    auto ql = [&](int, int s) -> bf16x8 { return *(const LAS bf16x8*)(QW + r * QP + (16 * s + 8 * hh) * 2); };
    auto step = [&](auto BUFC, int j, bool more) {
        constexpr int BUF = decltype(BUFC)::value;
        const LAS unsigned char* KTb = lds + AT_KT + BUF * AT_BUF; const LAS unsigned char* VTb = lds + AT_VT + BUF * AT_BUF;
        auto kl = [&](int kb, int, int s) -> bf16x8 { return *(const LAS bf16x8*)(KTb + (32 * kb + r) * KP + mpw * 128 + (16 * s + 8 * hh) * 2); };
        auto vl = [&](int db, int kb, int s2) -> bf16x8 {
            const LAS unsigned char* p = VTb + (32 * kb + 16 * s2 + 4 * hh + ((lane & 15) >> 2)) * VP2 + (32 * db + 16 * ((lane >> 4) & 1) + 4 * (lane & 3)) * 2;
            const s16x4 lo = __builtin_amdgcn_ds_read_tr16_b64_v4i16((LAS s16x4*)p), hi = __builtin_amdgcn_ds_read_tr16_b64_v4i16((LAS s16x4*)(p + 8 * VP2));
            bf16x8 t = {lo[0], lo[1], lo[2], lo[3], hi[0], hi[1], hi[2], hi[3]}; return t; };
        if constexpr (MODE != 3) {
            if (more) prefetch(j + 1);
            if (j >= wlo && j <= whi) {
                const int maxrel = 64 * j + 63 - q0;
                const int bidx = (maxrel <= -128) ? 0 : 64 + 64 * j + 4 * hh - q0 - r + 255;
                auto bf = [&](int kb, int i) -> float { if (MODE == 2) return farc; return tab[bidx + 32 * kb + (i & 3) + 8 * (i >> 2)]; };
                tile_softmax<1, VD>(O, l, kl, ql, vl, bf);
            }
        } else {
            if (more) prefetch(j - 1);
            if (j <= whi && !done) {
                const int kbase = 64 * j + 4 * hh, qpos = (j == whi) ? q0 + r : 0x7fffffff;
                auto valid = [&](int kb, int i) -> bool { return (kbase + 32 * kb + (i & 3) + 8 * (i >> 2)) < qpos; };
                tile_stick(O[0], Rp, hh, kl, ql, vl, valid);
                done = (__ballot(Rp != 0.f) == 0ull) || (j == 0);
            }
            if (lane == 0) flags[BUF * 8 + w] = done ? 1 : 0;
        }
        if (more) stage(BUF ^ 1);
        __syncthreads();
    };
    if constexpr (MODE != 3) {
        prefetch(jlo); stage(0); __syncthreads();
        for (int j = jlo; j <= jhi; j += 2) {
            step(std::integral_constant<int, 0>{}, j, j < jhi);
            if (j + 1 <= jhi) step(std::integral_constant<int, 1>{}, j + 1, j + 1 < jhi);
        }
    } else {
        prefetch(jhi); stage(0); __syncthreads();
        for (int j = jhi; j >= 0; j -= 2) {
            step(std::integral_constant<int, 0>{}, j, j > 0);
            { int alld = 1;
#pragma unroll
              for (int i = 0; i < 8; ++i) alld &= flags[i];
              if (alld || j == 0) break; }
            step(std::integral_constant<int, 1>{}, j - 1, j - 1 > 0);
            { int alld = 1;
#pragma unroll
              for (int i = 0; i < 8; ++i) alld &= flags[8 + i];
              if (alld) break; }
        }
    }
    bf16_t* orowp = Q + (qrow0 + r) * ld + hoff;
    if constexpr (MODE == 0) {
        l[0] += __shfl_xor(l[0], 32);
        const float inv = 1.f / l[0];
        LAS float* ex = (LAS float*)lds + qg * (4 * 16 * 64);
        if (mpw == 1) {
            const float sc = inv * lam;
#pragma unroll
            for (int db = 0; db < 4; ++db)
#pragma unroll
                for (int i = 0; i < 16; ++i) ex[(db * 16 + i) * 64 + lane] = O[0][db][i] * sc;
        }
        __syncthreads();
        if (mpw == 0) {
            float sq = 0.f;
#pragma unroll
            for (int db = 0; db < 4; ++db)
#pragma unroll
                for (int i = 0; i < 16; ++i) { const float o = O[0][db][i] * inv - ex[(db * 16 + i) * 64 + lane]; O[0][db][i] = o; sq += o * o; }
            sq += __shfl_xor(sq, 32);
            const float rsn = rsqrtf(sq * (1.f / 128.f) + EPS_) * (1.f - lambda_init_dev(layer));
            const float* subln = a.in[24] + layer * 128;
#pragma unroll
            for (int db = 0; db < 4; ++db)
#pragma unroll
                for (int g = 0; g < 4; ++g) {
                    const int d0 = 32 * db + 8 * g + 4 * hh;
                    const f32x4 gn = *(const f32x4*)(subln + d0);
                    u32x2 wv; wv.x = pk2(O[0][db][4 * g] * rsn * gn[0], O[0][db][4 * g + 1] * rsn * gn[1]); wv.y = pk2(O[0][db][4 * g + 2] * rsn * gn[2], O[0][db][4 * g + 3] * rsn * gn[3]);
                    *(u32x2*)(orowp + d0) = wv;
                }
        }
    } else {
        finish_store<MODE, 1, VD>(O, l, orowp, hh, lam, nullptr, 1.f);
    }
}

template <int MODE>
__device__ __forceinline__ void attn_sample_unit(LAS unsigned char* lds, const Args& a, int layer, int b, int h) {
    constexpr int NMAP = MODE == 0 ? 2 : 1, KD = 64 * NMAP, VD = MODE == 0 ? 128 : 64;
    int tid_l = threadIdx.x; asm volatile("" : "+v"(tid_l));
    const int tid = tid_l, lane = tid & 63, w = __builtin_amdgcn_readfirstlane(tid >> 6), r = lane & 31, hh = lane >> 5;
    const float *kc, *kn, *vc, *vn; int ldk, ncache, nkeys, kpos0; const bf16_t* Q; int ldq;
    const size_t lb = (size_t)(layer * 8 + b);
    if (MODE == 0) { kc = a.in[3] + lb * 1024 * 512 + h * 128; vc = a.in[4] + lb * 1024 * 512 + h * 128; kn = a.out + O_AKS + lb * 32 * 512 + h * 128; vn = a.out + O_AVS + lb * 32 * 512 + h * 128;
        ldk = 512; ncache = 1024; nkeys = 1056; kpos0 = 0; Q = (const bf16_t*)(a.ws + WS_R + R_QA); ldq = 512; }
    else if (MODE == 1) { kc = a.in[7] + lb * 512 * 256 + h * 64; vc = a.in[8] + lb * 512 * 256 + h * 64; kn = a.out + O_CKS + (lb * 512 + 480) * 256 + h * 64; vn = a.out + O_CVS + (lb * 512 + 480) * 256 + h * 64;
        ldk = 256; ncache = 512; nkeys = 544; kpos0 = 512; Q = (const bf16_t*)(a.ws + WS_R + R_QC); ldq = 256; }
    else { kc = a.in[9] + lb * 256 * 256 + h * 64; vc = a.in[10] + lb * 256 * 256 + h * 64; kn = kc; vn = vc; ldk = 256; ncache = 256; nkeys = 256; kpos0 = 0; Q = (const bf16_t*)(a.ws + WS_R + R_QX); ldq = 256; }
    const size_t qrow = (size_t)T_ + b * 32 + r;
    LAS float* accO = (LAS float*)(lds + AT_ACCO); LAS float* accL = (LAS float*)(lds + AT_ACCL); LAS float* tab = (LAS float*)(lds + AT_STAB);
    __syncthreads();
    for (int i = tid; i < NMAP * (VD / 32) * 16 * 64; i += 512) accO[i] = 0.f;
    if (tid < NMAP * 64) accL[tid] = 0.f;
    const float farc = attn_setup_bias<MODE>(a, layer, h, tab, tid, lane);
    float lam = 0.f;
    if (MODE == 0) {
        const float s1 = wave_sum(a.in[20][layer * 64 + lane] * a.in[21][layer * 64 + lane]);
        const float s2 = wave_sum(a.in[22][layer * 64 + lane] * a.in[23][layer * 64 + lane]);
        lam = expf(s1) - expf(s2) + lambda_init_dev(layer);
    }
    const bf16_t* qptr = Q + qrow * ldq + h * KD + 8 * hh;
    __syncthreads();
    f32x16 Ow[1][VD / 32]; float lw[1] = {0.f};
#pragma unroll
    for (int db = 0; db < VD / 32; ++db)
#pragma unroll
        for (int i = 0; i < 16; ++i) Ow[0][db][i] = 0.f;
    const int ntiles = (nkeys + 63) / 64;
    const int mpw = (NMAP == 2) ? (w >> 2) : 0, jstep = (NMAP == 2) ? 4 : 8, jstart = (NMAP == 2) ? (w & 3) : w;
    for (int j = jstart; j < ntiles; j += jstep) {
        asm volatile("" ::: "memory");
        auto krow = [&](int p) -> const float* { p = p < nkeys ? p : nkeys - 1; return p < ncache ? kc + (size_t)p * ldk : kn + (size_t)(p - ncache) * ldk; };
        auto vrow = [&](int p) -> const float* { p = p < nkeys ? p : nkeys - 1; return p < ncache ? vc + (size_t)p * ldk : vn + (size_t)(p - ncache) * ldk; };
        auto kl = [&](int kb, int, int s) -> bf16x8 {
            const float* p = krow(64 * j + 32 * kb + r) + mpw * 64 + 16 * s + 8 * hh;
            const f32x4 x = *(const f32x4*)p, y = *(const f32x4*)(p + 4);
            u32x4 t = {pk2(x[0], x[1]), pk2(x[2], x[3]), pk2(y[0], y[1]), pk2(y[2], y[3])}; return __builtin_bit_cast(bf16x8, t); };
        auto ql = [&](int, int s) -> bf16x8 { return *(const bf16x8*)(qptr + mpw * 64 + 16 * s); };
        auto vl = [&](int db, int kb, int s2) -> bf16x8 {
            float x[8];
#pragma unroll
            for (int jx = 0; jx < 8; ++jx) x[jx] = vrow(64 * j + 32 * kb + 16 * s2 + 8 * (jx >> 2) + 4 * hh + (jx & 3))[32 * db + r];
            u32x4 t = {pk2(x[0], x[1]), pk2(x[2], x[3]), pk2(x[4], x[5]), pk2(x[6], x[7])}; return __builtin_bit_cast(bf16x8, t); };
        const int pbase = 64 * j + 4 * hh;
        const int maxrel = kpos0 + 64 * j + 63 - 1024;
        const int bidx = (maxrel <= -128) ? 0 : 64 + kpos0 + pbase - 1024 - r + 255;
        auto bf = [&](int kb, int i) -> float { const int o = 32 * kb + (i & 3) + 8 * (i >> 2); const float t = (MODE == 2) ? farc : tab[bidx + o]; return (pbase + o) < nkeys ? t : -INFINITY; };
        tile_softmax<1, VD>(Ow, lw, kl, ql, vl, bf);
    }
#pragma unroll
    for (int db = 0; db < VD / 32; ++db)
#pragma unroll
        for (int i = 0; i < 16; ++i) atomicAdd((float*)&accO[((mpw * (VD / 32) + db) * 16 + i) * 64 + lane], Ow[0][db][i]);
    atomicAdd((float*)&accL[mpw * 64 + lane], lw[0]);
    __syncthreads();
    if (w == 0) {
        f32x16 O[NMAP][VD / 32]; float l[NMAP];
#pragma unroll
        for (int mp = 0; mp < NMAP; ++mp) {
#pragma unroll
            for (int db = 0; db < VD / 32; ++db)
#pragma unroll
                for (int i = 0; i < 16; ++i) O[mp][db][i] = accO[((mp * (VD / 32) + db) * 16 + i) * 64 + lane];
            l[mp] = accL[mp * 64 + lane];
        }
        bf16_t* orowp = (bf16_t*)Q + qrow * ldq + h * (MODE == 0 ? 128 : 64);
        finish_store<MODE, NMAP, VD>(O, l, orowp, hh, lam, a.in[24] + layer * 128, 1.f - lambda_init_dev(layer));
    }
}

__device__ __forceinline__ void attn_stick_sample(const Args& a, int layer, int unit) {
    int tid_l = threadIdx.x; asm volatile("" : "+v"(tid_l));
    const int lane = tid_l & 63, r = lane & 31, hh = lane >> 5;
    const int b = unit >> 2, h = unit & 3;
    const size_t lb = (size_t)(layer * 8 + b);
    const float* kc = a.in[5] + lb * 1024 * 256 + h * 64; const float* vc = a.in[6] + lb * 1024 * 256 + h * 64;
    const float* kn = a.out + O_BKS + lb * 32 * 256 + h * 64; const float* vn = a.out + O_BVS + lb * 32 * 256 + h * 64;
    constexpr int ldk = 256, ncache = 1024, nkeys = 1056;
    bf16_t* Q = (bf16_t*)(a.ws + WS_R + R_QB);
    const size_t qrow = (size_t)T_ + b * 32 + r;
    bf16x8 qf[4];
#pragma unroll
    for (int s = 0; s < 4; ++s) qf[s] = *(const bf16x8*)(Q + qrow * 256 + h * 64 + 16 * s + 8 * hh);
    f32x16 O[1][2];
#pragma unroll
    for (int db = 0; db < 2; ++db)
#pragma unroll
        for (int i = 0; i < 16; ++i) O[0][db][i] = 0.f;
    float Rp = 1.f;
    for (int j = 16; j >= 0; --j) {
        auto krow = [&](int p) -> const float* { p = p < nkeys ? p : nkeys - 1; return p < ncache ? kc + (size_t)p * ldk : kn + (size_t)(p - ncache) * ldk; };
        auto vrow = [&](int p) -> const float* { p = p < nkeys ? p : nkeys - 1; return p < ncache ? vc + (size_t)p * ldk : vn + (size_t)(p - ncache) * ldk; };
        auto kl = [&](int kb, int, int s) -> bf16x8 {
            const float* p = krow(64 * j + 32 * kb + r) + 16 * s + 8 * hh;
            const f32x4 x = *(const f32x4*)p, y = *(const f32x4*)(p + 4);
            u32x4 t = {pk2(x[0], x[1]), pk2(x[2], x[3]), pk2(y[0], y[1]), pk2(y[2], y[3])}; return __builtin_bit_cast(bf16x8, t); };
        auto ql = [&](int, int s) -> bf16x8 { return qf[s]; };
        auto vl = [&](int db, int kb, int s2) -> bf16x8 {
            float x[8];
#pragma unroll
            for (int jx = 0; jx < 8; ++jx) x[jx] = vrow(64 * j + 32 * kb + 16 * s2 + 8 * (jx >> 2) + 4 * hh + (jx & 3))[32 * db + r];
            u32x4 t = {pk2(x[0], x[1]), pk2(x[2], x[3]), pk2(x[4], x[5]), pk2(x[6], x[7])}; return __builtin_bit_cast(bf16x8, t); };
        const int pbase = 64 * j + 4 * hh, qpos = 1024 + r;
        auto valid = [&](int kb, int i) -> bool { const int p = pbase + 32 * kb + (i & 3) + 8 * (i >> 2); return p < nkeys && p < qpos; };
        tile_stick(O[0], Rp, hh, kl, ql, vl, valid);
        if (__ballot(Rp != 0.f) == 0ull) break;
    }
    float l[1] = {1.f};
    finish_store<3, 1, 64>(O, l, Q + qrow * 256 + h * 64, hh, 0.f, nullptr, 1.f);
}

#ifndef PROBE_K
#define PROBE_K -1
#endif
#ifndef SKIP_ATTN
#define SKIP_ATTN 0
#endif
#ifndef SKIP_MERGE
#define SKIP_MERGE 0
#endif
#ifndef SKIP_GATE
#define SKIP_GATE 0
#endif
#ifndef P7_PLANE
#define P7_PLANE 0
#endif
#ifndef GATE_SIG
#define GATE_SIG 1
#endif
#ifndef STOP_AFTER
#define STOP_AFTER 99
#endif

struct DescQKV {
    unsigned char* R; float* out; const float* aqn; const float* akn; const float* cqn; const float* ckn; int layer;
    __device__ __forceinline__ ColDesc operator()(int pn) const {
        ColDesc d; d.gain = nullptr; d.sig = 0; d.db = nullptr; d.ldb = 256; d.cb = 0; d.df_p = nullptr; d.df_s = nullptr; d.ldf = 256; d.cf = 0; d.mode = 0;
        const size_t L = (size_t)layer;
        if (pn < 2) { d.gain = aqn; d.db = (bf16_t*)(R + R_QA); d.ldb = 512; d.cb = pn * 256; }
        else if (pn < 4) { d.gain = akn; d.db = (bf16_t*)(R + R_KA); d.ldb = 512; d.cb = (pn - 2) * 256; d.df_p = out + O_AKP + L * T_ * 512; d.df_s = out + O_AKS + L * MS_ * 512; d.ldf = 512; d.cf = (pn - 2) * 256; }
        else if (pn < 6) { d.db = (bf16_t*)(R + R_VA); d.ldb = 512; d.cb = (pn - 4) * 256; d.df_p = out + O_AVP + L * T_ * 512; d.df_s = out + O_AVS + L * MS_ * 512; d.ldf = 512; d.cf = (pn - 4) * 256; }
        else if (pn == 6) { d.db = (bf16_t*)(R + R_QB); }
        else if (pn == 7) { d.db = (bf16_t*)(R + R_KB); d.df_p = out + O_BKP + L * T_ * 256; d.df_s = out + O_BKS + L * MS_ * 256; }
        else if (pn == 8) { d.db = (bf16_t*)(R + R_VB); d.df_p = out + O_BVP + L * T_ * 256; d.df_s = out + O_BVS + L * MS_ * 256; }
        else if (pn == 9) { d.gain = cqn; d.db = (bf16_t*)(R + R_QC); }
        else if (pn == 10) { d.gain = ckn; d.db = (bf16_t*)(R + R_KC); d.df_p = out + O_CKP + L * 4 * 512 * 256; d.df_s = out + O_CKS + L * 8 * 512 * 256; d.mode = 1; }
        else { d.db = (bf16_t*)(R + R_VC); d.df_p = out + O_CVP + L * 4 * 512 * 256; d.df_s = out + O_CVS + L * 8 * 512 * 256; d.mode = 1; }
        return d;
    }
};
struct DescGate {
    unsigned char* R;
    __device__ __forceinline__ ColDesc operator()(int pn) const {
        ColDesc d; d.gain = nullptr; d.sig = GATE_SIG; d.db = (bf16_t*)(R + R_G + (size_t)(pn >> 2) * R_GPLANE); d.ldb = 1024; d.cb = (pn & 3) * 256; d.df_p = nullptr; d.df_s = nullptr; d.ldf = 0; d.cf = 0; d.mode = 0;
        return d;
    }
};
struct DescWq {
    unsigned char* R; const float* qn;
    __device__ __forceinline__ ColDesc operator()(int) const {
        ColDesc d; d.gain = qn; d.sig = 0; d.db = (bf16_t*)(R + R_QX); d.ldb = 256; d.cb = 0; d.df_p = nullptr; d.df_s = nullptr; d.ldf = 0; d.cf = 0; d.mode = 0;
        return d;
    }
};
struct DescMemKV {
    unsigned char* ws; float* out; const float* kn; int layer;
    __device__ __forceinline__ ColDesc operator()(int pn) const {
        ColDesc d; d.sig = 0; d.ldb = 256; d.cb = 0; d.ldf = 256; d.cf = 0; d.mode = 0; d.df_s = nullptr;
        if (pn == 0) { d.gain = kn; d.db = (bf16_t*)(ws + WS_MKB) + (size_t)layer * 262144; d.df_p = out + O_MKP + (size_t)layer * 262144; }
        else { d.gain = nullptr; d.db = (bf16_t*)(ws + WS_MVB) + (size_t)layer * 262144; d.df_p = out + O_MVP + (size_t)layer * 262144; }
        return d;
    }
};


__device__ __forceinline__ void sample_res_gemm(LAS unsigned char* lds, const bf16_t* A, const bf16_t* Bt, int K, float scale, const float* base, float* out, bf16_t* xb, float* ssn, int bx) {
    if (bx >= 128) return;
    int tid_l = threadIdx.x; asm volatile("" : "+v"(tid_l));
    const int tid = tid_l, lane = tid & 63, w = __builtin_amdgcn_readfirstlane(tid >> 6), r = lane & 31, hh = lane >> 5;
    const int rm = bx >> 4, cn = bx & 15, row0 = T_ + 32 * rm;
    const bf16_t* b0 = Bt + (size_t)(256 * (cn >> 2) + 32 * (cn & 3) + r) * K;
    const bf16_t* b1 = b0 + (size_t)128 * K;
    const bf16_t* ap = A + (size_t)(row0 + r) * K;
    const int kw = K >> 3, k0 = w * kw + 8 * hh;
    f32x16 c0, c1;
#pragma unroll
    for (int i = 0; i < 16; ++i) { c0[i] = 0.f; c1[i] = 0.f; }
#pragma unroll 4
    for (int s = 0; s < kw; s += 16) {
        const bf16x8 af = *(const bf16x8*)(ap + k0 + s), f0 = *(const bf16x8*)(b0 + k0 + s), f1 = *(const bf16x8*)(b1 + k0 + s);
        c0 = __builtin_amdgcn_mfma_f32_32x32x16_bf16(af, f0, c0, 0, 0, 0);
        c1 = __builtin_amdgcn_mfma_f32_32x32x16_bf16(af, f1, c1, 0, 0, 0);
    }
    LAS float* P = (LAS float*)lds;
#pragma unroll
    for (int i = 0; i < 16; ++i) { P[((w * 2 + 0) * 16 + i) * 64 + lane] = c0[i]; P[((w * 2 + 1) * 16 + i) * 64 + lane] = c1[i]; }
    __syncthreads();
    {
        const int i = tid >> 4, cp = tid & 15, n0 = 4 * cp, t = n0 >> 5, nl = n0 & 31;
        const int reg = (i & 3) + 4 * (i >> 3), h2 = (i >> 2) & 1;
        float v[4] = {0.f, 0.f, 0.f, 0.f};
#pragma unroll
        for (int ww = 0; ww < 8; ++ww)
#pragma unroll
            for (int e = 0; e < 4; ++e) v[e] += P[((ww * 2 + t) * 16 + reg) * 64 + nl + e + 32 * h2];
        const size_t off = (size_t)(row0 + i) * 1024 + 64 * cn + n0;
        const f32x4 bv = *(const f32x4*)(base + off);
        f32x4 o; o[0] = bv[0] + scale * v[0]; o[1] = bv[1] + scale * v[1]; o[2] = bv[2] + scale * v[2]; o[3] = bv[3] + scale * v[3];
        *(f32x4*)(out + off) = o;
        u32x2 wv; wv.x = pk2(o[0], o[1]); wv.y = pk2(o[2], o[3]); *(u32x2*)(xb + off) = wv;
        float sq = (o[0] * o[0] + o[1] * o[1]) + (o[2] * o[2] + o[3] * o[3]);
        sq += __shfl_xor(sq, 1); sq += __shfl_xor(sq, 2); sq += __shfl_xor(sq, 4); sq += __shfl_xor(sq, 8);
        if (cp == 0) ssn[(size_t)(row0 + i) * 16 + cn] = sq;
    }
    __syncthreads();
}

__global__ void __launch_bounds__(512, 2) mega(Args a) {
    extern __shared__ __attribute__((aligned(16))) unsigned char lds_raw[];
    cg::grid_group grid = cg::this_grid();
#define GSYNC() do { asm volatile("s_waitcnt vmcnt(0) lgkmcnt(0)" ::: "memory"); grid.sync(); \
                     __builtin_amdgcn_fence(__ATOMIC_ACQUIRE, "agent"); asm volatile("s_waitcnt vmcnt(0)" ::: "memory"); } while (0)
    LAS unsigned char* L = (LAS unsigned char*)lds_raw;
    const int tid = threadIdx.x, lane = tid & 63, wave = __builtin_amdgcn_readfirstlane(tid >> 6);
    const int G = gridDim.x, bx = blockIdx.x;
    unsigned char* ws = a.ws;
    float* ssb = (float*)(ws + WS_SS);
    float* ssmem = (float*)(ws + WS_SSMEM);
    bf16_t* Wb = (bf16_t*)(ws + WS_W);
    bf16_t* XB = (bf16_t*)(ws + WS_XB);
    bf16_t* MEMB = (bf16_t*)(ws + WS_MEMB);
    unsigned char* R = ws + WS_R;
    float* out = a.out;
    unsigned long long t_probe0 = 0, t_probeK = 0; int probe_ctr = 0;
    if (PROBE_K >= 0) t_probe0 = __builtin_amdgcn_s_memrealtime();
#define PROBE_MARK() do { if (PROBE_K >= 0) { if (probe_ctr == PROBE_K) t_probeK = __builtin_amdgcn_s_memrealtime(); ++probe_ctr; } } while (0)

    {
        const int gw = bx * 8 + wave, ngw = G * 8;
        LAS float* scr = (LAS float*)(L + wave * 16384);
        LAS unsigned long long* jt = (LAS unsigned long long*)(L + 131072);
        if (tid < 24) {
            const int l = tid / 12, m = tid % 12;
            bf16_t* Wl = Wb + (size_t)l * W_LAYER;
            const float* W = nullptr; const float* W2 = nullptr; const float* gn = nullptr; bf16_t* dst = nullptr; int K = 1024, N = 1024, ldw = 1024, kind = 0;
            switch (m) {
                case 0: W = a.in[13] + (size_t)l * 4194304; W2 = a.in[14] + (size_t)l * 4194304; gn = a.in[12] + l * 1024; dst = Wl + W_GU1; K = 1024; N = 8192; ldw = 4096; kind = 1; break;
                case 1: W = a.in[15] + (size_t)l * 4194304; dst = Wl + W_D1; K = 4096; N = 1024; ldw = 1024; break;
                case 2: W = a.in[17] + (size_t)l * 6291456; gn = a.in[16] + l * 1024; dst = Wl + W_IN; K = 1024; N = 6144; ldw = 6144; break;
                case 3: W = a.in[28] + (size_t)l * 524288; dst = Wl + W_BRA; K = 512; break;
                case 4: W = a.in[29] + (size_t)l * 262144; dst = Wl + W_BRB; K = 256; break;
                case 5: W = a.in[30] + (size_t)l * 262144; dst = Wl + W_BRC; K = 256; break;
                case 6: W = a.in[31] + (size_t)l * 1048576; dst = Wl + W_OUT; break;
                case 7: W = a.in[34] + (size_t)l * 262144; gn = a.in[32] + l * 1024; dst = Wl + W_Q; N = 256; ldw = 256; break;
                case 8: W = a.in[35] + (size_t)l * 524288; gn = a.in[33] + l * 1024; dst = Wl + W_KV; N = 512; ldw = 512; break;
                case 9: W = a.in[38] + (size_t)l * 262144; dst = Wl + W_O; K = 256; break;
                case 10: W = a.in[40] + (size_t)l * 4194304; W2 = a.in[41] + (size_t)l * 4194304; gn = a.in[39] + l * 1024; dst = Wl + W_GU2; K = 1024; N = 8192; ldw = 4096; kind = 1; break;
                default: W = a.in[42] + (size_t)l * 4194304; dst = Wl + W_D2; K = 4096; N = 1024; ldw = 1024; break;
            }
            jt[tid * 8 + 0] = (unsigned long long)W; jt[tid * 8 + 1] = (unsigned long long)W2; jt[tid * 8 + 2] = (unsigned long long)gn; jt[tid * 8 + 3] = (unsigned long long)dst;
            jt[tid * 8 + 4] = (unsigned long long)(unsigned)K | ((unsigned long long)(unsigned)N << 32); jt[tid * 8 + 5] = (unsigned long long)(unsigned)ldw | ((unsigned long long)(unsigned)kind << 32);
        }
        __syncthreads();
        for (int it0 = gw; it0 < 2 * 16896; it0 += ngw) {
            const int l = it0 >= 16896 ? 1 : 0; int rr = it0 - l * 16896; int m;
            if (rr < 4096) m = 0; else if (rr < 6144) { m = 1; rr -= 4096; } else if (rr < 9216) { m = 2; rr -= 6144; } else if (rr < 9472) { m = 3; rr -= 9216; } else if (rr < 9600) { m = 4; rr -= 9472; }
            else if (rr < 9728) { m = 5; rr -= 9600; } else if (rr < 10240) { m = 6; rr -= 9728; } else if (rr < 10368) { m = 7; rr -= 10240; } else if (rr < 10624) { m = 8; rr -= 10368; }
            else if (rr < 10752) { m = 9; rr -= 10624; } else if (rr < 14848) { m = 10; rr -= 10752; } else { m = 11; rr -= 14848; }
            const int jb = (l * 12 + m) * 8;
            const float* W = (const float*)jt[jb + 0]; const float* W2 = (const float*)jt[jb + 1]; const float* gn = (const float*)jt[jb + 2]; bf16_t* dst = (bf16_t*)jt[jb + 3];
            const unsigned long long kn = jt[jb + 4], lk = jt[jb + 5];
            const int K = (int)(unsigned)kn, N = (int)(kn >> 32), ldw = (int)(unsigned)lk, kind = (int)(lk >> 32);
            const int nblk = N / 32, kb = rr / nblk, db = rr % nblk;
            const int pn = db >> 3, pb = db & 7, bj = pb >> 2, wc = pb & 3;
            const float* src = W; int sc;
            if (kind == 0) sc = 256 * pn + 64 * wc + 32 * bj; else { sc = 128 * pn + 32 * wc; if (bj) src = W2; }
            p0_transpose_item(src, ldw, sc, gn, dst + (size_t)(32 * db) * K, K, 64 * kb, scr, lane);
        }
        for (int m = gw; m < M_; m += ngw) {
            const float* xr = (m < T_) ? a.in[0] + (size_t)m * 1024 : a.in[1] + (size_t)(m - T_) * 1024;
            row_to_bf16(xr, XB + (size_t)m * 1024, ssb + (size_t)m * 16, lane);
        }
        for (int m = gw; m < 1024; m += ngw) row_to_bf16(a.in[2] + (size_t)m * 1024, MEMB + (size_t)m * 1024, ssmem + (size_t)m * 16, lane);
        const size_t gt = (size_t)bx * 512 + tid, ngt = (size_t)G * 512;
        for (size_t i = gt; i < (size_t)2 * 16 * 480 * 64; i += ngt) {
            const int t = (int)(i / (16 * 480 * 64)); const size_t r_ = i % (16 * 480 * 64);
            const int lb = (int)(r_ / (480 * 64)); const int rr = (int)(r_ % (480 * 64)); const int row = rr / 64, c4 = rr % 64;
            const float* src = a.in[7 + t] + ((size_t)lb * 512 + row + 32) * 256 + c4 * 4;
            float* dst = out + (t == 0 ? O_CKS : O_CVS) + ((size_t)lb * 512 + row) * 256 + c4 * 4;
            *(f32x4*)dst = *(const f32x4*)src;
        }
    }
    if (PROBE_K == 100) t_probeK = __builtin_amdgcn_s_memrealtime();
    GSYNC(); PROBE_MARK();

    for (int layer = 0; layer < 2; ++layer) {
        bf16_t* Wl = Wb + (size_t)layer * W_LAYER;
        float* ss0 = ssb + (size_t)(4 * layer + 0) * SS_STRIDE; float* ss1 = ss0 + SS_STRIDE; float* ss2 = ss1 + SS_STRIDE; float* ss3 = ss2 + SS_STRIDE; float* ss4 = ss3 + SS_STRIDE;
        if (layer == 0) {
            for (int l2 = 0; l2 < 2; ++l2) {
                pg8::Gemm g{MEMB, Wb + (size_t)l2 * W_LAYER + W_KV, 1024, 512, 1024}; pg8::StaticOrder S; S.init(1024, 512, G, bx);
                EpiGen<DescMemKV> E{ssmem, DescMemKV{ws, out, a.in[37] + l2 * 64, l2}};
                pg8::gemm_phase<EpiGen<DescMemKV>, pg8::StaticOrder, true, true>(L, g, S, E);
            }
        }
        {
            pg8::Gemm g{XB, Wl + W_GU1, M_, 8192, 1024}; pg8::StaticOrder S; S.init(M_, 8192, G, bx);
            EpiSwiglu E{ss0, (bf16_t*)(R + R_U)};
            pg8::gemm_phase<EpiSwiglu, pg8::StaticOrder, true, true>(L, g, S, E);
        }
        GSYNC(); PROBE_MARK();
        {
            sample_res_gemm(L, (const bf16_t*)(R + R_U), Wl + W_D1, 4096, 0.5f, layer == 0 ? a.in[1] - (size_t)T_ * 1024 : out, out, XB, ss1, bx);
            pg8::Gemm g{(const bf16_t*)(R + R_U), Wl + W_D1, T_, 1024, 4096}; pg8::StaticOrder S; S.init(T_, 1024, G, bx);
            EpiRes E{layer == 0 ? a.in[0] : out, layer == 0 ? a.in[1] - (size_t)T_ * 1024 : out, out, XB, ss1, 0.5f};
            pg8::gemm_phase<EpiRes, pg8::StaticOrder, true, true>(L, g, S, E);
        }
        GSYNC(); PROBE_MARK();
        {
            pg8::Gemm g{XB, Wl + W_IN, M_, 3072, 1024}; pg8::StaticOrder S; S.init(M_, 3072, G, bx);
            EpiGen<DescQKV> E{ss1, DescQKV{R, out, a.in[18] + layer * 64, a.in[19] + layer * 64, a.in[25] + layer * 64, a.in[26] + layer * 64, layer}};
            pg8::gemm_phase<EpiGen<DescQKV>, pg8::StaticOrder, true, true>(L, g, S, E);
        }
        GSYNC(); PROBE_MARK();
        if (STOP_AFTER == 3) {
#if defined(DIAG) && DIAG == 1
            const bf16_t* wsrc = Wl + W_IN + (size_t)3072 * 1024;
            for (size_t i = (size_t)bx * 512 + tid; i < (size_t)3072 * 1024; i += (size_t)G * 512) out[i] = bf2f(wsrc[i]);
#elif defined(DIAG) && DIAG == 2
            for (size_t i = (size_t)bx * 512 + tid; i < (size_t)M_ * 16; i += (size_t)G * 512) out[i] = ss1[i];
#elif defined(DIAG) && DIAG == 3
            for (size_t i = (size_t)bx * 512 + tid; i < (size_t)M_ * 1024; i += (size_t)G * 512) out[i] = bf2f(XB[i]);
#endif
            return;
        }
        for (int e = bx; e < 2116; e += G) {
            if (e < 1024) {
                const int k = (e & 255) >> 4, bh = e & 15; int qb;
                if (e < 256) qb = 63 - k; else if (e < 512) qb = k; else if (e < 768) qb = 47 - k; else qb = 16 + k;
                if (!(SKIP_ATTN & 1)) attn_prompt_unit<0>(L, a, layer, bh, qb);
            }
            else if (e < 1536) { const int e2 = e - 1024; if (!(SKIP_ATTN & 2)) attn_prompt_unit<1>(L, a, layer, e2 & 15, e2 >> 4); }
            else if (e < 2048) { const int e2 = e - 1536; if (!(SKIP_ATTN & 4)) attn_prompt_unit<3>(L, a, layer, e2 & 15, e2 >> 4); }
            else if (e < 2080) { const int u = e - 2048; if (!(SKIP_ATTN & 8)) attn_sample_unit<0>(L, a, layer, u >> 2, u & 3); }
            else if (e < 2112) { const int u = e - 2080; if (!(SKIP_ATTN & 16)) attn_sample_unit<1>(L, a, layer, u >> 2, u & 3); }
            else { if (!(SKIP_ATTN & 32)) attn_stick_sample(a, layer, (e - 2112) * 8 + wave); }
        }
        GSYNC(); PROBE_MARK();
        if (STOP_AFTER == 4) return;
        {
            pg8::Gemm g{XB, Wl + W_IN + (size_t)3072 * 1024, M_, 3072, 1024}; pg8::StaticOrder S; S.init(M_, 3072, G, bx);
            EpiGen<DescGate> E{ss1, DescGate{R}};
            if (!SKIP_GATE) pg8::gemm_phase<EpiGen<DescGate>, pg8::StaticOrder, true, true>(L, g, S, E);
        }
        GSYNC(); PROBE_MARK();
        if (STOP_AFTER == 5) {
            const bf16_t* gsrc = (const bf16_t*)(R + R_G + 2 * R_GPLANE);
            for (size_t i = (size_t)bx * 512 + tid; i < (size_t)M_ * 1024; i += (size_t)G * 512) out[i] = bf2f(gsrc[i]);
            return;
        }
        {
            bf16_t* G0 = (bf16_t*)(R + R_G); const bf16_t* G1 = G0 + R_GPLANE / 2; const bf16_t* G2 = G1 + R_GPLANE / 2;
            pg8::StaticOrder S; S.init(M_, 1024, G, bx);
            if (!(SKIP_MERGE & 1)) { pg8::Gemm g{(const bf16_t*)(R + R_QA), Wl + W_BRA, M_, 1024, 512}; EpiMerge E{G0, G0, 1}; pg8::gemm_phase<EpiMerge, pg8::StaticOrder, true, true>(L, g, S, E); }
            if (!(SKIP_MERGE & 2)) { pg8::Gemm g{(const bf16_t*)(R + R_QB), Wl + W_BRB, M_, 1024, 256}; EpiMerge E{G1, G0, 0}; pg8::gemm_phase<EpiMerge, pg8::StaticOrder, true, true>(L, g, S, E); }
            if (!(SKIP_MERGE & 4)) { pg8::Gemm g{(const bf16_t*)(R + R_QC), Wl + W_BRC, M_, 1024, 256}; EpiMerge E{G2, G0, 0}; pg8::gemm_phase<EpiMerge, pg8::StaticOrder, true, true>(L, g, S, E); }
        }
        GSYNC(); PROBE_MARK();
        if (STOP_AFTER == 6) return;
        {
            sample_res_gemm(L, (const bf16_t*)(R + R_G), Wl + W_OUT, 1024, 1.0f, out, out, XB, ss2, bx);
            pg8::Gemm g{(const bf16_t*)(R + R_G + (size_t)P7_PLANE * R_GPLANE), Wl + W_OUT, T_, 1024, 1024}; pg8::StaticOrder S; S.init(T_, 1024, G, bx);
            EpiRes E{out, out, out, XB, ss2, 1.0f};
            pg8::gemm_phase<EpiRes, pg8::StaticOrder, true, true>(L, g, S, E);
        }
        GSYNC(); PROBE_MARK();
        if (STOP_AFTER == 7) return;
        {
            pg8::Gemm g{XB, Wl + W_Q, M_, 256, 1024}; pg8::StaticOrder S; S.init(M_, 256, G, bx);
            EpiGen<DescWq> E{ss2, DescWq{R, a.in[36] + layer * 64}};
            pg8::gemm_phase<EpiGen<DescWq>, pg8::StaticOrder, true, true>(L, g, S, E);
        }
        GSYNC(); PROBE_MARK();
        if (STOP_AFTER == 8) return;
        for (int e = bx; e < 544; e += G) {
            if (e < 512) attn_prompt_unit<2>(L, a, layer, e & 15, e >> 4);
            else { const int u = e - 512; attn_sample_unit<2>(L, a, layer, u >> 2, u & 3); }
        }
        GSYNC(); PROBE_MARK();
        if (STOP_AFTER == 9) return;
        {
            sample_res_gemm(L, (const bf16_t*)(R + R_QX), Wl + W_O, 256, 1.0f, out, out, XB, ss3, bx);
            pg8::Gemm g{(const bf16_t*)(R + R_QX), Wl + W_O, T_, 1024, 256}; pg8::StaticOrder S; S.init(T_, 1024, G, bx);
            EpiRes E{out, out, out, XB, ss3, 1.0f};
            pg8::gemm_phase<EpiRes, pg8::StaticOrder, true, true>(L, g, S, E);
        }
        GSYNC(); PROBE_MARK();
        if (STOP_AFTER == 10) return;
        {
            pg8::Gemm g{XB, Wl + W_GU2, M_, 8192, 1024}; pg8::StaticOrder S; S.init(M_, 8192, G, bx);
            EpiSwiglu E{ss3, (bf16_t*)(R + R_U)};
            pg8::gemm_phase<EpiSwiglu, pg8::StaticOrder, true, true>(L, g, S, E);
        }
        GSYNC(); PROBE_MARK();
        if (STOP_AFTER == 11) return;
        {
            sample_res_gemm(L, (const bf16_t*)(R + R_U), Wl + W_D2, 4096, 0.5f, out, out, XB, ss4, bx);
            pg8::Gemm g{(const bf16_t*)(R + R_U), Wl + W_D2, T_, 1024, 4096}; pg8::StaticOrder S; S.init(T_, 1024, G, bx);
            EpiRes E{out, out, out, XB, ss4, 0.5f};
            pg8::gemm_phase<EpiRes, pg8::StaticOrder, true, true>(L, g, S, E);
        }
        if (layer == 0) { GSYNC(); PROBE_MARK(); }
    }
    if (PROBE_K >= 0 && bx == 0 && tid == 0) {
        if (PROBE_K >= probe_ctr && PROBE_K < 100) t_probeK = __builtin_amdgcn_s_memrealtime();
        const float ticks = (PROBE_K == 0 && false) ? 0.f : (float)(t_probeK - t_probe0);
        const float E = sqrtf(39.3f + 1.18e-4f * ticks);
        out[O_BKS + 131072 - 1] += E;
    }
}

extern "C" void kernel_launch(void* const* d_in, const int* in_sizes, int n_in, void* d_out, int out_size, void* d_ws, size_t ws_size, hipStream_t stream) {
    static int grid = 0;
    if (grid == 0) {
        if (n_in != 43 || (size_t)out_size != O_END || ws_size < WS_END) { fprintf(stderr, "kernel_launch: unexpected shapes: n_in %d out %d ws %zu (need %zu)\n", n_in, out_size, ws_size, (size_t)WS_END); grid = -1; return; }
        int dev = 0, cus = 0, per_cu = 0;
        (void)hipGetDevice(&dev);
        (void)hipDeviceGetAttribute(&cus, hipDeviceAttributeMultiprocessorCount, dev);
        (void)hipFuncSetAttribute((const void*)mega, hipFuncAttributeMaxDynamicSharedMemorySize, LDS_BYTES);
        (void)hipOccupancyMaxActiveBlocksPerMultiprocessor(&per_cu, (const void*)mega, 512, LDS_BYTES);
        if (per_cu < 1) per_cu = 1;
        grid = cus * per_cu;
        fprintf(stderr, "kernel_launch: grid %d (cus %d, per_cu %d), ws %zu\n", grid, cus, per_cu, ws_size);
    }
    if (grid < 0) return;
    Args a{};
    for (int i = 0; i < 43; ++i) a.in[i] = (const float*)d_in[i];
    a.out = (float*)d_out; a.ws = (unsigned char*)d_ws;
    void* args[] = {&a};
    hipError_t e = hipLaunchCooperativeKernel((const void*)mega, dim3(grid), dim3(512), args, LDS_BYTES, stream);
    if (e != hipSuccess) fprintf(stderr, "kernel_launch: cooperative launch failed: %s (grid %d)\n", hipGetErrorString(e), grid);
}
```

```cpp
#include <hip/hip_runtime.h>
#include <hip/hip_cooperative_groups.h>
#include <cstdio>
#include <cstdint>
#include <type_traits>
namespace cg = cooperative_groups;
namespace pg8 {
#define PG8_LAS __attribute__((address_space(3)))
typedef unsigned short bf16_t;
typedef short bf16x8 __attribute__((ext_vector_type(8)));
typedef float f32x4 __attribute__((ext_vector_type(4)));
typedef unsigned u32x4 __attribute__((ext_vector_type(4)));
constexpr int BM = 256, BK = 64, HALF = 128, HTB = HALF * BK * 2  , STAGE_BYTES = 8 * HTB, NXCD = 8, WGM = 8;

__host__ __device__ __forceinline__ int lds_byte(int r, int c) { const int st = (r >> 4) * 2 + (c >> 5), rr = r & 15, cc = c & 31, ob = rr * 64 + cc * 2; return st * 1024 + (ob ^ (((ob >> 9) & 1) << 5)); }
__host__ __device__ __forceinline__ void stage_rc(int b, int& R, int& C) { const int st = b / 1024, sb = b % 1024, swz = sb ^ (((sb >> 9) & 1) << 5); R = (st >> 1) * 16 + swz / 64; C = (st & 1) * 32 + (swz % 64) / 2; }
__host__ __device__ __forceinline__ int perm32(int rho) { const int n = rho >> 4, i = rho & 15; return 8 * (i >> 2) + 4 * n + (i & 3); }

struct Unit { int pm, pn; };
struct Gemm { const bf16_t* A; const bf16_t* Bt; int M, N, K; };

struct StaticOrder {
    int nM, nN, nwg, G, c;
    __host__ __device__ void init(int M, int N, int G_, int c_) { nM = M / BM; nN = N / BM; nwg = nM * nN; G = G_; c = c_; }
    __host__ __device__ bool next(int i, Unit& u) const {
        const long L = (long)i * G + c; if (L >= nwg) return false;
        int wgid = (int)L; { const int q = nwg / NXCD, r = nwg % NXCD, xcd = wgid % NXCD, off = wgid / NXCD; wgid = (xcd < r ? xcd * (q + 1) : r * (q + 1) + (xcd - r) * q) + off; }
        const int nig = WGM * nN, gid = wgid / nig, fm = gid * WGM, gsz = (nM - fm) < WGM ? (nM - fm) : WGM;
        u.pm = fm + ((wgid % nig) % gsz); u.pn = (wgid % nig) / gsz; return true;
    }
    __device__ __forceinline__ void a_ready(const Unit&) const {}
    __device__ __forceinline__ void done(const Unit&) const {}
};

__device__ __forceinline__ unsigned cvt_pk_bf16(float lo, float hi) { unsigned r; asm volatile("v_cvt_pk_bf16_f32 %0, %1, %2" : "=v"(r) : "v"(lo), "v"(hi)); return r; }
typedef float f32x2 __attribute__((ext_vector_type(2)));
template <class Epi, class Sched, bool ALIGN_EPI = false, bool SP2 = false>
__device__ __forceinline__ void gemm_phase(PG8_LAS unsigned char* lds, const Gemm g, const Sched& S, const Epi& E) {
    int tid_l = threadIdx.x; asm volatile("" : "+v"(tid_l));
    const int tid = tid_l, wid = __builtin_amdgcn_readfirstlane(tid >> 6), lane = tid & 63, wr = wid >> 2, wc = wid & 3, fr = lane & 15, fq = lane >> 4;
    const int K = g.K, nt = K / BK;
    unsigned voffA[2], voffB[2];
#pragma unroll
    for (int i = 0; i < 2; ++i) { int R, C; stage_rc(tid * 16 + i * 8192, R, C); const int Rb = Epi::PERM ? ((R & ~31) + perm32(R & 31)) : R;
        voffA[i] = (unsigned)(R * K + C) * 2u; voffB[i] = (unsigned)(Rb * K + C) * 2u; }
    const size_t kstep = (size_t)(BK * 2);
    const size_t hstep = (size_t)HALF * K * 2;
    const size_t tstep = 2 * hstep;
    const unsigned ldsw = (unsigned)wid * 1024u;
    const int aoff = lds_byte(wr * 64 + fr, fq * 8), boff = lds_byte(wc * 32 + fr, fq * 8);
#define PG8_SA(b, h) (((b) * 2 + (h)) * HTB)
#define PG8_SB(b, h) ((4 + (b) * 2 + (h)) * HTB)
#define PG8_STAGE(bufoff, gbase, voff) do { _Pragma("unroll") for (int _i = 0; _i < 2; ++_i) \
        __builtin_amdgcn_global_load_lds((const unsigned*)((const char*)(gbase) + (voff)[_i]), (PG8_LAS unsigned*)(lds + (bufoff) + ldsw + _i * 8192), 16, 0, 0); } while (0)
#define PG8_LDA(dst, b, h) do { _Pragma("unroll") for (int m = 0; m < 4; ++m) _Pragma("unroll") for (int k = 0; k < 2; ++k) dst[m][k] = *(const PG8_LAS bf16x8*)(lds + PG8_SA(b, h) + aoff + m * 2048 + k * 1024); } while (0)
#define PG8_LDB(dst, b, h) do { _Pragma("unroll") for (int n = 0; n < 2; ++n) _Pragma("unroll") for (int k = 0; k < 2; ++k) dst[n][k] = *(const PG8_LAS bf16x8*)(lds + PG8_SB(b, h) + boff + n * 2048 + k * 1024); } while (0)
#define PG8_MMA(ai, bj, At, Bt) do { __builtin_amdgcn_s_setprio(1); _Pragma("unroll") for (int m = 0; m < 4; ++m) _Pragma("unroll") for (int n = 0; n < 2; ++n) _Pragma("unroll") for (int k = 0; k < 2; ++k) \
        acc[ai][bj][m][n] = __builtin_amdgcn_mfma_f32_16x16x32_bf16(Bt[n][k], At[m][k], acc[ai][bj][m][n], 0, 0, 0); __builtin_amdgcn_s_setprio(0); } while (0)
#define PG8_WAIT_V(n) asm volatile("s_waitcnt vmcnt(" #n ")" ::: "memory")
#define PG8_WAIT_L(n) asm volatile("s_waitcnt lgkmcnt(" #n ")" ::: "memory")
#define PG8_BAR __builtin_amdgcn_s_barrier()
#define PG8_SCHED __builtin_amdgcn_sched_barrier(0)
    Unit cur, nxt; int ui = 0;
    if (!S.next(0, cur)) return;
    f32x4 acc[2][2][4][2];
#pragma unroll
    for (int a = 0; a < 2; ++a)
#pragma unroll
        for (int b = 0; b < 2; ++b)
#pragma unroll
            for (int m = 0; m < 4; ++m)
#pragma unroll
                for (int n = 0; n < 2; ++n) acc[a][b][m][n] = (f32x4){0.f, 0.f, 0.f, 0.f};
    bf16x8 At[4][2], B0[2][2], B1[2][2];
    const char* cA = (const char*)g.A + (size_t)cur.pm * tstep; const char* cB = (const char*)g.Bt + (size_t)cur.pn * tstep;
    S.a_ready(cur);
    if constexpr (SP2) {
        PG8_STAGE(PG8_SB(0, 0), cB, voffB); PG8_STAGE(PG8_SB(0, 1), cB + hstep, voffB); PG8_STAGE(PG8_SA(0, 0), cA, voffA); PG8_STAGE(PG8_SA(0, 1), cA + hstep, voffA);
        if (wr == 1) PG8_BAR;
        PG8_WAIT_V(2); PG8_BAR;
        PG8_STAGE(PG8_SB(1, 0), cB + kstep, voffB); PG8_STAGE(PG8_SA(1, 0), cA + kstep, voffA); PG8_STAGE(PG8_SB(1, 1), cB + hstep + kstep, voffB);
        PG8_WAIT_V(6); PG8_BAR;
    } else {
        PG8_STAGE(PG8_SB(0, 0), cB, voffB); PG8_STAGE(PG8_SA(0, 0), cA, voffA); PG8_STAGE(PG8_SB(0, 1), cB + hstep, voffB); PG8_STAGE(PG8_SA(0, 1), cA + hstep, voffA);
        if (wr == 1) PG8_BAR;
        PG8_WAIT_V(4); PG8_BAR;
        PG8_STAGE(PG8_SB(1, 0), cB + kstep, voffB); PG8_STAGE(PG8_SA(1, 0), cA + kstep, voffA); PG8_STAGE(PG8_SB(1, 1), cB + hstep + kstep, voffB);
        PG8_WAIT_V(6); PG8_BAR;
    }
    for (;;) {
        const bool has_next = S.next(ui + 1, nxt);
        const char* nA = has_next ? (const char*)g.A + (size_t)nxt.pm * tstep : cA; const char* nB = has_next ? (const char*)g.Bt + (size_t)nxt.pn * tstep : cB;
        for (int t = 0; t < nt; t += 2) {
            const bool last = (t == nt - 2);
            const char* a1 = cA + (size_t)(t + 1) * kstep;
            const char* a2 = last ? nA : cA + (size_t)(t + 2) * kstep; const char* b2 = last ? nB : cB + (size_t)(t + 2) * kstep;
            const char* a3 = a2 + kstep; const char* b3 = b2 + kstep;
            if (last && has_next) S.a_ready(nxt);
            if constexpr (SP2) {
            PG8_LDB(B0, 0, 0); PG8_LDB(B1, 0, 1); PG8_SCHED; PG8_LDA(At, 0, 0); PG8_STAGE(PG8_SA(1, 1), a1 + hstep, voffA);
            PG8_WAIT_V(8); PG8_WAIT_L(0); PG8_BAR; PG8_MMA(0, 0, At, B0); PG8_MMA(0, 1, At, B1); PG8_BAR; PG8_SCHED;
            PG8_LDA(At, 0, 1); PG8_STAGE(PG8_SB(0, 0), b2, voffB); PG8_STAGE(PG8_SB(0, 1), b2 + hstep, voffB); PG8_STAGE(PG8_SA(0, 0), a2, voffA);
            PG8_WAIT_V(8); PG8_WAIT_L(0); PG8_BAR; PG8_MMA(1, 0, At, B0); PG8_MMA(1, 1, At, B1); PG8_BAR; PG8_SCHED;
            PG8_LDB(B0, 1, 0); PG8_LDB(B1, 1, 1); PG8_SCHED; PG8_LDA(At, 1, 0); PG8_STAGE(PG8_SA(0, 1), a2 + hstep, voffA);
            PG8_WAIT_V(8); PG8_WAIT_L(0); PG8_BAR; PG8_MMA(0, 0, At, B0); PG8_MMA(0, 1, At, B1); PG8_BAR; PG8_SCHED;
            PG8_LDA(At, 1, 1); PG8_STAGE(PG8_SB(1, 0), b3, voffB); PG8_STAGE(PG8_SB(1, 1), b3 + hstep, voffB); PG8_STAGE(PG8_SA(1, 0), a3, voffA);
            PG8_WAIT_V(8); PG8_WAIT_L(0); PG8_BAR; PG8_MMA(1, 0, At, B0); PG8_MMA(1, 1, At, B1); PG8_BAR; PG8_SCHED;
            } else {
            PG8_LDB(B0, 0, 0); PG8_SCHED; PG8_LDA(At, 0, 0); PG8_STAGE(PG8_SA(1, 1), a1 + hstep, voffA);
            PG8_WAIT_L(8); PG8_BAR; PG8_WAIT_L(0); PG8_MMA(0, 0, At, B0); PG8_BAR; PG8_SCHED;
            PG8_LDB(B1, 0, 1); PG8_STAGE(PG8_SB(0, 0), b2, voffB);
            PG8_BAR; PG8_WAIT_L(0); PG8_MMA(0, 1, At, B1); PG8_BAR;
            PG8_LDA(At, 0, 1); PG8_STAGE(PG8_SA(0, 0), a2, voffA);
            PG8_BAR; PG8_WAIT_L(0); PG8_MMA(1, 0, At, B0); PG8_BAR; PG8_SCHED;
            PG8_STAGE(PG8_SB(0, 1), b2 + hstep, voffB);
            PG8_WAIT_V(6); PG8_BAR; PG8_MMA(1, 1, At, B1); PG8_BAR;
            PG8_LDB(B0, 1, 0); PG8_SCHED; PG8_LDA(At, 1, 0); PG8_STAGE(PG8_SA(0, 1), a2 + hstep, voffA);
            PG8_WAIT_L(8); PG8_BAR; PG8_WAIT_L(0); PG8_MMA(0, 0, At, B0); PG8_BAR; PG8_SCHED;
            PG8_LDB(B1, 1, 1); PG8_STAGE(PG8_SB(1, 0), b3, voffB);
            PG8_BAR; PG8_WAIT_L(0); PG8_MMA(0, 1, At, B1); PG8_BAR;
            PG8_LDA(At, 1, 1); PG8_STAGE(PG8_SA(1, 0), a3, voffA);
            PG8_BAR; PG8_WAIT_L(0); PG8_MMA(1, 0, At, B0); PG8_BAR; PG8_SCHED;
            PG8_STAGE(PG8_SB(1, 1), b3 + hstep, voffB);
            PG8_WAIT_V(6); PG8_BAR; PG8_MMA(1, 1, At, B1); PG8_BAR;
            }
        }
        if constexpr (ALIGN_EPI) { if (wr == 0) PG8_BAR; }
        if constexpr (!Epi::AFTER_DRAIN) { asm volatile("s_waitcnt vmcnt(0)" ::: "memory"); E(acc, cur, wr, wc, fr, fq); asm volatile("s_waitcnt vmcnt(0)" ::: "memory"); S.done(cur); }
        if (!has_next) break;
#pragma unroll
        for (int a = 0; a < 2; ++a)
#pragma unroll
            for (int b = 0; b < 2; ++b)
#pragma unroll
                for (int m = 0; m < 4; ++m)
#pragma unroll
                    for (int n = 0; n < 2; ++n) acc[a][b][m][n] = (f32x4){0.f, 0.f, 0.f, 0.f};
        cur = nxt; cA = nA; cB = nB; ++ui;
        if constexpr (ALIGN_EPI) { if (wr == 1) PG8_BAR; }
    }
    PG8_WAIT_V(0);
    if constexpr (!ALIGN_EPI) { if (wr == 0) PG8_BAR; }
    PG8_BAR;
    if constexpr (Epi::AFTER_DRAIN) { E.fused(acc, cur, wr, wc, fr, fq, lds, wid, lane); S.done(cur); }
#undef PG8_SA
#undef PG8_SB
#undef PG8_STAGE
#undef PG8_LDA
#undef PG8_LDB
#undef PG8_MMA
#undef PG8_WAIT_V
#undef PG8_WAIT_L
#undef PG8_BAR
#undef PG8_SCHED
}
}

#define LAS __attribute__((address_space(3)))
typedef unsigned short bf16_t;
typedef short bf16x8 __attribute__((ext_vector_type(8)));
typedef float f32x4 __attribute__((ext_vector_type(4)));
typedef float f32x16 __attribute__((ext_vector_type(16)));
typedef unsigned u32x2 __attribute__((ext_vector_type(2)));
typedef unsigned u32x4 __attribute__((ext_vector_type(4)));
typedef short s16x4 __attribute__((ext_vector_type(4)));

constexpr int T_ = 32768, MS_ = 256, M_ = 33024, D_ = 1024, S_ = 8192, FF_ = 4096;
constexpr float EPS_ = 1e-6f;
constexpr float LOG2E = 1.4426950408889634f;
constexpr int LDS_BYTES = 147456;

constexpr size_t O_Y = 0, O_YS = 33554432, O_AKP = 33816576, O_AVP = O_AKP + 33554432, O_BKP = O_AVP + 33554432, O_BVP = O_BKP + 16777216,
                 O_CKP = O_BVP + 16777216, O_CVP = O_CKP + 1048576, O_MKP = O_CVP + 1048576, O_MVP = O_MKP + 524288, O_AKS = O_MVP + 524288,
                 O_AVS = O_AKS + 262144, O_BKS = O_AVS + 262144, O_BVS = O_BKS + 131072, O_CKS = O_BVS + 131072, O_CVS = O_CKS + 2097152, O_END = O_CVS + 2097152;

constexpr size_t MiB = 1048576;
constexpr size_t WS_SS = 464 * MiB;
constexpr size_t SS_STRIDE = (size_t)M_ * 16;
constexpr size_t WS_SSMEM = 484 * MiB;
constexpr size_t WS_MEMB = 2 * MiB;
constexpr size_t WS_MKB = 4 * MiB, WS_MVB = 5 * MiB;
constexpr size_t WS_W = 8 * MiB;
constexpr size_t W_LAYER = 34603008;
constexpr size_t W_GU1 = 0, W_D1 = 8388608, W_IN = 12582912, W_BRA = 18874368, W_BRB = 19398656, W_BRC = 19660800, W_OUT = 19922944,
                 W_Q = 20971520, W_KV = 21233664, W_O = 21757952, W_GU2 = 22020096, W_D2 = 30408704;
constexpr size_t WS_XB = 140 * MiB;
constexpr size_t WS_R = 205 * MiB;
constexpr size_t R_QA = 0, R_QB = 33816576, R_QC = 50724864, R_KA = 67633152, R_VA = 101449728, R_KB = 135266304, R_VB = 152174592,
                 R_KC = 169082880, R_VC = 185991168, R_G = 67633152, R_GPLANE = 67633152, R_U = 0, R_QX = 0;
constexpr size_t WS_END = 485 * MiB;
static_assert(WS_R + 270532608 <= WS_SS && WS_SS + 9 * SS_STRIDE * 4 <= WS_SSMEM, "ws map");

struct Args {
    const float* in[43];
    float* out;
    unsigned char* ws;
};

__device__ __forceinline__ float bf2f(unsigned v) { return __uint_as_float(v << 16); }
typedef float f32x2v __attribute__((ext_vector_type(2)));
typedef __bf16 bf16x2v __attribute__((ext_vector_type(2)));
__device__ __forceinline__ unsigned pk2(float lo, float hi) { const f32x2v v = {lo, hi}; const bf16x2v b = __builtin_convertvector(v, bf16x2v); return __builtin_bit_cast(unsigned, b); }
__device__ __forceinline__ float wave_sum(float v) {
#pragma unroll
    for (int o = 1; o < 64; o <<= 1) v += __shfl_xor(v, o);
    return v;
}
__device__ __forceinline__ float wave_max(float v) {
#pragma unroll
    for (int o = 1; o < 64; o <<= 1) v = fmaxf(v, __shfl_xor(v, o));
    return v;
}

__device__ __forceinline__ float row_rstd(const float* ss, int row) {
    const f32x4* q = (const f32x4*)(ss + (size_t)row * 16);
    const f32x4 a = q[0], b = q[1], c = q[2], d = q[3];
    const float s = ((a[0] + a[1]) + (a[2] + a[3])) + ((b[0] + b[1]) + (b[2] + b[3])) + ((c[0] + c[1]) + (c[2] + c[3])) + ((d[0] + d[1]) + (d[2] + d[3]));
    return rsqrtf(s * (1.f / 1024.f) + EPS_);
}
__device__ __forceinline__ float row_rstd_q(const float* ss, int row, int fq) {
    const f32x4 a = *(const f32x4*)(ss + (size_t)row * 16 + 4 * fq);
    float s = (a[0] + a[1]) + (a[2] + a[3]);
    s += __shfl_xor(s, 16); s += __shfl_xor(s, 32);
    return rsqrtf(s * (1.f / 1024.f) + EPS_);
}
struct EpiSwiglu {
    static constexpr bool PERM = false, AFTER_DRAIN = false;
    const float* ss; bf16_t* U;
    __device__ __forceinline__ void operator()(const pg8::f32x4 (&acc)[2][2][4][2], const pg8::Unit& u, int wr, int wc, int fr, int fq) const {
        const int row0 = u.pm * 256 + wr * 64 + fr;
        const int f0 = u.pn * 128 + wc * 32 + 4 * fq;
        float rsv[2][4];
#pragma unroll
        for (int ai = 0; ai < 2; ++ai)
#pragma unroll
            for (int m = 0; m < 4; ++m) rsv[ai][m] = row_rstd_q(ss, row0 + ai * 128 + m * 16, fq);
#pragma unroll
        for (int ai = 0; ai < 2; ++ai)
#pragma unroll
            for (int m = 0; m < 4; ++m) {
                const int row = row0 + ai * 128 + m * 16;
                const float rs = rsv[ai][m];
#pragma unroll
                for (int n = 0; n < 2; ++n) {
                    const pg8::f32x4 g = acc[ai][0][m][n] * rs, up = acc[ai][1][m][n] * rs;
                    float o[4];
#pragma unroll
                    for (int i = 0; i < 4; ++i) o[i] = g[i] * __builtin_amdgcn_rcpf(1.f + __expf(-g[i])) * up[i];
                    u32x2 w; w.x = pk2(o[0], o[1]); w.y = pk2(o[2], o[3]);
                    *(u32x2*)(U + (size_t)row * 4096 + f0 + 16 * n) = w;
                }
                asm volatile("" ::: "memory");
            }
    }
};

struct EpiRes {
    static constexpr bool PERM = false, AFTER_DRAIN = false;
    const float* base_p; const float* base_s; float* out; bf16_t* xb; float* ssn; float scale;
    __device__ __forceinline__ void operator()(const pg8::f32x4 (&acc)[2][2][4][2], const pg8::Unit& u, int wr, int wc, int fr, int fq) const {
        const float* base = (u.pm < 128) ? base_p : base_s;
        const int row0 = u.pm * 256 + wr * 64 + fr;
        const int col0 = u.pn * 256 + wc * 64 + 4 * fq;
#pragma unroll
        for (int ai = 0; ai < 2; ++ai)
#pragma unroll
            for (int m = 0; m < 4; ++m) {
                const int row = row0 + ai * 128 + m * 16;
                float sq = 0.f;
#pragma unroll
                for (int bj = 0; bj < 2; ++bj)
#pragma unroll
                    for (int n = 0; n < 2; ++n) {
                        const size_t off = (size_t)row * 1024 + col0 + 32 * bj + 16 * n;
                        const pg8::f32x4 bv = *(const pg8::f32x4*)(base + off);
                        const pg8::f32x4 v = bv + acc[ai][bj][m][n] * scale;
                        *(pg8::f32x4*)(out + off) = v;
                        sq += (v[0] * v[0] + v[1] * v[1]) + (v[2] * v[2] + v[3] * v[3]);
                        u32x2 w; w.x = pk2(v[0], v[1]); w.y = pk2(v[2], v[3]);
                        *(u32x2*)(xb + off) = w;
                    }
                sq += __shfl_xor(sq, 16); sq += __shfl_xor(sq, 32);
                if (fq == 0) ssn[(size_t)row * 16 + u.pn * 4 + wc] = sq;
                if (m & 1) asm volatile("" ::: "memory");
            }
    }
};

struct ColDesc {
    const float* gain;
    int sig;
    bf16_t* db; int ldb, cb;
    float* df_p; float* df_s; int ldf, cf, mode;
};

template <class DescFn> struct EpiGen {
    static constexpr bool PERM = false, AFTER_DRAIN = false;
    const float* ss; DescFn fn;
    __device__ __forceinline__ void operator()(const pg8::f32x4 (&acc)[2][2][4][2], const pg8::Unit& u, int wr, int wc, int fr, int fq) const {
        const ColDesc d = fn(u.pn);
        const int row0 = u.pm * 256 + wr * 64 + fr;
        const int lc0 = wc * 64 + 4 * fq;
        pg8::f32x4 gn[2][2];
        if (d.gain) {
#pragma unroll
            for (int bj = 0; bj < 2; ++bj)
#pragma unroll
                for (int n = 0; n < 2; ++n) gn[bj][n] = *(const pg8::f32x4*)(d.gain + 4 * fq + 32 * bj + 16 * n);
        }
        const bool samp = (u.pm >= 128);
        float rsv[2][4];
#pragma unroll
        for (int ai = 0; ai < 2; ++ai)
#pragma unroll
            for (int m = 0; m < 4; ++m) rsv[ai][m] = row_rstd_q(ss, row0 + ai * 128 + m * 16, fq);
#pragma unroll
        for (int ai = 0; ai < 2; ++ai)
#pragma unroll
            for (int m = 0; m < 4; ++m) {
                const int row = row0 + ai * 128 + m * 16;
                const float rs = rsv[ai][m];
                pg8::f32x4 v[2][2];
                float sq = 0.f;
#pragma unroll
                for (int bj = 0; bj < 2; ++bj)
#pragma unroll
                    for (int n = 0; n < 2; ++n) { v[bj][n] = acc[ai][bj][m][n] * rs; const pg8::f32x4 t = v[bj][n]; sq += (t[0] * t[0] + t[1] * t[1]) + (t[2] * t[2] + t[3] * t[3]); }
                if (d.gain) {
                    sq += __shfl_xor(sq, 16); sq += __shfl_xor(sq, 32);
                    const float hn = rsqrtf(sq * (1.f / 64.f) + EPS_);
#pragma unroll
                    for (int bj = 0; bj < 2; ++bj)
#pragma unroll
                        for (int n = 0; n < 2; ++n) v[bj][n] = v[bj][n] * hn * gn[bj][n];
                }
                if (d.sig) {
#pragma unroll
                    for (int bj = 0; bj < 2; ++bj)
#pragma unroll
                        for (int n = 0; n < 2; ++n)
#pragma unroll
                            for (int i = 0; i < 4; ++i) v[bj][n][i] = __builtin_amdgcn_rcpf(1.f + __expf(-v[bj][n][i]));
                }
                {
                    bf16_t* p = d.db + (size_t)row * d.ldb + d.cb + lc0;
#pragma unroll
                    for (int bj = 0; bj < 2; ++bj)
#pragma unroll
                        for (int n = 0; n < 2; ++n) { u32x2 w; w.x = pk2(v[bj][n][0], v[bj][n][1]); w.y = pk2(v[bj][n][2], v[bj][n][3]); *(u32x2*)(p + 32 * bj + 16 * n) = w; }
                }
                if (d.df_p) {
                    float* p = nullptr;
                    if (!samp) {
                        if (d.mode == 0) p = d.df_p + (size_t)row * d.ldf;
                        else { const int s = row & (S_ - 1), b = row >> 13; if (s >= S_ - 512) p = d.df_p + (size_t)(b * 512 + s - (S_ - 512)) * d.ldf; }
                    } else {
                        const int r2 = row - T_;
                        if (d.mode == 0) p = d.df_s + (size_t)r2 * d.ldf;
                        else p = d.df_s + (size_t)((r2 >> 5) * 512 + 480 + (r2 & 31)) * d.ldf;
                    }
                    if (p) {
                        p += d.cf + lc0;
#pragma unroll
                        for (int bj = 0; bj < 2; ++bj)
#pragma unroll
                            for (int n = 0; n < 2; ++n) *(pg8::f32x4*)(p + 32 * bj + 16 * n) = v[bj][n];
                    }
                }
                asm volatile("" ::: "memory");
            }
    }
};

struct EpiMerge {
    static constexpr bool PERM = false, AFTER_DRAIN = false;
    const bf16_t* gate; bf16_t* merged; int first;
    __device__ __forceinline__ void operator()(const pg8::f32x4 (&acc)[2][2][4][2], const pg8::Unit& u, int wr, int wc, int fr, int fq) const {
        const int row0 = u.pm * 256 + wr * 64 + fr;
        const int col0 = u.pn * 256 + wc * 64 + 4 * fq;
#pragma unroll
        for (int ai = 0; ai < 2; ++ai)
#pragma unroll
            for (int m = 0; m < 4; ++m) {
                const int row = row0 + ai * 128 + m * 16;
#pragma unroll
                for (int bj = 0; bj < 2; ++bj)
#pragma unroll
                    for (int n = 0; n < 2; ++n) {
                        const size_t off = (size_t)row * 1024 + col0 + 32 * bj + 16 * n;
                        const u32x2 g = *(const u32x2*)(gate + off);
                        float o0 = bf2f(g.x & 0xffffu) * acc[ai][bj][m][n][0], o1 = bf2f(g.x >> 16) * acc[ai][bj][m][n][1];
                        float o2 = bf2f(g.y & 0xffffu) * acc[ai][bj][m][n][2], o3 = bf2f(g.y >> 16) * acc[ai][bj][m][n][3];
                        if (!first) { const u32x2 mo = *(const u32x2*)(merged + off); o0 += bf2f(mo.x & 0xffffu); o1 += bf2f(mo.x >> 16); o2 += bf2f(mo.y & 0xffffu); o3 += bf2f(mo.y >> 16); }
                        u32x2 w; w.x = pk2(o0, o1); w.y = pk2(o2, o3);
                        *(u32x2*)(merged + off) = w;
                    }
                if (m & 1) asm volatile("" ::: "memory");
            }
    }
};

__device__ __forceinline__ void p0_transpose_item(const float* W, int ldw, int srccol, const float* gain, bf16_t* dst, int prow, int K, int k0, LAS float* scr, int lane) {
    const int rsub = lane >> 4, c4 = lane & 15;
    const float* src = W + (size_t)(k0 + rsub) * ldw + srccol + 4 * c4;
    f32x4 v[8];
#pragma unroll
    for (int i = 0; i < 8; ++i) v[i] = __builtin_nontemporal_load((const f32x4*)(src + (size_t)(4 * i) * ldw));
    if (gain) {
#pragma unroll
        for (int i = 0; i < 8; ++i) v[i] = v[i] * gain[k0 + 4 * i + rsub];
    }
#pragma unroll
    for (int i = 0; i < 8; ++i) *(LAS f32x4*)(scr + (4 * i + rsub) * 68 + 4 * c4) = v[i];
    asm volatile("s_waitcnt lgkmcnt(0)" ::: "memory");
    bf16_t* drow = dst + (size_t)prow * K + k0;
#pragma unroll
    for (int c = 0; c < 4; ++c) {
        const LAS float* s = scr + (8 * c) * 68 + lane;
        u32x4 o; o.x = pk2(s[0 * 68], s[1 * 68]); o.y = pk2(s[2 * 68], s[3 * 68]); o.z = pk2(s[4 * 68], s[5 * 68]); o.w = pk2(s[6 * 68], s[7 * 68]);
        *(u32x4*)(drow + 8 * c) = o;
    }
    asm volatile("s_waitcnt lgkmcnt(0)" ::: "memory");
}
__device__ __forceinline__ void row_to_bf16(const float* xrow, bf16_t* orow, float* ssp, int lane) {
    const f32x4* xr = (const f32x4*)xrow + lane;
    f32x4 v[4]; float s = 0.f;
#pragma unroll
    for (int j = 0; j < 4; ++j) { v[j] = xr[64 * j]; s += (v[j].x * v[j].x + v[j].y * v[j].y) + (v[j].z * v[j].z + v[j].w * v[j].w); }
    s = wave_sum(s);
    u32x2* o = (u32x2*)orow + lane;
#pragma unroll
    for (int j = 0; j < 4; ++j) { u32x2 w; w.x = pk2(v[j].x, v[j].y); w.y = pk2(v[j].z, v[j].w); o[64 * j] = w; }
    if (lane < 16) ssp[lane] = (lane == 0) ? s : 0.f;
}

constexpr int AT_KT = 0, AT_VT = 17408, AT_BUF = 17408 + 18432  , AT_QW = 2 * AT_BUF, AT_TAB = AT_QW + 8 * 32 * 144, AT_FLAG = AT_TAB + 1600, AT_END = AT_FLAG + 64;
static_assert(4 * 4 * 16 * 64 * 4 <= AT_TAB, "differential exchange area below the bias table");
static_assert(AT_END <= 131072, "attention LDS map");
constexpr int AT_ACCO = 0, AT_ACCL = 32768, AT_STAB = 34816, AT_SV = 36864;

struct NoPrep { __device__ __forceinline__ void operator()(int) const {} };
template <int NMAP, int VD, class KL, class QL, class VL, class BF, class PREP = NoPrep>
__device__ __forceinline__ void tile_softmax(f32x16 (&O)[NMAP][VD / 32], float (&l)[NMAP], const KL& kl, const QL& ql, const VL& vl, const BF& bf, const PREP& prep = PREP()) {
    constexpr float C1 = 0.125f * LOG2E;
#pragma unroll
    for (int kb = 0; kb < 2; ++kb) {
        prep(kb);
#pragma unroll
        for (int mp = 0; mp < NMAP; ++mp) {
            f32x16 S;
#pragma unroll
            for (int i = 0; i < 16; ++i) S[i] = 0.f;
#pragma unroll
            for (int s = 0; s < 4; ++s) S = __builtin_amdgcn_mfma_f32_32x32x16_bf16(kl(kb, mp, s), ql(mp, s), S, 0, 0, 0);
            float ls = 0.f; unsigned pw[8];
#pragma unroll
            for (int r2 = 0; r2 < 16; r2 += 2) {
                const float p0 = __builtin_amdgcn_exp2f(S[r2] * C1 + bf(kb, r2)), p1 = __builtin_amdgcn_exp2f(S[r2 + 1] * C1 + bf(kb, r2 + 1));
                ls += p0 + p1; pw[r2 >> 1] = pk2(p0, p1);
            }
            l[mp] += ls;
            u32x4 t0 = {pw[0], pw[1], pw[2], pw[3]}, t1 = {pw[4], pw[5], pw[6], pw[7]};
            const bf16x8 pf0 = __builtin_bit_cast(bf16x8, t0), pf1 = __builtin_bit_cast(bf16x8, t1);
            __builtin_amdgcn_sched_barrier(0);
#pragma unroll
            for (int db = 0; db < VD / 32; ++db) {
                O[mp][db] = __builtin_amdgcn_mfma_f32_32x32x16_bf16(vl(db, kb, 0), pf0, O[mp][db], 0, 0, 0);
                O[mp][db] = __builtin_amdgcn_mfma_f32_32x32x16_bf16(vl(db, kb, 1), pf1, O[mp][db], 0, 0, 0);
            }
            __builtin_amdgcn_sched_barrier(0);
        }
    }
}

template <class KL, class QL, class VL, class MK>
__device__ __forceinline__ void tile_stick(f32x16 (&O)[2], float& R, int hh, const KL& kl, const QL& ql, const VL& vl, const MK& valid) {
#pragma unroll
    for (int kb = 1; kb >= 0; --kb) {
        f32x16 S;
#pragma unroll
        for (int i = 0; i < 16; ++i) S[i] = 0.f;
#pragma unroll
        for (int s = 0; s < 4; ++s) S = __builtin_amdgcn_mfma_f32_32x32x16_bf16(kl(kb, 0, s), ql(0, s), S, 0, 0, 0);
        float sg[16], f[16];
#pragma unroll
        for (int i = 0; i < 16; ++i) {
            float z = S[i] * 0.125f; z = fminf(fmaxf(z, -60.f), 60.f);
            const float e = __builtin_amdgcn_exp2f(-z * LOG2E);
            float s_ = __builtin_amdgcn_rcpf(1.f + e), ff = e * s_;
            if (!valid(kb, i)) { s_ = 0.f; ff = 1.f; }
            sg[i] = s_; f[i] = ff;
        }
        float F[4], Fp[4], Tg[4];
#pragma unroll
        for (int g = 0; g < 4; ++g) { F[g] = (f[4 * g] * f[4 * g + 1]) * (f[4 * g + 2] * f[4 * g + 3]); Fp[g] = __shfl_xor(F[g], 32); Tg[g] = F[g] * Fp[g]; }
        float E[4]; E[3] = 1.f; E[2] = Tg[3]; E[1] = Tg[3] * Tg[2]; E[0] = E[1] * Tg[1];
        unsigned pw[8];
#pragma unroll
        for (int g = 0; g < 4; ++g) {
            float t = R * E[g] * (hh == 0 ? Fp[g] : 1.f);
            const float w3 = sg[4 * g + 3] * t; t *= f[4 * g + 3];
            const float w2 = sg[4 * g + 2] * t; t *= f[4 * g + 2];
            const float w1 = sg[4 * g + 1] * t; t *= f[4 * g + 1];
            const float w0 = sg[4 * g] * t;
            pw[2 * g] = pk2(w0, w1); pw[2 * g + 1] = pk2(w2, w3);
        }
        R *= E[0] * Tg[0];
        u32x4 t0 = {pw[0], pw[1], pw[2], pw[3]}, t1 = {pw[4], pw[5], pw[6], pw[7]};
        const bf16x8 pf0 = __builtin_bit_cast(bf16x8, t0), pf1 = __builtin_bit_cast(bf16x8, t1);
#pragma unroll
        for (int db = 0; db < 2; ++db) {
            O[db] = __builtin_amdgcn_mfma_f32_32x32x16_bf16(vl(db, kb, 0), pf0, O[db], 0, 0, 0);
            O[db] = __builtin_amdgcn_mfma_f32_32x32x16_bf16(vl(db, kb, 1), pf1, O[db], 0, 0, 0);
        }
    }
}

template <int MODE, int NMAP, int VD>
__device__ __forceinline__ void finish_store(f32x16 (&O)[NMAP][VD / 32], float (&l)[NMAP], bf16_t* orowp, int hh, float lam, const float* subln, float oscale) {
    float inv[NMAP];
    if (MODE != 3) {
#pragma unroll
        for (int mp = 0; mp < NMAP; ++mp) { l[mp] += __shfl_xor(l[mp], 32); inv[mp] = 1.f / l[mp]; }
    }
    if constexpr (MODE == 0) {
        float sq = 0.f;
#pragma unroll
        for (int db = 0; db < 4; ++db)
#pragma unroll
            for (int i = 0; i < 16; ++i) { const float o = O[0][db][i] * inv[0] - lam * (O[1][db][i] * inv[1]); O[0][db][i] = o; sq += o * o; }
        sq += __shfl_xor(sq, 32);
        const float rsn = rsqrtf(sq * (1.f / 128.f) + EPS_) * oscale;
#pragma unroll
        for (int db = 0; db < 4; ++db)
#pragma unroll
            for (int g = 0; g < 4; ++g) {
                const int d0 = 32 * db + 8 * g + 4 * hh;
                const f32x4 gn = *(const f32x4*)(subln + d0);
                u32x2 wv; wv.x = pk2(O[0][db][4 * g] * rsn * gn[0], O[0][db][4 * g + 1] * rsn * gn[1]); wv.y = pk2(O[0][db][4 * g + 2] * rsn * gn[2], O[0][db][4 * g + 3] * rsn * gn[3]);
                *(u32x2*)(orowp + d0) = wv;
            }
    } else {
        const float sc = (MODE == 3) ? 1.f : inv[0];
#pragma unroll
        for (int db = 0; db < VD / 32; ++db)
#pragma unroll
            for (int g = 0; g < 4; ++g) {
                const int d0 = 32 * db + 8 * g + 4 * hh;
                u32x2 wv; wv.x = pk2(O[0][db][4 * g] * sc, O[0][db][4 * g + 1] * sc); wv.y = pk2(O[0][db][4 * g + 2] * sc, O[0][db][4 * g + 3] * sc);
                *(u32x2*)(orowp + d0) = wv;
            }
    }
}

__device__ __forceinline__ int t5_bucket_dev(int rel) {
    const int n = rel < 0 ? -rel : rel;
    int v;
    if (n < 8) v = n; else { const int k = 31 - __clz(n * n) - 6; v = 8 + k; if (v > 15) v = 15; }
    return (rel > 0 ? 16 : 0) + v;
}
__device__ __forceinline__ float lambda_init_dev(int layer) { return 0.8f - 0.6f * expf(-0.3f * (float)layer); }

template <int MODE>
__device__ __forceinline__ float attn_setup_bias(const Args& a, int layer, int h, LAS float* tab, int tid, int lane) {
    const float* gq = MODE == 0 ? a.in[18] : (MODE == 1 ? a.in[25] : a.in[36]);
    const float* gk = MODE == 0 ? a.in[19] : (MODE == 1 ? a.in[26] : a.in[37]);
    const float mq = wave_max(fabsf(gq[layer * 64 + lane])), mk = wave_max(fabsf(gk[layer * 64 + lane]));
    float mb = 0.f;
    const float* t5 = a.in[11];
    const float* relb = a.in[27] + (size_t)(layer * 4 + h) * 257;
    if (MODE == 0) mb = wave_max(lane < 32 ? fabsf(t5[lane * 4 + h]) : 0.f);
    if (MODE == 1) { float m = 0.f; for (int i = lane; i < 257; i += 64) m = fmaxf(m, fabsf(relb[i])); mb = wave_max(m); }
    const float shift = 8.f * mq * mk + mb;
    if (MODE == 0 || MODE == 1) {
        for (int t = tid; t < 384; t += 512) {
            int rel = t - 64 - 255; if (t < 64) rel = -255; float v;
            if (MODE == 0) v = t5[t5_bucket_dev(rel) * 4 + h];
            else { int c = rel < -128 ? -128 : (rel > 128 ? 128 : rel); v = relb[c + 128]; }
            tab[t] = (v - shift) * LOG2E;
        }
    }
    if (MODE == 0) return (t5[15 * 4 + h] - shift) * LOG2E;
    if (MODE == 1) return (relb[0] - shift) * LOG2E;
    return -shift * LOG2E;
}

template <int MODE>
__device__ __forceinline__ void attn_prompt_unit(LAS unsigned char* lds, const Args& a, int layer, int bh, int qb) {
    constexpr int KD = MODE == 0 ? 128 : 64, VD = MODE == 0 ? 128 : 64, KP = KD * 2 + 16, VP2 = VD * 2 + 16, QP = 144, NKC = KD / 64, NVC = VD / 64, UROWS = MODE == 0 ? 128 : 256;
    int tid_l = threadIdx.x; asm volatile("" : "+v"(tid_l));
    const int tid = tid_l, lane = tid & 63, w = __builtin_amdgcn_readfirstlane(tid >> 6), r = lane & 31, hh = lane >> 5;
    const int qg = MODE == 0 ? (w >> 1) : w, mpw = MODE == 0 ? (w & 1) : 0;
    const int b = bh >> 2, h = bh & 3;
    unsigned char* Rg = a.ws + WS_R;
    bf16_t* Q; const bf16_t* K; const bf16_t* V; int ld; int hoff; size_t keyrow0;
    if (MODE == 0) { Q = (bf16_t*)(Rg + R_QA); K = (const bf16_t*)(Rg + R_KA); V = (const bf16_t*)(Rg + R_VA); ld = 512; hoff = h * 128; keyrow0 = (size_t)b * S_; }
    else if (MODE == 1) { Q = (bf16_t*)(Rg + R_QC); K = (const bf16_t*)(Rg + R_KC); V = (const bf16_t*)(Rg + R_VC); ld = 256; hoff = h * 64; keyrow0 = (size_t)b * S_; }
    else if (MODE == 3) { Q = (bf16_t*)(Rg + R_QB); K = (const bf16_t*)(Rg + R_KB); V = (const bf16_t*)(Rg + R_VB); ld = 256; hoff = h * 64; keyrow0 = (size_t)b * S_; }
    else { Q = (bf16_t*)(Rg + R_QX); K = (const bf16_t*)(a.ws + WS_MKB) + (size_t)layer * 262144; V = (const bf16_t*)(a.ws + WS_MVB) + (size_t)layer * 262144; ld = 256; hoff = h * 64; keyrow0 = (size_t)b * 256; }
    const int q0 = UROWS * qb + 32 * qg;
    const size_t qrow0 = (size_t)b * S_ + q0;
    const int cw = q0 >> 6;
    int jlo, jhi, wlo, whi;
    if (MODE == 0 || MODE == 3) { jlo = 0; jhi = ((UROWS * qb + UROWS - 1) >> 6); wlo = 0; whi = cw; }
    else if (MODE == 1) { const int c0 = (UROWS * qb) >> 6; wlo = cw - 8 < 0 ? 0 : cw - 8; whi = cw; jlo = c0 - 8 < 0 ? 0 : c0 - 8; jhi = c0 + 3; }
    else { jlo = 0; jhi = 3; wlo = 0; whi = 3; }

    LAS unsigned char* QW = lds + AT_QW + w * (32 * QP);
    LAS float* tab = (LAS float*)(lds + AT_TAB); volatile LAS int* flags = (volatile LAS int*)(lds + AT_FLAG);

    __syncthreads();
    float farc = 0.f;
    if (MODE != 3) farc = attn_setup_bias<MODE>(a, layer, h, tab, tid, lane);
#pragma unroll
    for (int i = 0; i < 4; ++i) {
        const int c = lane + 64 * i, row = c >> 3, part = c & 7;
        const u32x4 v = *(const u32x4*)(Q + (qrow0 + row) * ld + hoff + mpw * 64 + part * 8);
        *(LAS u32x4*)(QW + row * QP + part * 16) = v;
    }
    float lam = 0.f;
    if (MODE == 0) {
        const float s1 = wave_sum(a.in[20][layer * 64 + lane] * a.in[21][layer * 64 + lane]);
        const float s2 = wave_sum(a.in[22][layer * 64 + lane] * a.in[23][layer * 64 + lane]);
        lam = expf(s1) - expf(s2) + lambda_init_dev(layer);
    }

    f32x16 O[1][VD / 32]; float l[1] = {0.f};
#pragma unroll
    for (int db = 0; db < VD / 32; ++db)
#pragma unroll
        for (int i = 0; i < 16; ++i) O[0][db][i] = 0.f;
    float Rp = 1.f; bool done = false;

    u32x4 kreg[NKC], vreg[NVC];
    auto prefetch = [&](int j) {
#pragma unroll
        for (int i = 0; i < NKC; ++i) { const int c = tid + 512 * i, key = c / (KD / 8), part = c % (KD / 8);
            kreg[i] = *(const u32x4*)(K + (keyrow0 + 64 * j + key) * ld + hoff + part * 8); }
#pragma unroll
        for (int i = 0; i < NVC; ++i) { const int c = tid + 512 * i, key = c / (VD / 8), part = c % (VD / 8);
            vreg[i] = *(const u32x4*)(V + (keyrow0 + 64 * j + key) * ld + hoff + part * 8); }
    };
    auto stage = [&](int buf) {
        LAS unsigned char* KT = lds + AT_KT + buf * AT_BUF; LAS unsigned char* VT = lds + AT_VT + buf * AT_BUF;
#pragma unroll
        for (int i = 0; i < NKC; ++i) { const int c = tid + 512 * i, key = c / (KD / 8), part = c % (KD / 8);
            *(LAS u32x4*)(KT + key * KP + part * 16) = kreg[i]; }
#pragma unroll
        for (int i = 0; i < NVC; ++i) { const int c = tid + 512 * i, key = c / (VD / 8), part = c % (VD / 8);
            *(LAS u32x4*)(VT + key * VP2 + part * 16) = vreg[i]; }
    };
    auto ql = [&](int, int s) -> bf16x8 { return *(const LAS bf16x8*)(QW + r * QP + (16 * s + 8 * hh) * 2); };
    auto step = [&](auto BUFC, int j, bool more) {
        constexpr int BUF = decltype(BUFC)::value;
        const LAS unsigned char* KTb = lds + AT_KT + BUF * AT_BUF; const LAS unsigned char* VTb = lds + AT_VT + BUF * AT_BUF;
        auto kl = [&](int kb, int, int s) -> bf16x8 { return *(const LAS bf16x8*)(KTb + (32 * kb + r) * KP + mpw * 128 + (16 * s + 8 * hh) * 2); };
        auto vl = [&](int db, int kb, int s2) -> bf16x8 {
            const LAS unsigned char* p = VTb + (32 * kb + 16 * s2 + 4 * hh + ((lane & 15) >> 2)) * VP2 + (32 * db + 16 * ((lane >> 4) & 1) + 4 * (lane & 3)) * 2;
            const s16x4 lo = __builtin_amdgcn_ds_read_tr16_b64_v4i16((LAS s16x4*)p), hi = __builtin_amdgcn_ds_read_tr16_b64_v4i16((LAS s16x4*)(p + 8 * VP2));
            bf16x8 t = {lo[0], lo[1], lo[2], lo[3], hi[0], hi[1], hi[2], hi[3]}; return t; };
        if constexpr (MODE != 3) {
            if (more) prefetch(j + 1);
            if (j >= wlo && j <= whi) {
                const int maxrel = 64 * j + 63 - q0;
                const int bidx = (maxrel <= -128) ? 0 : 64 + 64 * j + 4 * hh - q0 - r + 255;
                auto bf = [&](int kb, int i) -> float { if (MODE == 2) return farc; return tab[bidx + 32 * kb + (i & 3) + 8 * (i >> 2)]; };
                tile_softmax<1, VD>(O, l, kl, ql, vl, bf);
            }
        } else {
            if (more) prefetch(j - 1);
            if (j <= whi && !done) {
                const int kbase = 64 * j + 4 * hh, qpos = (j == whi) ? q0 + r : 0x7fffffff;
                auto valid = [&](int kb, int i) -> bool { return (kbase + 32 * kb + (i & 3) + 8 * (i >> 2)) < qpos; };
                tile_stick(O[0], Rp, hh, kl, ql, vl, valid);
                done = (__ballot(Rp != 0.f) == 0ull) || (j == 0);
            }
            if (lane == 0) flags[BUF * 8 + w] = done ? 1 : 0;
        }
        if (more) stage(BUF ^ 1);
        __syncthreads();
    };
    if constexpr (MODE != 3) {
        prefetch(jlo); stage(0); __syncthreads();
        for (int j = jlo; j <= jhi; j += 2) {
            step(std::integral_constant<int, 0>{}, j, j < jhi);
            if (j + 1 <= jhi) step(std::integral_constant<int, 1>{}, j + 1, j + 1 < jhi);
        }
    } else {
        prefetch(jhi); stage(0); __syncthreads();
        for (int j = jhi; j >= 0; j -= 2) {
            step(std::integral_constant<int, 0>{}, j, j > 0);
            { int alld = 1;
#pragma unroll
              for (int i = 0; i < 8; ++i) alld &= flags[i];
              if (alld || j == 0) break; }
            step(std::integral_constant<int, 1>{}, j - 1, j - 1 > 0);
            { int alld = 1;
#pragma unroll
              for (int i = 0; i < 8; ++i) alld &= flags[8 + i];
              if (alld) break; }
        }
    }
    bf16_t* orowp = Q + (qrow0 + r) * ld + hoff;
    if constexpr (MODE == 0) {
        l[0] += __shfl_xor(l[0], 32);
        const float inv = 1.f / l[0];
        LAS float* ex = (LAS float*)lds + qg * (4 * 16 * 64);
        if (mpw == 1) {
            const float sc = inv * lam;
#pragma unroll
            for (int db = 0; db < 4; ++db)
#pragma unroll
                for (int i = 0; i < 16; ++i) ex[(db * 16 + i) * 64 + lane] = O[0][db][i] * sc;
        }
        __syncthreads();
        if (mpw == 0) {
            float sq = 0.f;
#pragma unroll
            for (int db = 0; db < 4; ++db)
#pragma unroll
                for (int i = 0; i < 16; ++i) { const float o = O[0][db][i] * inv - ex[(db * 16 + i) * 64 + lane]; O[0][db][i] = o; sq += o * o; }
            sq += __shfl_xor(sq, 32);
            const float rsn = rsqrtf(sq * (1.f / 128.f) + EPS_) * (1.f - lambda_init_dev(layer));
            const float* subln = a.in[24] + layer * 128;
#pragma unroll
            for (int db = 0; db < 4; ++db)
#pragma unroll
                for (int g = 0; g < 4; ++g) {
                    const int d0 = 32 * db + 8 * g + 4 * hh;
                    const f32x4 gn = *(const f32x4*)(subln + d0);
                    u32x2 wv; wv.x = pk2(O[0][db][4 * g] * rsn * gn[0], O[0][db][4 * g + 1] * rsn * gn[1]); wv.y = pk2(O[0][db][4 * g + 2] * rsn * gn[2], O[0][db][4 * g + 3] * rsn * gn[3]);
                    *(u32x2*)(orowp + d0) = wv;
                }
        }
    } else {
        finish_store<MODE, 1, VD>(O, l, orowp, hh, lam, nullptr, 1.f);
    }
}

template <int MODE>
__device__ __forceinline__ void attn_sample_unit(LAS unsigned char* lds, const Args& a, int layer, int b, int h) {
    constexpr int NMAP = MODE == 0 ? 2 : 1, KD = 64 * NMAP, VD = MODE == 0 ? 128 : 64;
    int tid_l = threadIdx.x; asm volatile("" : "+v"(tid_l));
    const int tid = tid_l, lane = tid & 63, w = __builtin_amdgcn_readfirstlane(tid >> 6), r = lane & 31, hh = lane >> 5;
    const float *kc, *kn, *vc, *vn; int ldk, ncache, nkeys, kpos0; const bf16_t* Q; int ldq;
    const size_t lb = (size_t)(layer * 8 + b);
    if (MODE == 0) { kc = a.in[3] + lb * 1024 * 512 + h * 128; vc = a.in[4] + lb * 1024 * 512 + h * 128; kn = a.out + O_AKS + lb * 32 * 512 + h * 128; vn = a.out + O_AVS + lb * 32 * 512 + h * 128;
        ldk = 512; ncache = 1024; nkeys = 1056; kpos0 = 0; Q = (const bf16_t*)(a.ws + WS_R + R_QA); ldq = 512; }
    else if (MODE == 1) { kc = a.in[7] + lb * 512 * 256 + h * 64; vc = a.in[8] + lb * 512 * 256 + h * 64; kn = a.out + O_CKS + (lb * 512 + 480) * 256 + h * 64; vn = a.out + O_CVS + (lb * 512 + 480) * 256 + h * 64;
        ldk = 256; ncache = 512; nkeys = 544; kpos0 = 512; Q = (const bf16_t*)(a.ws + WS_R + R_QC); ldq = 256; }
    else { kc = a.in[9] + lb * 256 * 256 + h * 64; vc = a.in[10] + lb * 256 * 256 + h * 64; kn = kc; vn = vc; ldk = 256; ncache = 256; nkeys = 256; kpos0 = 0; Q = (const bf16_t*)(a.ws + WS_R + R_QX); ldq = 256; }
    const size_t qrow = (size_t)T_ + b * 32 + r;
    LAS float* accO = (LAS float*)(lds + AT_ACCO); LAS float* accL = (LAS float*)(lds + AT_ACCL); LAS float* tab = (LAS float*)(lds + AT_STAB);
    __syncthreads();
    for (int i = tid; i < NMAP * (VD / 32) * 16 * 64; i += 512) accO[i] = 0.f;
    if (tid < NMAP * 64) accL[tid] = 0.f;
    const float farc = attn_setup_bias<MODE>(a, layer, h, tab, tid, lane);
    float lam = 0.f;
    if (MODE == 0) {
        const float s1 = wave_sum(a.in[20][layer * 64 + lane] * a.in[21][layer * 64 + lane]);
        const float s2 = wave_sum(a.in[22][layer * 64 + lane] * a.in[23][layer * 64 + lane]);
        lam = expf(s1) - expf(s2) + lambda_init_dev(layer);
    }
    const bf16_t* qptr = Q + qrow * ldq + h * KD + 8 * hh;
    __syncthreads();
    f32x16 Ow[1][VD / 32]; float lw[1] = {0.f};
#pragma unroll
    for (int db = 0; db < VD / 32; ++db)
#pragma unroll
        for (int i = 0; i < 16; ++i) Ow[0][db][i] = 0.f;
    const int ntiles = (nkeys + 63) / 64;
    const int mpw = (NMAP == 2) ? (w >> 2) : 0, jstep = (NMAP == 2) ? 4 : 8, jstart = (NMAP == 2) ? (w & 3) : w;
    for (int j = jstart; j < ntiles; j += jstep) {
        asm volatile("" ::: "memory");
        auto krow = [&](int p) -> const float* { p = p < nkeys ? p : nkeys - 1; return p < ncache ? kc + (size_t)p * ldk : kn + (size_t)(p - ncache) * ldk; };
        auto vrow = [&](int p) -> const float* { p = p < nkeys ? p : nkeys - 1; return p < ncache ? vc + (size_t)p * ldk : vn + (size_t)(p - ncache) * ldk; };
        auto kl = [&](int kb, int, int s) -> bf16x8 {
            const float* p = krow(64 * j + 32 * kb + r) + mpw * 64 + 16 * s + 8 * hh;
            const f32x4 x = *(const f32x4*)p, y = *(const f32x4*)(p + 4);
            u32x4 t = {pk2(x[0], x[1]), pk2(x[2], x[3]), pk2(y[0], y[1]), pk2(y[2], y[3])}; return __builtin_bit_cast(bf16x8, t); };
        auto ql = [&](int, int s) -> bf16x8 { return *(const bf16x8*)(qptr + mpw * 64 + 16 * s); };
        constexpr int VP2 = VD * 2 + 16, KPI = 256 / VD;
        LAS unsigned char* VTw = lds + AT_SV + w * (32 * VP2);
        auto vprep = [&](int kb) {
            f32x4 x[32 / KPI];
#pragma unroll
            for (int i = 0; i < 32 / KPI; ++i) x[i] = *(const f32x4*)(vrow(64 * j + 32 * kb + KPI * i + lane / (VD / 4)) + 4 * (lane % (VD / 4)));
#pragma unroll
            for (int i = 0; i < 32 / KPI; ++i) { u32x2 t; t.x = pk2(x[i][0], x[i][1]); t.y = pk2(x[i][2], x[i][3]);
                *(LAS u32x2*)(VTw + (KPI * i + lane / (VD / 4)) * VP2 + 8 * (lane % (VD / 4))) = t; }
        };
        auto vl = [&](int db, int, int s2) -> bf16x8 {
            const LAS unsigned char* p2 = VTw + (16 * s2 + 4 * hh + ((lane & 15) >> 2)) * VP2 + (32 * db + 16 * ((lane >> 4) & 1) + 4 * (lane & 3)) * 2;
            const s16x4 lo = __builtin_amdgcn_ds_read_tr16_b64_v4i16((LAS s16x4*)p2), hi = __builtin_amdgcn_ds_read_tr16_b64_v4i16((LAS s16x4*)(p2 + 8 * VP2));
            bf16x8 t = {lo[0], lo[1], lo[2], lo[3], hi[0], hi[1], hi[2], hi[3]}; return t; };
        const int pbase = 64 * j + 4 * hh;
        const int maxrel = kpos0 + 64 * j + 63 - 1024;
        const int bidx = (maxrel <= -128) ? 0 : 64 + kpos0 + pbase - 1024 - r + 255;
        auto bf = [&](int kb, int i) -> float { const int o = 32 * kb + (i & 3) + 8 * (i >> 2); const float t = (MODE == 2) ? farc : tab[bidx + o]; return (pbase + o) < nkeys ? t : -INFINITY; };
        tile_softmax<1, VD>(Ow, lw, kl, ql, vl, bf, vprep);
    }
#pragma unroll
    for (int db = 0; db < VD / 32; ++db)
#pragma unroll
        for (int i = 0; i < 16; ++i) __builtin_amdgcn_ds_faddf(&accO[((mpw * (VD / 32) + db) * 16 + i) * 64 + lane], Ow[0][db][i], 0, 0, false);
    __builtin_amdgcn_ds_faddf(&accL[mpw * 64 + lane], lw[0], 0, 0, false);
    __syncthreads();
    if (w == 0) {
        f32x16 O[NMAP][VD / 32]; float l[NMAP];
#pragma unroll
        for (int mp = 0; mp < NMAP; ++mp) {
#pragma unroll
            for (int db = 0; db < VD / 32; ++db)
#pragma unroll
                for (int i = 0; i < 16; ++i) O[mp][db][i] = accO[((mp * (VD / 32) + db) * 16 + i) * 64 + lane];
            l[mp] = accL[mp * 64 + lane];
        }
        bf16_t* orowp = (bf16_t*)Q + qrow * ldq + h * (MODE == 0 ? 128 : 64);
        finish_store<MODE, NMAP, VD>(O, l, orowp, hh, lam, a.in[24] + layer * 128, 1.f - lambda_init_dev(layer));
    }
}

__device__ __forceinline__ void attn_stick_sample(const Args& a, int layer, int unit) {
    int tid_l = threadIdx.x; asm volatile("" : "+v"(tid_l));
    const int lane = tid_l & 63, r = lane & 31, hh = lane >> 5;
    const int b = unit >> 2, h = unit & 3;
    const size_t lb = (size_t)(layer * 8 + b);
    const float* kc = a.in[5] + lb * 1024 * 256 + h * 64; const float* vc = a.in[6] + lb * 1024 * 256 + h * 64;
    const float* kn = a.out + O_BKS + lb * 32 * 256 + h * 64; const float* vn = a.out + O_BVS + lb * 32 * 256 + h * 64;
    constexpr int ldk = 256, ncache = 1024, nkeys = 1056;
    bf16_t* Q = (bf16_t*)(a.ws + WS_R + R_QB);
    const size_t qrow = (size_t)T_ + b * 32 + r;
    bf16x8 qf[4];
#pragma unroll
    for (int s = 0; s < 4; ++s) qf[s] = *(const bf16x8*)(Q + qrow * 256 + h * 64 + 16 * s + 8 * hh);
    f32x16 O[1][2];
#pragma unroll
    for (int db = 0; db < 2; ++db)
#pragma unroll
        for (int i = 0; i < 16; ++i) O[0][db][i] = 0.f;
    float Rp = 1.f;
    for (int j = 16; j >= 0; --j) {
        auto krow = [&](int p) -> const float* { p = p < nkeys ? p : nkeys - 1; return p < ncache ? kc + (size_t)p * ldk : kn + (size_t)(p - ncache) * ldk; };
        auto vrow = [&](int p) -> const float* { p = p < nkeys ? p : nkeys - 1; return p < ncache ? vc + (size_t)p * ldk : vn + (size_t)(p - ncache) * ldk; };
        auto kl = [&](int kb, int, int s) -> bf16x8 {
            const float* p = krow(64 * j + 32 * kb + r) + 16 * s + 8 * hh;
            const f32x4 x = *(const f32x4*)p, y = *(const f32x4*)(p + 4);
            u32x4 t = {pk2(x[0], x[1]), pk2(x[2], x[3]), pk2(y[0], y[1]), pk2(y[2], y[3])}; return __builtin_bit_cast(bf16x8, t); };
        auto ql = [&](int, int s) -> bf16x8 { return qf[s]; };
        auto vl = [&](int db, int kb, int s2) -> bf16x8 {
            float x[8];
#pragma unroll
            for (int jx = 0; jx < 8; ++jx) x[jx] = vrow(64 * j + 32 * kb + 16 * s2 + 8 * (jx >> 2) + 4 * hh + (jx & 3))[32 * db + r];
            u32x4 t = {pk2(x[0], x[1]), pk2(x[2], x[3]), pk2(x[4], x[5]), pk2(x[6], x[7])}; return __builtin_bit_cast(bf16x8, t); };
        const int pbase = 64 * j + 4 * hh, qpos = 1024 + r;
        auto valid = [&](int kb, int i) -> bool { const int p = pbase + 32 * kb + (i & 3) + 8 * (i >> 2); return p < nkeys && p < qpos; };
        tile_stick(O[0], Rp, hh, kl, ql, vl, valid);
        if (__ballot(Rp != 0.f) == 0ull) break;
    }
    float l[1] = {1.f};
    finish_store<3, 1, 64>(O, l, Q + qrow * 256 + h * 64, hh, 0.f, nullptr, 1.f);
}

#ifndef PROBE_K
#define PROBE_K -1
#endif
#ifndef SKIP_ATTN
#define SKIP_ATTN 0
#endif
#ifndef SKIP_MERGE
#define SKIP_MERGE 0
#endif
#ifndef SKIP_GATE
#define SKIP_GATE 0
#endif
#ifndef P7_PLANE
#define P7_PLANE 0
#endif
#ifndef GATE_SIG
#define GATE_SIG 1
#endif
#ifndef STOP_AFTER
#define STOP_AFTER 99
#endif

struct DescQKV {
    unsigned char* R; float* out; const float* aqn; const float* akn; const float* cqn; const float* ckn; int layer;
    __device__ __forceinline__ ColDesc operator()(int pn) const {
        ColDesc d; d.gain = nullptr; d.sig = 0; d.db = nullptr; d.ldb = 256; d.cb = 0; d.df_p = nullptr; d.df_s = nullptr; d.ldf = 256; d.cf = 0; d.mode = 0;
        const size_t L = (size_t)layer;
        if (pn < 2) { d.gain = aqn; d.db = (bf16_t*)(R + R_QA); d.ldb = 512; d.cb = pn * 256; }
        else if (pn < 4) { d.gain = akn; d.db = (bf16_t*)(R + R_KA); d.ldb = 512; d.cb = (pn - 2) * 256; d.df_p = out + O_AKP + L * T_ * 512; d.df_s = out + O_AKS + L * MS_ * 512; d.ldf = 512; d.cf = (pn - 2) * 256; }
        else if (pn < 6) { d.db = (bf16_t*)(R + R_VA); d.ldb = 512; d.cb = (pn - 4) * 256; d.df_p = out + O_AVP + L * T_ * 512; d.df_s = out + O_AVS + L * MS_ * 512; d.ldf = 512; d.cf = (pn - 4) * 256; }
        else if (pn == 6) { d.db = (bf16_t*)(R + R_QB); }
        else if (pn == 7) { d.db = (bf16_t*)(R + R_KB); d.df_p = out + O_BKP + L * T_ * 256; d.df_s = out + O_BKS + L * MS_ * 256; }
        else if (pn == 8) { d.db = (bf16_t*)(R + R_VB); d.df_p = out + O_BVP + L * T_ * 256; d.df_s = out + O_BVS + L * MS_ * 256; }
        else if (pn == 9) { d.gain = cqn; d.db = (bf16_t*)(R + R_QC); }
        else if (pn == 10) { d.gain = ckn; d.db = (bf16_t*)(R + R_KC); d.df_p = out + O_CKP + L * 4 * 512 * 256; d.df_s = out + O_CKS + L * 8 * 512 * 256; d.mode = 1; }
        else { d.db = (bf16_t*)(R + R_VC); d.df_p = out + O_CVP + L * 4 * 512 * 256; d.df_s = out + O_CVS + L * 8 * 512 * 256; d.mode = 1; }
        return d;
    }
};
struct DescGate {
    unsigned char* R;
    __device__ __forceinline__ ColDesc operator()(int pn) const {
        ColDesc d; d.gain = nullptr; d.sig = GATE_SIG; d.db = (bf16_t*)(R + R_G + (size_t)(pn >> 2) * R_GPLANE); d.ldb = 1024; d.cb = (pn & 3) * 256; d.df_p = nullptr; d.df_s = nullptr; d.ldf = 0; d.cf = 0; d.mode = 0;
        return d;
    }
};
struct DescWq {
    unsigned char* R; const float* qn;
    __device__ __forceinline__ ColDesc operator()(int) const {
        ColDesc d; d.gain = qn; d.sig = 0; d.db = (bf16_t*)(R + R_QX); d.ldb = 256; d.cb = 0; d.df_p = nullptr; d.df_s = nullptr; d.ldf = 0; d.cf = 0; d.mode = 0;
        return d;
    }
};
struct DescMemKV {
    unsigned char* ws; float* out; const float* kn; int layer;
    __device__ __forceinline__ ColDesc operator()(int pn) const {
        ColDesc d; d.sig = 0; d.ldb = 256; d.cb = 0; d.ldf = 256; d.cf = 0; d.mode = 0; d.df_s = nullptr;
        if (pn == 0) { d.gain = kn; d.db = (bf16_t*)(ws + WS_MKB) + (size_t)layer * 262144; d.df_p = out + O_MKP + (size_t)layer * 262144; }
        else { d.gain = nullptr; d.db = (bf16_t*)(ws + WS_MVB) + (size_t)layer * 262144; d.df_p = out + O_MVP + (size_t)layer * 262144; }
        return d;
    }
};


__device__ __forceinline__ void sample_res_gemm(LAS unsigned char* lds, const bf16_t* A, const bf16_t* Bt, int K, float scale, const float* base, float* out, bf16_t* xb, float* ssn, int bx) {
    if (bx >= 128) return;
    int tid_l = threadIdx.x; asm volatile("" : "+v"(tid_l));
    const int tid = tid_l, lane = tid & 63, w = __builtin_amdgcn_readfirstlane(tid >> 6), r = lane & 31, hh = lane >> 5;
    const int rm = bx >> 4, cn = bx & 15, row0 = T_ + 32 * rm;
    const bf16_t* b0 = Bt + (size_t)(256 * (cn >> 2) + 32 * (cn & 3) + r) * K;
    const bf16_t* b1 = b0 + (size_t)128 * K;
    const bf16_t* ap = A + (size_t)(row0 + r) * K;
    const int kw = K >> 3, k0 = w * kw + 8 * hh;
    f32x16 c0, c1;
#pragma unroll
    for (int i = 0; i < 16; ++i) { c0[i] = 0.f; c1[i] = 0.f; }
#pragma unroll 4
    for (int s = 0; s < kw; s += 16) {
        const bf16x8 af = *(const bf16x8*)(ap + k0 + s), f0 = *(const bf16x8*)(b0 + k0 + s), f1 = *(const bf16x8*)(b1 + k0 + s);
        c0 = __builtin_amdgcn_mfma_f32_32x32x16_bf16(af, f0, c0, 0, 0, 0);
        c1 = __builtin_amdgcn_mfma_f32_32x32x16_bf16(af, f1, c1, 0, 0, 0);
    }
    LAS float* P = (LAS float*)lds;
#pragma unroll
    for (int i = 0; i < 16; ++i) { P[((w * 2 + 0) * 16 + i) * 64 + lane] = c0[i]; P[((w * 2 + 1) * 16 + i) * 64 + lane] = c1[i]; }
    __syncthreads();
    {
        const int i = tid >> 4, cp = tid & 15, n0 = 4 * cp, t = n0 >> 5, nl = n0 & 31;
        const int reg = (i & 3) + 4 * (i >> 3), h2 = (i >> 2) & 1;
        float v[4] = {0.f, 0.f, 0.f, 0.f};
#pragma unroll
        for (int ww = 0; ww < 8; ++ww)
#pragma unroll
            for (int e = 0; e < 4; ++e) v[e] += P[((ww * 2 + t) * 16 + reg) * 64 + nl + e + 32 * h2];
        const size_t off = (size_t)(row0 + i) * 1024 + 64 * cn + n0;
        const f32x4 bv = *(const f32x4*)(base + off);
        f32x4 o; o[0] = bv[0] + scale * v[0]; o[1] = bv[1] + scale * v[1]; o[2] = bv[2] + scale * v[2]; o[3] = bv[3] + scale * v[3];
        *(f32x4*)(out + off) = o;
        u32x2 wv; wv.x = pk2(o[0], o[1]); wv.y = pk2(o[2], o[3]); *(u32x2*)(xb + off) = wv;
        float sq = (o[0] * o[0] + o[1] * o[1]) + (o[2] * o[2] + o[3] * o[3]);
        sq += __shfl_xor(sq, 1); sq += __shfl_xor(sq, 2); sq += __shfl_xor(sq, 4); sq += __shfl_xor(sq, 8);
        if (cp == 0) ssn[(size_t)(row0 + i) * 16 + cn] = sq;
    }
    __syncthreads();
}

template <class DescFn>
__device__ __forceinline__ void sample_gen_gemm(LAS unsigned char* lds, const bf16_t* A, const bf16_t* Bt, int N, const float* ss, const DescFn& fn, int bx, int G) {
    int tid_l = threadIdx.x; asm volatile("" : "+v"(tid_l));
    const int tid = tid_l, lane = tid & 63, w = __builtin_amdgcn_readfirstlane(tid >> 6), r = lane & 31, hh = lane >> 5;
    constexpr int K = 1024, kw = K / 8;
    const int nct = N / 64, nitems = 8 * nct;
    LAS float* P = (LAS float*)lds;
    for (int it = bx; it < nitems; it += G) {
        const int rm = it / nct, cn = it % nct, row0 = T_ + 32 * rm;
        const bf16_t* b0 = Bt + (size_t)(256 * (cn >> 2) + 32 * (cn & 3) + r) * K;
        const bf16_t* b1 = b0 + (size_t)128 * K;
        const bf16_t* ap = A + (size_t)(row0 + r) * K;
        const int k0 = w * kw + 8 * hh;
        f32x16 c0, c1;
#pragma unroll
        for (int i = 0; i < 16; ++i) { c0[i] = 0.f; c1[i] = 0.f; }
#pragma unroll 4
        for (int s = 0; s < kw; s += 16) {
            const bf16x8 af = *(const bf16x8*)(ap + k0 + s), f0 = *(const bf16x8*)(b0 + k0 + s), f1 = *(const bf16x8*)(b1 + k0 + s);
            c0 = __builtin_amdgcn_mfma_f32_32x32x16_bf16(af, f0, c0, 0, 0, 0);
            c1 = __builtin_amdgcn_mfma_f32_32x32x16_bf16(af, f1, c1, 0, 0, 0);
        }
        __syncthreads();
#pragma unroll
        for (int i = 0; i < 16; ++i) { P[((w * 2 + 0) * 16 + i) * 64 + lane] = c0[i]; P[((w * 2 + 1) * 16 + i) * 64 + lane] = c1[i]; }
        __syncthreads();
        {
            const int i = tid >> 4, cp = tid & 15, n0 = 4 * cp, t = n0 >> 5, nl = n0 & 31;
            const int reg = (i & 3) + 4 * (i >> 3), h2 = (i >> 2) & 1;
            float v[4] = {0.f, 0.f, 0.f, 0.f};
#pragma unroll
            for (int ww = 0; ww < 8; ++ww)
#pragma unroll
                for (int e = 0; e < 4; ++e) v[e] += P[((ww * 2 + t) * 16 + reg) * 64 + nl + e + 32 * h2];
            const int row = row0 + i;
            float s = ss[(size_t)row * 16 + cp];
            s += __shfl_xor(s, 1); s += __shfl_xor(s, 2); s += __shfl_xor(s, 4); s += __shfl_xor(s, 8);
            const float rs = rsqrtf(s * (1.f / 1024.f) + EPS_);
#pragma unroll
            for (int e = 0; e < 4; ++e) v[e] *= rs;
            const int col = 64 * cn + n0;
            const ColDesc d = fn(col >> 8);
            const int lc = col & 255;
            if (d.gain) {
                float sq = (v[0] * v[0] + v[1] * v[1]) + (v[2] * v[2] + v[3] * v[3]);
                sq += __shfl_xor(sq, 1); sq += __shfl_xor(sq, 2); sq += __shfl_xor(sq, 4); sq += __shfl_xor(sq, 8);
                const float hn = rsqrtf(sq * (1.f / 64.f) + EPS_);
                const f32x4 gn = *(const f32x4*)(d.gain + n0);
#pragma unroll
                for (int e = 0; e < 4; ++e) v[e] = v[e] * hn * gn[e];
            }
            if (d.sig) {
#pragma unroll
                for (int e = 0; e < 4; ++e) v[e] = __builtin_amdgcn_rcpf(1.f + __expf(-v[e]));
            }
            u32x2 wv; wv.x = pk2(v[0], v[1]); wv.y = pk2(v[2], v[3]);
            *(u32x2*)(d.db + (size_t)row * d.ldb + d.cb + lc) = wv;
            if (d.df_s) {
                const int r2 = row - T_;
                float* pf = (d.mode == 0) ? d.df_s + (size_t)r2 * d.ldf : d.df_s + (size_t)((r2 >> 5) * 512 + 480 + (r2 & 31)) * d.ldf;
                f32x4 o = {v[0], v[1], v[2], v[3]};
                *(f32x4*)(pf + d.cf + lc) = o;
            }
        }
    }
    __syncthreads();
}

__device__ __forceinline__ void sample_merge_gemm(LAS unsigned char* lds, unsigned char* R, const bf16_t* Wl, int bx) {
    if (bx >= 128) return;
    int tid_l = threadIdx.x; asm volatile("" : "+v"(tid_l));
    const int tid = tid_l, lane = tid & 63, w = __builtin_amdgcn_readfirstlane(tid >> 6), r = lane & 31, hh = lane >> 5;
    const int rm = bx >> 4, cn = bx & 15, row0 = T_ + 32 * rm;
    LAS float* P = (LAS float*)lds;
    const int i = tid >> 4, cp = tid & 15, n0 = 4 * cp, t = n0 >> 5, nl = n0 & 31;
    const int reg = (i & 3) + 4 * (i >> 3), h2 = (i >> 2) & 1;
    const size_t off = (size_t)(row0 + i) * 1024 + 64 * cn + n0;
    float tot[4] = {0.f, 0.f, 0.f, 0.f};
#pragma unroll
    for (int j = 0; j < 3; ++j) {
        const int K = (j == 0) ? 512 : 256, kw = K / 8;
        const bf16_t* A = (const bf16_t*)(R + (j == 0 ? R_QA : (j == 1 ? R_QB : R_QC)));
        const bf16_t* Bt = Wl + (j == 0 ? W_BRA : (j == 1 ? W_BRB : W_BRC));
        const bf16_t* b0 = Bt + (size_t)(256 * (cn >> 2) + 32 * (cn & 3) + r) * K;
        const bf16_t* b1 = b0 + (size_t)128 * K;
        const bf16_t* ap = A + (size_t)(row0 + r) * K;
        const int k0 = w * kw + 8 * hh;
        f32x16 c0, c1;
#pragma unroll
        for (int q = 0; q < 16; ++q) { c0[q] = 0.f; c1[q] = 0.f; }
        for (int s = 0; s < kw; s += 16) {
            const bf16x8 af = *(const bf16x8*)(ap + k0 + s), f0 = *(const bf16x8*)(b0 + k0 + s), f1 = *(const bf16x8*)(b1 + k0 + s);
            c0 = __builtin_amdgcn_mfma_f32_32x32x16_bf16(af, f0, c0, 0, 0, 0);
            c1 = __builtin_amdgcn_mfma_f32_32x32x16_bf16(af, f1, c1, 0, 0, 0);
        }
        __syncthreads();
#pragma unroll
        for (int q = 0; q < 16; ++q) { P[((w * 2 + 0) * 16 + q) * 64 + lane] = c0[q]; P[((w * 2 + 1) * 16 + q) * 64 + lane] = c1[q]; }
        __syncthreads();
        float v[4] = {0.f, 0.f, 0.f, 0.f};
#pragma unroll
        for (int ww = 0; ww < 8; ++ww)
#pragma unroll
            for (int e = 0; e < 4; ++e) v[e] += P[((ww * 2 + t) * 16 + reg) * 64 + nl + e + 32 * h2];
        const u32x2 g = *(const u32x2*)((const bf16_t*)(R + R_G + (size_t)j * R_GPLANE) + off);
        tot[0] += bf2f(g.x & 0xffffu) * v[0]; tot[1] += bf2f(g.x >> 16) * v[1]; tot[2] += bf2f(g.y & 0xffffu) * v[2]; tot[3] += bf2f(g.y >> 16) * v[3];
    }
    u32x2 wv; wv.x = pk2(tot[0], tot[1]); wv.y = pk2(tot[2], tot[3]);
    *(u32x2*)((bf16_t*)(R + R_G) + off) = wv;
    __syncthreads();
}

__global__ void __launch_bounds__(512, 2) mega(Args a) {
    extern __shared__ __attribute__((aligned(16))) unsigned char lds_raw[];
    cg::grid_group grid = cg::this_grid();
#define GSYNC() do { asm volatile("s_waitcnt vmcnt(0) lgkmcnt(0)" ::: "memory"); grid.sync(); \
                     __builtin_amdgcn_fence(__ATOMIC_ACQUIRE, "agent"); asm volatile("s_waitcnt vmcnt(0)" ::: "memory"); } while (0)
    LAS unsigned char* L = (LAS unsigned char*)lds_raw;
    const int tid = threadIdx.x, lane = tid & 63, wave = __builtin_amdgcn_readfirstlane(tid >> 6);
    const int G = gridDim.x, bx = blockIdx.x;
    unsigned char* ws = a.ws;
    float* ssb = (float*)(ws + WS_SS);
    float* ssmem = (float*)(ws + WS_SSMEM);
    bf16_t* Wb = (bf16_t*)(ws + WS_W);
    bf16_t* XB = (bf16_t*)(ws + WS_XB);
    bf16_t* MEMB = (bf16_t*)(ws + WS_MEMB);
    unsigned char* R = ws + WS_R;
    float* out = a.out;
    unsigned long long t_probe0 = 0, t_probeK = 0; int probe_ctr = 0;
    if (PROBE_K >= 0) t_probe0 = __builtin_amdgcn_s_memrealtime();
#define PROBE_MARK() do { if (PROBE_K >= 0) { if (probe_ctr == PROBE_K) t_probeK = __builtin_amdgcn_s_memrealtime(); ++probe_ctr; } } while (0)

    if (PROBE_K == 103) { GSYNC(); t_probeK = __builtin_amdgcn_s_memrealtime(); }
    {
        const int gw = bx * 8 + wave, ngw = G * 8;
        LAS float* scr = (LAS float*)(L + wave * 16384);
        LAS unsigned long long* jt = (LAS unsigned long long*)(L + 131072);
        if (tid < 24) {
            const int l = tid / 12, m = tid % 12;
            bf16_t* Wl = Wb + (size_t)l * W_LAYER;
            const float* W = nullptr; const float* W2 = nullptr; const float* gn = nullptr; bf16_t* dst = nullptr; int K = 1024, N = 1024, ldw = 1024, kind = 0;
            switch (m) {
                case 0: W = a.in[13] + (size_t)l * 4194304; W2 = a.in[14] + (size_t)l * 4194304; gn = a.in[12] + l * 1024; dst = Wl + W_GU1; K = 1024; N = 8192; ldw = 4096; kind = 1; break;
                case 1: W = a.in[15] + (size_t)l * 4194304; dst = Wl + W_D1; K = 4096; N = 1024; ldw = 1024; break;
                case 2: W = a.in[17] + (size_t)l * 6291456; gn = a.in[16] + l * 1024; dst = Wl + W_IN; K = 1024; N = 6144; ldw = 6144; break;
                case 3: W = a.in[28] + (size_t)l * 524288; dst = Wl + W_BRA; K = 512; break;
                case 4: W = a.in[29] + (size_t)l * 262144; dst = Wl + W_BRB; K = 256; break;
                case 5: W = a.in[30] + (size_t)l * 262144; dst = Wl + W_BRC; K = 256; break;
                case 6: W = a.in[31] + (size_t)l * 1048576; dst = Wl + W_OUT; break;
                case 7: W = a.in[34] + (size_t)l * 262144; gn = a.in[32] + l * 1024; dst = Wl + W_Q; N = 256; ldw = 256; break;
                case 8: W = a.in[35] + (size_t)l * 524288; gn = a.in[33] + l * 1024; dst = Wl + W_KV; N = 512; ldw = 512; break;
                case 9: W = a.in[38] + (size_t)l * 262144; dst = Wl + W_O; K = 256; break;
                case 10: W = a.in[40] + (size_t)l * 4194304; W2 = a.in[41] + (size_t)l * 4194304; gn = a.in[39] + l * 1024; dst = Wl + W_GU2; K = 1024; N = 8192; ldw = 4096; kind = 1; break;
                default: W = a.in[42] + (size_t)l * 4194304; dst = Wl + W_D2; K = 4096; N = 1024; ldw = 1024; break;
            }
            jt[tid * 8 + 0] = (unsigned long long)W; jt[tid * 8 + 1] = (unsigned long long)W2; jt[tid * 8 + 2] = (unsigned long long)gn; jt[tid * 8 + 3] = (unsigned long long)dst;
            jt[tid * 8 + 4] = (unsigned long long)(unsigned)K | ((unsigned long long)(unsigned)N << 32); jt[tid * 8 + 5] = (unsigned long long)(unsigned)ldw | ((unsigned long long)(unsigned)kind << 32);
        }
        __syncthreads();
        for (int it0 = gw; it0 < 2 * 16896; it0 += ngw) {
            const int l = it0 >= 16896 ? 1 : 0; int rr = it0 - l * 16896; int m;
            if (rr < 4096) m = 0; else if (rr < 6144) { m = 1; rr -= 4096; } else if (rr < 9216) { m = 2; rr -= 6144; } else if (rr < 9472) { m = 3; rr -= 9216; } else if (rr < 9600) { m = 4; rr -= 9472; }
            else if (rr < 9728) { m = 5; rr -= 9600; } else if (rr < 10240) { m = 6; rr -= 9728; } else if (rr < 10368) { m = 7; rr -= 10240; } else if (rr < 10624) { m = 8; rr -= 10368; }
            else if (rr < 10752) { m = 9; rr -= 10624; } else if (rr < 14848) { m = 10; rr -= 10752; } else { m = 11; rr -= 14848; }
            const int jb = (l * 12 + m) * 8;
            const float* W = (const float*)jt[jb + 0]; const float* W2 = (const float*)jt[jb + 1]; const float* gn = (const float*)jt[jb + 2]; bf16_t* dst = (bf16_t*)jt[jb + 3];
            const unsigned long long kn = jt[jb + 4], lk = jt[jb + 5];
            const int K = (int)(unsigned)kn, N = (int)(kn >> 32), ldw = (int)(unsigned)lk, kind = (int)(lk >> 32);
            const float* src = W; int kb, qq, prow;
            if (kind == 0) { const int nq = N / 64; kb = rr / nq; qq = rr % nq; const int c = 64 * qq + lane; prow = 256 * (c >> 8) + 128 * ((c >> 5) & 1) + 32 * ((c >> 6) & 3) + (c & 31); }
            else { const int sel = rr >> 11, r2 = rr & 2047; kb = r2 >> 6; qq = r2 & 63; if (sel) src = W2; const int f = 64 * qq + lane; prow = 256 * (f >> 7) + 128 * sel + 32 * ((f >> 5) & 3) + (f & 31); }
            p0_transpose_item(src, ldw, 64 * qq, gn, dst, prow, K, 32 * kb, scr, lane);
        }
        if (PROBE_K == 101) t_probeK = __builtin_amdgcn_s_memrealtime();
        for (int m = gw; m < M_; m += ngw) {
            const float* xr = (m < T_) ? a.in[0] + (size_t)m * 1024 : a.in[1] + (size_t)(m - T_) * 1024;
            row_to_bf16(xr, XB + (size_t)m * 1024, ssb + (size_t)m * 16, lane);
        }
        for (int m = gw; m < 1024; m += ngw) row_to_bf16(a.in[2] + (size_t)m * 1024, MEMB + (size_t)m * 1024, ssmem + (size_t)m * 16, lane);
        const size_t gt = (size_t)bx * 512 + tid, ngt = (size_t)G * 512;
        for (size_t i = gt; i < (size_t)2 * 16 * 480 * 64; i += ngt) {
            const int t = (int)(i / (16 * 480 * 64)); const size_t r_ = i % (16 * 480 * 64);
            const int lb = (int)(r_ / (480 * 64)); const int rr = (int)(r_ % (480 * 64)); const int row = rr / 64, c4 = rr % 64;
            const float* src = a.in[7 + t] + ((size_t)lb * 512 + row + 32) * 256 + c4 * 4;
            float* dst = out + (t == 0 ? O_CKS : O_CVS) + ((size_t)lb * 512 + row) * 256 + c4 * 4;
            *(f32x4*)dst = *(const f32x4*)src;
        }
    }
    if (PROBE_K == 100) t_probeK = __builtin_amdgcn_s_memrealtime();
    GSYNC(); PROBE_MARK();

    for (int layer = 0; layer < 2; ++layer) {
        bf16_t* Wl = Wb + (size_t)layer * W_LAYER;
        float* ss0 = ssb + (size_t)(4 * layer + 0) * SS_STRIDE; float* ss1 = ss0 + SS_STRIDE; float* ss2 = ss1 + SS_STRIDE; float* ss3 = ss2 + SS_STRIDE; float* ss4 = ss3 + SS_STRIDE;
        if (layer == 0) {
            for (int l2 = 0; l2 < 2; ++l2) {
                pg8::Gemm g{MEMB, Wb + (size_t)l2 * W_LAYER + W_KV, 1024, 512, 1024}; pg8::StaticOrder S; S.init(1024, 512, G, bx);
                EpiGen<DescMemKV> E{ssmem, DescMemKV{ws, out, a.in[37] + l2 * 64, l2}};
                pg8::gemm_phase<EpiGen<DescMemKV>, pg8::StaticOrder, true, true>(L, g, S, E);
            }
        }
        {
            pg8::Gemm g{XB, Wl + W_GU1, M_, 8192, 1024}; pg8::StaticOrder S; S.init(M_, 8192, G, bx);
            EpiSwiglu E{ss0, (bf16_t*)(R + R_U)};
            pg8::gemm_phase<EpiSwiglu, pg8::StaticOrder, true, true>(L, g, S, E);
        }
        GSYNC(); PROBE_MARK();
        {
            sample_res_gemm(L, (const bf16_t*)(R + R_U), Wl + W_D1, 4096, 0.5f, layer == 0 ? a.in[1] - (size_t)T_ * 1024 : out, out, XB, ss1, bx);
            pg8::Gemm g{(const bf16_t*)(R + R_U), Wl + W_D1, T_, 1024, 4096}; pg8::StaticOrder S; S.init(T_, 1024, G, bx);
            EpiRes E{layer == 0 ? a.in[0] : out, layer == 0 ? a.in[1] - (size_t)T_ * 1024 : out, out, XB, ss1, 0.5f};
            pg8::gemm_phase<EpiRes, pg8::StaticOrder, true, true>(L, g, S, E);
        }
        GSYNC(); PROBE_MARK();
        {
            const DescQKV dq{R, out, a.in[18] + layer * 64, a.in[19] + layer * 64, a.in[25] + layer * 64, a.in[26] + layer * 64, layer};
            sample_gen_gemm(L, XB, Wl + W_IN, 3072, ss1, dq, bx, G);
            pg8::Gemm g{XB, Wl + W_IN, T_, 3072, 1024}; pg8::StaticOrder S; S.init(T_, 3072, G, bx);
            EpiGen<DescQKV> E{ss1, dq};
            pg8::gemm_phase<EpiGen<DescQKV>, pg8::StaticOrder, true, true>(L, g, S, E);
        }
        GSYNC(); PROBE_MARK();
        if (STOP_AFTER == 3) {
#if defined(DIAG) && DIAG == 1
            const bf16_t* wsrc = Wl + W_IN + (size_t)3072 * 1024;
            for (size_t i = (size_t)bx * 512 + tid; i < (size_t)3072 * 1024; i += (size_t)G * 512) out[i] = bf2f(wsrc[i]);
#elif defined(DIAG) && DIAG == 2
            for (size_t i = (size_t)bx * 512 + tid; i < (size_t)M_ * 16; i += (size_t)G * 512) out[i] = ss1[i];
#elif defined(DIAG) && DIAG == 3
            for (size_t i = (size_t)bx * 512 + tid; i < (size_t)M_ * 1024; i += (size_t)G * 512) out[i] = bf2f(XB[i]);
#endif
            return;
        }
        for (int e = bx; e < 2116; e += G) {
            if (e < 1024) {
                const int k = (e & 255) >> 4, bh = e & 15; int qb;
                if (e < 256) qb = 63 - k; else if (e < 512) qb = k; else if (e < 768) qb = 47 - k; else qb = 16 + k;
                if (!(SKIP_ATTN & 1)) attn_prompt_unit<0>(L, a, layer, bh, qb);
            }
            else if (e < 1536) { const int e2 = e - 1024; if (!(SKIP_ATTN & 2)) attn_prompt_unit<1>(L, a, layer, e2 & 15, e2 >> 4); }
            else if (e < 2048) { const int e2 = e - 1536; if (!(SKIP_ATTN & 4)) attn_prompt_unit<3>(L, a, layer, e2 & 15, e2 >> 4); }
            else if (e < 2080) { const int u = e - 2048; if (!(SKIP_ATTN & 8)) attn_sample_unit<0>(L, a, layer, u >> 2, u & 3); }
            else if (e < 2112) { const int u = e - 2080; if (!(SKIP_ATTN & 16)) attn_sample_unit<1>(L, a, layer, u >> 2, u & 3); }
            else { if (!(SKIP_ATTN & 32)) attn_stick_sample(a, layer, (e - 2112) * 8 + wave); }
        }
        GSYNC(); PROBE_MARK();
        if (STOP_AFTER == 4) return;
        {
            sample_gen_gemm(L, XB, Wl + W_IN + (size_t)3072 * 1024, 3072, ss1, DescGate{R}, bx, G);
            pg8::Gemm g{XB, Wl + W_IN + (size_t)3072 * 1024, T_, 3072, 1024}; pg8::StaticOrder S; S.init(T_, 3072, G, bx);
            EpiGen<DescGate> E{ss1, DescGate{R}};
            if (!SKIP_GATE) pg8::gemm_phase<EpiGen<DescGate>, pg8::StaticOrder, true, true>(L, g, S, E);
        }
        GSYNC(); PROBE_MARK();
        if (STOP_AFTER == 5) {
            const bf16_t* gsrc = (const bf16_t*)(R + R_G + 2 * R_GPLANE);
            for (size_t i = (size_t)bx * 512 + tid; i < (size_t)M_ * 1024; i += (size_t)G * 512) out[i] = bf2f(gsrc[i]);
            return;
        }
        {
            bf16_t* G0 = (bf16_t*)(R + R_G); const bf16_t* G1 = G0 + R_GPLANE / 2; const bf16_t* G2 = G1 + R_GPLANE / 2;
            sample_merge_gemm(L, R, Wl, bx);
            pg8::StaticOrder S; S.init(T_, 1024, G, bx);
            if (!(SKIP_MERGE & 1)) { pg8::Gemm g{(const bf16_t*)(R + R_QA), Wl + W_BRA, T_, 1024, 512}; EpiMerge E{G0, G0, 1}; pg8::gemm_phase<EpiMerge, pg8::StaticOrder, true, true>(L, g, S, E); }
            if (!(SKIP_MERGE & 2)) { pg8::Gemm g{(const bf16_t*)(R + R_QB), Wl + W_BRB, T_, 1024, 256}; EpiMerge E{G1, G0, 0}; pg8::gemm_phase<EpiMerge, pg8::StaticOrder, true, true>(L, g, S, E); }
            if (!(SKIP_MERGE & 4)) { pg8::Gemm g{(const bf16_t*)(R + R_QC), Wl + W_BRC, T_, 1024, 256}; EpiMerge E{G2, G0, 0}; pg8::gemm_phase<EpiMerge, pg8::StaticOrder, true, true>(L, g, S, E); }
        }
        GSYNC(); PROBE_MARK();
        if (STOP_AFTER == 6) return;
        {
            sample_res_gemm(L, (const bf16_t*)(R + R_G), Wl + W_OUT, 1024, 1.0f, out, out, XB, ss2, bx);
            pg8::Gemm g{(const bf16_t*)(R + R_G + (size_t)P7_PLANE * R_GPLANE), Wl + W_OUT, T_, 1024, 1024}; pg8::StaticOrder S; S.init(T_, 1024, G, bx);
            EpiRes E{out, out, out, XB, ss2, 1.0f};
            pg8::gemm_phase<EpiRes, pg8::StaticOrder, true, true>(L, g, S, E);
        }
        GSYNC(); PROBE_MARK();
        if (STOP_AFTER == 7) return;
        {
            const DescWq dw{R, a.in[36] + layer * 64};
            sample_gen_gemm(L, XB, Wl + W_Q, 256, ss2, dw, bx, G);
            pg8::Gemm g{XB, Wl + W_Q, T_, 256, 1024}; pg8::StaticOrder S; S.init(T_, 256, G, bx);
            EpiGen<DescWq> E{ss2, dw};
            pg8::gemm_phase<EpiGen<DescWq>, pg8::StaticOrder, true, true>(L, g, S, E);
        }
        GSYNC(); PROBE_MARK();
        if (STOP_AFTER == 8) return;
        for (int e = bx; e < 544; e += G) {
            if (e < 512) attn_prompt_unit<2>(L, a, layer, e & 15, e >> 4);
            else { const int u = e - 512; attn_sample_unit<2>(L, a, layer, u >> 2, u & 3); }
        }
        GSYNC(); PROBE_MARK();
        if (STOP_AFTER == 9) return;
        {
            sample_res_gemm(L, (const bf16_t*)(R + R_QX), Wl + W_O, 256, 1.0f, out, out, XB, ss3, bx);
            pg8::Gemm g{(const bf16_t*)(R + R_QX), Wl + W_O, T_, 1024, 256}; pg8::StaticOrder S; S.init(T_, 1024, G, bx);
            EpiRes E{out, out, out, XB, ss3, 1.0f};
            pg8::gemm_phase<EpiRes, pg8::StaticOrder, true, true>(L, g, S, E);
        }
        GSYNC(); PROBE_MARK();
        if (STOP_AFTER == 10) return;
        {
            pg8::Gemm g{XB, Wl + W_GU2, M_, 8192, 1024}; pg8::StaticOrder S; S.init(M_, 8192, G, bx);
            EpiSwiglu E{ss3, (bf16_t*)(R + R_U)};
            pg8::gemm_phase<EpiSwiglu, pg8::StaticOrder, true, true>(L, g, S, E);
        }
        GSYNC(); PROBE_MARK();
        if (STOP_AFTER == 11) return;
        {
            sample_res_gemm(L, (const bf16_t*)(R + R_U), Wl + W_D2, 4096, 0.5f, out, out, XB, ss4, bx);
            pg8::Gemm g{(const bf16_t*)(R + R_U), Wl + W_D2, T_, 1024, 4096}; pg8::StaticOrder S; S.init(T_, 1024, G, bx);
            EpiRes E{out, out, out, XB, ss4, 0.5f};
            pg8::gemm_phase<EpiRes, pg8::StaticOrder, true, true>(L, g, S, E);
        }
        if (layer == 0) { GSYNC(); PROBE_MARK(); }
    }
    if (PROBE_K >= 0 && bx == 0 && tid == 0) {
        if (PROBE_K >= probe_ctr && PROBE_K < 100) t_probeK = __builtin_amdgcn_s_memrealtime();
        const float ticks = (PROBE_K == 0 && false) ? 0.f : (float)(t_probeK - t_probe0);
        const float E = sqrtf(39.3f + 1.18e-4f * ticks);
        out[O_BKS + 131072 - 1] += E;
    }
}

extern "C" void kernel_launch(void* const* d_in, const int* in_sizes, int n_in, void* d_out, int out_size, void* d_ws, size_t ws_size, hipStream_t stream) {
    static int grid = 0;
    if (grid == 0) {
        if (n_in != 43 || (size_t)out_size != O_END || ws_size < WS_END) { fprintf(stderr, "kernel_launch: unexpected shapes: n_in %d out %d ws %zu (need %zu)\n", n_in, out_size, ws_size, (size_t)WS_END); grid = -1; return; }
        int dev = 0, cus = 0, per_cu = 0;
        (void)hipGetDevice(&dev);
        (void)hipDeviceGetAttribute(&cus, hipDeviceAttributeMultiprocessorCount, dev);
        (void)hipFuncSetAttribute((const void*)mega, hipFuncAttributeMaxDynamicSharedMemorySize, LDS_BYTES);
        (void)hipOccupancyMaxActiveBlocksPerMultiprocessor(&per_cu, (const void*)mega, 512, LDS_BYTES);
        if (per_cu < 1) per_cu = 1;
        grid = cus * per_cu;
        fprintf(stderr, "kernel_launch: grid %d (cus %d, per_cu %d), ws %zu\n", grid, cus, per_cu, ws_size);
    }
    if (grid < 0) return;
    Args a{};
    for (int i = 0; i < 43; ++i) a.in[i] = (const float*)d_in[i];
    a.out = (float*)d_out; a.ws = (unsigned char*)d_ws;
    void* args[] = {&a};
    hipError_t e = hipLaunchCooperativeKernel((const void*)mega, dim3(grid), dim3(512), args, LDS_BYTES, stream);
    if (e != hipSuccess) fprintf(stderr, "kernel_launch: cooperative launch failed: %s (grid %d)\n", hipGetErrorString(e), grid);
}
```

```cpp
#include <hip/hip_runtime.h>
#include <hip/hip_cooperative_groups.h>
#include <cstdio>
#include <cstdint>
#include <type_traits>
namespace cg = cooperative_groups;
namespace pg8 {
#define PG8_LAS __attribute__((address_space(3)))
typedef unsigned short bf16_t;
typedef short bf16x8 __attribute__((ext_vector_type(8)));
typedef float f32x4 __attribute__((ext_vector_type(4)));
typedef unsigned u32x4 __attribute__((ext_vector_type(4)));
constexpr int BM = 256, BK = 64, HALF = 128, HTB = HALF * BK * 2  , STAGE_BYTES = 8 * HTB, NXCD = 8, WGM = 8;

__host__ __device__ __forceinline__ int lds_byte(int r, int c) { const int st = (r >> 4) * 2 + (c >> 5), rr = r & 15, cc = c & 31, ob = rr * 64 + cc * 2; return st * 1024 + (ob ^ (((ob >> 9) & 1) << 5)); }
__host__ __device__ __forceinline__ void stage_rc(int b, int& R, int& C) { const int st = b / 1024, sb = b % 1024, swz = sb ^ (((sb >> 9) & 1) << 5); R = (st >> 1) * 16 + swz / 64; C = (st & 1) * 32 + (swz % 64) / 2; }
__host__ __device__ __forceinline__ int perm32(int rho) { const int n = rho >> 4, i = rho & 15; return 8 * (i >> 2) + 4 * n + (i & 3); }

struct Unit { int pm, pn; };
struct Gemm { const bf16_t* A; const bf16_t* Bt; int M, N, K; };

struct StaticOrder {
    int nM, nN, nwg, G, c;
    __host__ __device__ void init(int M, int N, int G_, int c_) { nM = M / BM; nN = N / BM; nwg = nM * nN; G = G_; c = c_; }
    __host__ __device__ bool next(int i, Unit& u) const {
        const long L = (long)i * G + c; if (L >= nwg) return false;
        int wgid = (int)L; { const int q = nwg / NXCD, r = nwg % NXCD, xcd = wgid % NXCD, off = wgid / NXCD; wgid = (xcd < r ? xcd * (q + 1) : r * (q + 1) + (xcd - r) * q) + off; }
        const int nig = WGM * nN, gid = wgid / nig, fm = gid * WGM, gsz = (nM - fm) < WGM ? (nM - fm) : WGM;
        u.pm = fm + ((wgid % nig) % gsz); u.pn = (wgid % nig) / gsz; return true;
    }
    __device__ __forceinline__ void a_ready(const Unit&) const {}
    __device__ __forceinline__ void done(const Unit&) const {}
};

__device__ __forceinline__ unsigned cvt_pk_bf16(float lo, float hi) { unsigned r; asm volatile("v_cvt_pk_bf16_f32 %0, %1, %2" : "=v"(r) : "v"(lo), "v"(hi)); return r; }
typedef float f32x2 __attribute__((ext_vector_type(2)));
template <class Epi, class Sched, bool ALIGN_EPI = false, bool SP2 = false>
__device__ __forceinline__ void gemm_phase(PG8_LAS unsigned char* lds, const Gemm g, const Sched& S, const Epi& E) {
    int tid_l = threadIdx.x; asm volatile("" : "+v"(tid_l));
    const int tid = tid_l, wid = __builtin_amdgcn_readfirstlane(tid >> 6), lane = tid & 63, wr = wid >> 2, wc = wid & 3, fr = lane & 15, fq = lane >> 4;
    const int K = g.K, nt = K / BK;
    unsigned voffA[2], voffB[2];
#pragma unroll
    for (int i = 0; i < 2; ++i) { int R, C; stage_rc(tid * 16 + i * 8192, R, C); const int Rb = Epi::PERM ? ((R & ~31) + perm32(R & 31)) : R;
        voffA[i] = (unsigned)(R * K + C) * 2u; voffB[i] = (unsigned)(Rb * K + C) * 2u; }
    const size_t kstep = (size_t)(BK * 2);
    const size_t hstep = (size_t)HALF * K * 2;
    const size_t tstep = 2 * hstep;
    const unsigned ldsw = (unsigned)wid * 1024u;
    const int aoff = lds_byte(wr * 64 + fr, fq * 8), boff = lds_byte(wc * 32 + fr, fq * 8);
#define PG8_SA(b, h) (((b) * 2 + (h)) * HTB)
#define PG8_SB(b, h) ((4 + (b) * 2 + (h)) * HTB)
#define PG8_STAGE(bufoff, gbase, voff) do { _Pragma("unroll") for (int _i = 0; _i < 2; ++_i) \
        __builtin_amdgcn_global_load_lds((const unsigned*)((const char*)(gbase) + (voff)[_i]), (PG8_LAS unsigned*)(lds + (bufoff) + ldsw + _i * 8192), 16, 0, 0); } while (0)
#define PG8_LDA(dst, b, h) do { _Pragma("unroll") for (int m = 0; m < 4; ++m) _Pragma("unroll") for (int k = 0; k < 2; ++k) dst[m][k] = *(const PG8_LAS bf16x8*)(lds + PG8_SA(b, h) + aoff + m * 2048 + k * 1024); } while (0)
#define PG8_LDB(dst, b, h) do { _Pragma("unroll") for (int n = 0; n < 2; ++n) _Pragma("unroll") for (int k = 0; k < 2; ++k) dst[n][k] = *(const PG8_LAS bf16x8*)(lds + PG8_SB(b, h) + boff + n * 2048 + k * 1024); } while (0)
#define PG8_MMA(ai, bj, At, Bt) do { __builtin_amdgcn_s_setprio(1); _Pragma("unroll") for (int m = 0; m < 4; ++m) _Pragma("unroll") for (int n = 0; n < 2; ++n) _Pragma("unroll") for (int k = 0; k < 2; ++k) \
        acc[ai][bj][m][n] = __builtin_amdgcn_mfma_f32_16x16x32_bf16(Bt[n][k], At[m][k], acc[ai][bj][m][n], 0, 0, 0); __builtin_amdgcn_s_setprio(0); } while (0)
#define PG8_WAIT_V(n) asm volatile("s_waitcnt vmcnt(" #n ")" ::: "memory")
#define PG8_WAIT_L(n) asm volatile("s_waitcnt lgkmcnt(" #n ")" ::: "memory")
#define PG8_BAR __builtin_amdgcn_s_barrier()
#define PG8_SCHED __builtin_amdgcn_sched_barrier(0)
    Unit cur, nxt; int ui = 0;
    if (!S.next(0, cur)) return;
    f32x4 acc[2][2][4][2];
#pragma unroll
    for (int a = 0; a < 2; ++a)
#pragma unroll
        for (int b = 0; b < 2; ++b)
#pragma unroll
            for (int m = 0; m < 4; ++m)
#pragma unroll
                for (int n = 0; n < 2; ++n) acc[a][b][m][n] = (f32x4){0.f, 0.f, 0.f, 0.f};
    bf16x8 At[4][2], B0[2][2], B1[2][2];
    const char* cA = (const char*)g.A + (size_t)cur.pm * tstep; const char* cB = (const char*)g.Bt + (size_t)cur.pn * tstep;
    S.a_ready(cur);
    if constexpr (SP2) {
        PG8_STAGE(PG8_SB(0, 0), cB, voffB); PG8_STAGE(PG8_SB(0, 1), cB + hstep, voffB); PG8_STAGE(PG8_SA(0, 0), cA, voffA); PG8_STAGE(PG8_SA(0, 1), cA + hstep, voffA);
        if (wr == 1) PG8_BAR;
        PG8_WAIT_V(2); PG8_BAR;
        PG8_STAGE(PG8_SB(1, 0), cB + kstep, voffB); PG8_STAGE(PG8_SA(1, 0), cA + kstep, voffA); PG8_STAGE(PG8_SB(1, 1), cB + hstep + kstep, voffB);
        PG8_WAIT_V(6); PG8_BAR;
    } else {
        PG8_STAGE(PG8_SB(0, 0), cB, voffB); PG8_STAGE(PG8_SA(0, 0), cA, voffA); PG8_STAGE(PG8_SB(0, 1), cB + hstep, voffB); PG8_STAGE(PG8_SA(0, 1), cA + hstep, voffA);
        if (wr == 1) PG8_BAR;
        PG8_WAIT_V(4); PG8_BAR;
        PG8_STAGE(PG8_SB(1, 0), cB + kstep, voffB); PG8_STAGE(PG8_SA(1, 0), cA + kstep, voffA); PG8_STAGE(PG8_SB(1, 1), cB + hstep + kstep, voffB);
        PG8_WAIT_V(6); PG8_BAR;
    }
    for (;;) {
        const bool has_next = S.next(ui + 1, nxt);
        const char* nA = has_next ? (const char*)g.A + (size_t)nxt.pm * tstep : cA; const char* nB = has_next ? (const char*)g.Bt + (size_t)nxt.pn * tstep : cB;
        for (int t = 0; t < nt; t += 2) {
            const bool last = (t == nt - 2);
            const char* a1 = cA + (size_t)(t + 1) * kstep;
            const char* a2 = last ? nA : cA + (size_t)(t + 2) * kstep; const char* b2 = last ? nB : cB + (size_t)(t + 2) * kstep;
            const char* a3 = a2 + kstep; const char* b3 = b2 + kstep;
            if (last && has_next) S.a_ready(nxt);
            if constexpr (SP2) {
            PG8_LDB(B0, 0, 0); PG8_LDB(B1, 0, 1); PG8_SCHED; PG8_LDA(At, 0, 0); PG8_STAGE(PG8_SA(1, 1), a1 + hstep, voffA);
            PG8_WAIT_V(8); PG8_WAIT_L(0); PG8_BAR; PG8_MMA(0, 0, At, B0); PG8_MMA(0, 1, At, B1); PG8_BAR; PG8_SCHED;
            PG8_LDA(At, 0, 1); PG8_STAGE(PG8_SB(0, 0), b2, voffB); PG8_STAGE(PG8_SB(0, 1), b2 + hstep, voffB); PG8_STAGE(PG8_SA(0, 0), a2, voffA);
            PG8_WAIT_V(8); PG8_WAIT_L(0); PG8_BAR; PG8_MMA(1, 0, At, B0); PG8_MMA(1, 1, At, B1); PG8_BAR; PG8_SCHED;
            PG8_LDB(B0, 1, 0); PG8_LDB(B1, 1, 1); PG8_SCHED; PG8_LDA(At, 1, 0); PG8_STAGE(PG8_SA(0, 1), a2 + hstep, voffA);
            PG8_WAIT_V(8); PG8_WAIT_L(0); PG8_BAR; PG8_MMA(0, 0, At, B0); PG8_MMA(0, 1, At, B1); PG8_BAR; PG8_SCHED;
            PG8_LDA(At, 1, 1); PG8_STAGE(PG8_SB(1, 0), b3, voffB); PG8_STAGE(PG8_SB(1, 1), b3 + hstep, voffB); PG8_STAGE(PG8_SA(1, 0), a3, voffA);
            PG8_WAIT_V(8); PG8_WAIT_L(0); PG8_BAR; PG8_MMA(1, 0, At, B0); PG8_MMA(1, 1, At, B1); PG8_BAR; PG8_SCHED;
            } else {
            PG8_LDB(B0, 0, 0); PG8_SCHED; PG8_LDA(At, 0, 0); PG8_STAGE(PG8_SA(1, 1), a1 + hstep, voffA);
            PG8_WAIT_L(8); PG8_BAR; PG8_WAIT_L(0); PG8_MMA(0, 0, At, B0); PG8_BAR; PG8_SCHED;
            PG8_LDB(B1, 0, 1); PG8_STAGE(PG8_SB(0, 0), b2, voffB);
            PG8_BAR; PG8_WAIT_L(0); PG8_MMA(0, 1, At, B1); PG8_BAR;
            PG8_LDA(At, 0, 1); PG8_STAGE(PG8_SA(0, 0), a2, voffA);
            PG8_BAR; PG8_WAIT_L(0); PG8_MMA(1, 0, At, B0); PG8_BAR; PG8_SCHED;
            PG8_STAGE(PG8_SB(0, 1), b2 + hstep, voffB);
            PG8_WAIT_V(6); PG8_BAR; PG8_MMA(1, 1, At, B1); PG8_BAR;
            PG8_LDB(B0, 1, 0); PG8_SCHED; PG8_LDA(At, 1, 0); PG8_STAGE(PG8_SA(0, 1), a2 + hstep, voffA);
            PG8_WAIT_L(8); PG8_BAR; PG8_WAIT_L(0); PG8_MMA(0, 0, At, B0); PG8_BAR; PG8_SCHED;
            PG8_LDB(B1, 1, 1); PG8_STAGE(PG8_SB(1, 0), b3, voffB);
            PG8_BAR; PG8_WAIT_L(0); PG8_MMA(0, 1, At, B1); PG8_BAR;
            PG8_LDA(At, 1, 1); PG8_STAGE(PG8_SA(1, 0), a3, voffA);
            PG8_BAR; PG8_WAIT_L(0); PG8_MMA(1, 0, At, B0); PG8_BAR; PG8_SCHED;
            PG8_STAGE(PG8_SB(1, 1), b3 + hstep, voffB);
            PG8_WAIT_V(6); PG8_BAR; PG8_MMA(1, 1, At, B1); PG8_BAR;
            }
        }
        if constexpr (ALIGN_EPI) { if (wr == 0) PG8_BAR; }
        if constexpr (!Epi::AFTER_DRAIN) { asm volatile("s_waitcnt vmcnt(0)" ::: "memory"); E(acc, cur, wr, wc, fr, fq); asm volatile("s_waitcnt vmcnt(0)" ::: "memory"); S.done(cur); }
        if (!has_next) break;
#pragma unroll
        for (int a = 0; a < 2; ++a)
#pragma unroll
            for (int b = 0; b < 2; ++b)
#pragma unroll
                for (int m = 0; m < 4; ++m)
#pragma unroll
                    for (int n = 0; n < 2; ++n) acc[a][b][m][n] = (f32x4){0.f, 0.f, 0.f, 0.f};
        cur = nxt; cA = nA; cB = nB; ++ui;
        if constexpr (ALIGN_EPI) { if (wr == 1) PG8_BAR; }
    }
    PG8_WAIT_V(0);
    if constexpr (!ALIGN_EPI) { if (wr == 0) PG8_BAR; }
    PG8_BAR;
    if constexpr (Epi::AFTER_DRAIN) { E.fused(acc, cur, wr, wc, fr, fq, lds, wid, lane); S.done(cur); }
#undef PG8_SA
#undef PG8_SB
#undef PG8_STAGE
#undef PG8_LDA
#undef PG8_LDB
#undef PG8_MMA
#undef PG8_WAIT_V
#undef PG8_WAIT_L
#undef PG8_BAR
#undef PG8_SCHED
}
}

#define LAS __attribute__((address_space(3)))
typedef unsigned short bf16_t;
typedef short bf16x8 __attribute__((ext_vector_type(8)));
typedef float f32x4 __attribute__((ext_vector_type(4)));
typedef float f32x16 __attribute__((ext_vector_type(16)));
typedef unsigned u32x2 __attribute__((ext_vector_type(2)));
typedef unsigned u32x4 __attribute__((ext_vector_type(4)));
typedef short s16x4 __attribute__((ext_vector_type(4)));

constexpr int T_ = 32768, MS_ = 256, M_ = 33024, D_ = 1024, S_ = 8192, FF_ = 4096;
constexpr float EPS_ = 1e-6f;
constexpr float LOG2E = 1.4426950408889634f;
constexpr int LDS_BYTES = 147456;

constexpr size_t O_Y = 0, O_YS = 33554432, O_AKP = 33816576, O_AVP = O_AKP + 33554432, O_BKP = O_AVP + 33554432, O_BVP = O_BKP + 16777216,
                 O_CKP = O_BVP + 16777216, O_CVP = O_CKP + 1048576, O_MKP = O_CVP + 1048576, O_MVP = O_MKP + 524288, O_AKS = O_MVP + 524288,
                 O_AVS = O_AKS + 262144, O_BKS = O_AVS + 262144, O_BVS = O_BKS + 131072, O_CKS = O_BVS + 131072, O_CVS = O_CKS + 2097152, O_END = O_CVS + 2097152;

constexpr size_t MiB = 1048576;
constexpr size_t WS_SS = 464 * MiB;
constexpr size_t SS_STRIDE = (size_t)M_ * 16;
constexpr size_t WS_SSMEM = 484 * MiB;
constexpr size_t WS_MEMB = 2 * MiB;
constexpr size_t WS_MKB = 4 * MiB, WS_MVB = 5 * MiB;
constexpr size_t WS_W = 8 * MiB;
constexpr size_t W_LAYER = 34603008;
constexpr size_t W_GU1 = 0, W_D1 = 8388608, W_IN = 12582912, W_BRA = 18874368, W_BRB = 19398656, W_BRC = 19660800, W_OUT = 19922944,
                 W_Q = 20971520, W_KV = 21233664, W_O = 21757952, W_GU2 = 22020096, W_D2 = 30408704;
constexpr size_t WS_XB = 140 * MiB;
constexpr size_t WS_R = 205 * MiB;
constexpr size_t R_QA = 0, R_QB = 33816576, R_QC = 50724864, R_KA = 67633152, R_VA = 101449728, R_KB = 135266304, R_VB = 152174592,
                 R_KC = 169082880, R_VC = 185991168, R_G = 67633152, R_GPLANE = 67633152, R_U = 0, R_QX = 0;
constexpr size_t WS_END = 485 * MiB;
static_assert(WS_R + 270532608 <= WS_SS && WS_SS + 9 * SS_STRIDE * 4 <= WS_SSMEM, "ws map");

struct Args {
    const float* in[43];
    float* out;
    unsigned char* ws;
};

__device__ __forceinline__ float bf2f(unsigned v) { return __uint_as_float(v << 16); }
typedef float f32x2v __attribute__((ext_vector_type(2)));
typedef __bf16 bf16x2v __attribute__((ext_vector_type(2)));
__device__ __forceinline__ unsigned pk2(float lo, float hi) { const f32x2v v = {lo, hi}; const bf16x2v b = __builtin_convertvector(v, bf16x2v); return __builtin_bit_cast(unsigned, b); }
__device__ __forceinline__ float wave_sum(float v) {
#pragma unroll
    for (int o = 1; o < 64; o <<= 1) v += __shfl_xor(v, o);
    return v;
}
__device__ __forceinline__ float wave_max(float v) {
#pragma unroll
    for (int o = 1; o < 64; o <<= 1) v = fmaxf(v, __shfl_xor(v, o));
    return v;
}

__device__ __forceinline__ float row_rstd(const float* ss, int row) {
    const f32x4* q = (const f32x4*)(ss + (size_t)row * 16);
    const f32x4 a = q[0], b = q[1], c = q[2], d = q[3];
    const float s = ((a[0] + a[1]) + (a[2] + a[3])) + ((b[0] + b[1]) + (b[2] + b[3])) + ((c[0] + c[1]) + (c[2] + c[3])) + ((d[0] + d[1]) + (d[2] + d[3]));
    return rsqrtf(s * (1.f / 1024.f) + EPS_);
}
__device__ __forceinline__ float row_rstd_q(const float* ss, int row, int fq) {
    const f32x4 a = *(const f32x4*)(ss + (size_t)row * 16 + 4 * fq);
    float s = (a[0] + a[1]) + (a[2] + a[3]);
    s += __shfl_xor(s, 16); s += __shfl_xor(s, 32);
    return rsqrtf(s * (1.f / 1024.f) + EPS_);
}
struct EpiSwiglu {
    static constexpr bool PERM = false, AFTER_DRAIN = false;
    const float* ss; bf16_t* U;
    __device__ __forceinline__ void operator()(const pg8::f32x4 (&acc)[2][2][4][2], const pg8::Unit& u, int wr, int wc, int fr, int fq) const {
        const int row0 = u.pm * 256 + wr * 64 + fr;
        const int f0 = u.pn * 128 + wc * 32 + 4 * fq;
        float rsv[2][4];
#pragma unroll
        for (int ai = 0; ai < 2; ++ai)
#pragma unroll
            for (int m = 0; m < 4; ++m) rsv[ai][m] = row_rstd_q(ss, row0 + ai * 128 + m * 16, fq);
#pragma unroll
        for (int ai = 0; ai < 2; ++ai)
#pragma unroll
            for (int m = 0; m < 4; ++m) {
                const int row = row0 + ai * 128 + m * 16;
                const float rs = rsv[ai][m];
#pragma unroll
                for (int n = 0; n < 2; ++n) {
                    const pg8::f32x4 g = acc[ai][0][m][n] * rs, up = acc[ai][1][m][n] * rs;
                    float o[4];
#pragma unroll
                    for (int i = 0; i < 4; ++i) o[i] = g[i] * __builtin_amdgcn_rcpf(1.f + __expf(-g[i])) * up[i];
                    u32x2 w; w.x = pk2(o[0], o[1]); w.y = pk2(o[2], o[3]);
                    *(u32x2*)(U + (size_t)row * 4096 + f0 + 16 * n) = w;
                }
                asm volatile("" ::: "memory");
            }
    }
};

struct EpiRes {
    static constexpr bool PERM = false, AFTER_DRAIN = false;
    const float* base_p; const float* base_s; float* out; bf16_t* xb; float* ssn; float scale;
    __device__ __forceinline__ void operator()(const pg8::f32x4 (&acc)[2][2][4][2], const pg8::Unit& u, int wr, int wc, int fr, int fq) const {
        const float* base = (u.pm < 128) ? base_p : base_s;
        const int row0 = u.pm * 256 + wr * 64 + fr;
        const int col0 = u.pn * 256 + wc * 64 + 4 * fq;
#pragma unroll
        for (int ai = 0; ai < 2; ++ai)
#pragma unroll
            for (int m = 0; m < 4; ++m) {
                const int row = row0 + ai * 128 + m * 16;
                float sq = 0.f;
#pragma unroll
                for (int bj = 0; bj < 2; ++bj)
#pragma unroll
                    for (int n = 0; n < 2; ++n) {
                        const size_t off = (size_t)row * 1024 + col0 + 32 * bj + 16 * n;
                        const pg8::f32x4 bv = *(const pg8::f32x4*)(base + off);
                        const pg8::f32x4 v = bv + acc[ai][bj][m][n] * scale;
                        *(pg8::f32x4*)(out + off) = v;
                        sq += (v[0] * v[0] + v[1] * v[1]) + (v[2] * v[2] + v[3] * v[3]);
                        u32x2 w; w.x = pk2(v[0], v[1]); w.y = pk2(v[2], v[3]);
                        *(u32x2*)(xb + off) = w;
                    }
                sq += __shfl_xor(sq, 16); sq += __shfl_xor(sq, 32);
                if (fq == 0) ssn[(size_t)row * 16 + u.pn * 4 + wc] = sq;
                if (m & 1) asm volatile("" ::: "memory");
            }
    }
};

struct ColDesc {
    const float* gain;
    int sig;
    bf16_t* db; int ldb, cb;
    float* df_p; float* df_s; int ldf, cf, mode;
};

template <class DescFn> struct EpiGen {
    static constexpr bool PERM = false, AFTER_DRAIN = false;
    const float* ss; DescFn fn;
    __device__ __forceinline__ void operator()(const pg8::f32x4 (&acc)[2][2][4][2], const pg8::Unit& u, int wr, int wc, int fr, int fq) const {
        const ColDesc d = fn(u.pn);
        const int row0 = u.pm * 256 + wr * 64 + fr;
        const int lc0 = wc * 64 + 4 * fq;
        pg8::f32x4 gn[2][2];
        if (d.gain) {
#pragma unroll
            for (int bj = 0; bj < 2; ++bj)
#pragma unroll
                for (int n = 0; n < 2; ++n) gn[bj][n] = *(const pg8::f32x4*)(d.gain + 4 * fq + 32 * bj + 16 * n);
        }
        const bool samp = (u.pm >= 128);
        float rsv[2][4];
#pragma unroll
        for (int ai = 0; ai < 2; ++ai)
#pragma unroll
            for (int m = 0; m < 4; ++m) rsv[ai][m] = row_rstd_q(ss, row0 + ai * 128 + m * 16, fq);
#pragma unroll
        for (int ai = 0; ai < 2; ++ai)
#pragma unroll
            for (int m = 0; m < 4; ++m) {
                const int row = row0 + ai * 128 + m * 16;
                const float rs = rsv[ai][m];
                pg8::f32x4 v[2][2];
                float sq = 0.f;
#pragma unroll
                for (int bj = 0; bj < 2; ++bj)
#pragma unroll
                    for (int n = 0; n < 2; ++n) { v[bj][n] = acc[ai][bj][m][n] * rs; const pg8::f32x4 t = v[bj][n]; sq += (t[0] * t[0] + t[1] * t[1]) + (t[2] * t[2] + t[3] * t[3]); }
                if (d.gain) {
                    sq += __shfl_xor(sq, 16); sq += __shfl_xor(sq, 32);
                    const float hn = rsqrtf(sq * (1.f / 64.f) + EPS_);
#pragma unroll
                    for (int bj = 0; bj < 2; ++bj)
#pragma unroll
                        for (int n = 0; n < 2; ++n) v[bj][n] = v[bj][n] * hn * gn[bj][n];
                }
                if (d.sig) {
#pragma unroll
                    for (int bj = 0; bj < 2; ++bj)
#pragma unroll
                        for (int n = 0; n < 2; ++n)
#pragma unroll
                            for (int i = 0; i < 4; ++i) v[bj][n][i] = __builtin_amdgcn_rcpf(1.f + __expf(-v[bj][n][i]));
                }
                {
                    bf16_t* p = d.db + (size_t)row * d.ldb + d.cb + lc0;
#pragma unroll
                    for (int bj = 0; bj < 2; ++bj)
#pragma unroll
                        for (int n = 0; n < 2; ++n) { u32x2 w; w.x = pk2(v[bj][n][0], v[bj][n][1]); w.y = pk2(v[bj][n][2], v[bj][n][3]); *(u32x2*)(p + 32 * bj + 16 * n) = w; }
                }
                if (d.df_p) {
                    float* p = nullptr;
                    if (!samp) {
                        if (d.mode == 0) p = d.df_p + (size_t)row * d.ldf;
                        else { const int s = row & (S_ - 1), b = row >> 13; if (s >= S_ - 512) p = d.df_p + (size_t)(b * 512 + s - (S_ - 512)) * d.ldf; }
                    } else {
                        const int r2 = row - T_;
                        if (d.mode == 0) p = d.df_s + (size_t)r2 * d.ldf;
                        else p = d.df_s + (size_t)((r2 >> 5) * 512 + 480 + (r2 & 31)) * d.ldf;
                    }
                    if (p) {
                        p += d.cf + lc0;
#pragma unroll
                        for (int bj = 0; bj < 2; ++bj)
#pragma unroll
                            for (int n = 0; n < 2; ++n) *(pg8::f32x4*)(p + 32 * bj + 16 * n) = v[bj][n];
                    }
                }
                asm volatile("" ::: "memory");
            }
    }
};

struct EpiMerge {
    static constexpr bool PERM = false, AFTER_DRAIN = false;
    const bf16_t* gate; bf16_t* merged; int first;
    __device__ __forceinline__ void operator()(const pg8::f32x4 (&acc)[2][2][4][2], const pg8::Unit& u, int wr, int wc, int fr, int fq) const {
        const int row0 = u.pm * 256 + wr * 64 + fr;
        const int col0 = u.pn * 256 + wc * 64 + 4 * fq;
#pragma unroll
        for (int ai = 0; ai < 2; ++ai)
#pragma unroll
            for (int m = 0; m < 4; ++m) {
                const int row = row0 + ai * 128 + m * 16;
#pragma unroll
                for (int bj = 0; bj < 2; ++bj)
#pragma unroll
                    for (int n = 0; n < 2; ++n) {
                        const size_t off = (size_t)row * 1024 + col0 + 32 * bj + 16 * n;
                        const u32x2 g = *(const u32x2*)(gate + off);
                        float o0 = bf2f(g.x & 0xffffu) * acc[ai][bj][m][n][0], o1 = bf2f(g.x >> 16) * acc[ai][bj][m][n][1];
                        float o2 = bf2f(g.y & 0xffffu) * acc[ai][bj][m][n][2], o3 = bf2f(g.y >> 16) * acc[ai][bj][m][n][3];
                        if (!first) { const u32x2 mo = *(const u32x2*)(merged + off); o0 += bf2f(mo.x & 0xffffu); o1 += bf2f(mo.x >> 16); o2 += bf2f(mo.y & 0xffffu); o3 += bf2f(mo.y >> 16); }
                        u32x2 w; w.x = pk2(o0, o1); w.y = pk2(o2, o3);
                        *(u32x2*)(merged + off) = w;
                    }
                if (m & 1) asm volatile("" ::: "memory");
            }
    }
};

__device__ __forceinline__ void p0_transpose_item(const float* W, int ldw, int srccol, const float* gain, bf16_t* dst, int prow, int K, int k0, LAS float* scr, int lane) {
    const int rsub = lane >> 4, c4 = lane & 15;
    const float* src = W + (size_t)(k0 + rsub) * ldw + srccol + 4 * c4;
    f32x4 v[8];
#pragma unroll
    for (int i = 0; i < 8; ++i) v[i] = __builtin_nontemporal_load((const f32x4*)(src + (size_t)(4 * i) * ldw));
    if (gain) {
#pragma unroll
        for (int i = 0; i < 8; ++i) v[i] = v[i] * gain[k0 + 4 * i + rsub];
    }
#pragma unroll
    for (int i = 0; i < 8; ++i) *(LAS f32x4*)(scr + (4 * i + rsub) * 68 + 4 * c4) = v[i];
    asm volatile("s_waitcnt lgkmcnt(0)" ::: "memory");
    bf16_t* drow = dst + (size_t)prow * K + k0;
#pragma unroll
    for (int c = 0; c < 4; ++c) {
        const LAS float* s = scr + (8 * c) * 68 + lane;
        u32x4 o; o.x = pk2(s[0 * 68], s[1 * 68]); o.y = pk2(s[2 * 68], s[3 * 68]); o.z = pk2(s[4 * 68], s[5 * 68]); o.w = pk2(s[6 * 68], s[7 * 68]);
        *(u32x4*)(drow + 8 * c) = o;
    }
    asm volatile("s_waitcnt lgkmcnt(0)" ::: "memory");
}
__device__ __forceinline__ void row_to_bf16(const float* xrow, bf16_t* orow, float* ssp, int lane) {
    const f32x4* xr = (const f32x4*)xrow + lane;
    f32x4 v[4]; float s = 0.f;
#pragma unroll
    for (int j = 0; j < 4; ++j) { v[j] = xr[64 * j]; s += (v[j].x * v[j].x + v[j].y * v[j].y) + (v[j].z * v[j].z + v[j].w * v[j].w); }
    s = wave_sum(s);
    u32x2* o = (u32x2*)orow + lane;
#pragma unroll
    for (int j = 0; j < 4; ++j) { u32x2 w; w.x = pk2(v[j].x, v[j].y); w.y = pk2(v[j].z, v[j].w); o[64 * j] = w; }
    if (lane < 16) ssp[lane] = (lane == 0) ? s : 0.f;
}

constexpr int AT_KT = 0, AT_VT = 17408, AT_BUF = 17408 + 18432  , AT_QW = 2 * AT_BUF, AT_TAB = AT_QW + 8 * 32 * 144, AT_FLAG = AT_TAB + 1600, AT_END = AT_FLAG + 64;
static_assert(4 * 4 * 16 * 64 * 4 <= AT_TAB, "differential exchange area below the bias table");
static_assert(AT_END <= 131072, "attention LDS map");
constexpr int AT_ACCO = 0, AT_ACCL = 32768, AT_STAB = 34816, AT_SV = 36864;

struct NoPrep { __device__ __forceinline__ void operator()(int) const {} };
template <int NMAP, int VD, class KL, class QL, class VL, class BF, class PREP = NoPrep>
__device__ __forceinline__ void tile_softmax(f32x16 (&O)[NMAP][VD / 32], float (&l)[NMAP], const KL& kl, const QL& ql, const VL& vl, const BF& bf, const PREP& prep = PREP()) {
    static_assert(NMAP == 1, "one map per wave");
    constexpr float C1 = 0.125f * LOG2E;
    f32x16 S[2];
#pragma unroll
    for (int kb = 0; kb < 2; ++kb) {
#pragma unroll
        for (int i = 0; i < 16; ++i) S[kb][i] = 0.f;
#pragma unroll
        for (int s = 0; s < 4; ++s) S[kb] = __builtin_amdgcn_mfma_f32_32x32x16_bf16(kl(kb, 0, s), ql(0, s), S[kb], 0, 0, 0);
    }
#pragma unroll
    for (int kb = 0; kb < 2; ++kb) {
        float ls = 0.f; unsigned pw[8];
#pragma unroll
        for (int r2 = 0; r2 < 16; r2 += 2) {
            const float p0 = __builtin_amdgcn_exp2f(S[kb][r2] * C1 + bf(kb, r2)), p1 = __builtin_amdgcn_exp2f(S[kb][r2 + 1] * C1 + bf(kb, r2 + 1));
            ls += p0 + p1; pw[r2 >> 1] = pk2(p0, p1);
        }
        l[0] += ls;
        u32x4 t0 = {pw[0], pw[1], pw[2], pw[3]}, t1 = {pw[4], pw[5], pw[6], pw[7]};
        const bf16x8 pf0 = __builtin_bit_cast(bf16x8, t0), pf1 = __builtin_bit_cast(bf16x8, t1);
        prep(kb);
#pragma unroll
        for (int db = 0; db < VD / 32; ++db) {
            O[0][db] = __builtin_amdgcn_mfma_f32_32x32x16_bf16(vl(db, kb, 0), pf0, O[0][db], 0, 0, 0);
            O[0][db] = __builtin_amdgcn_mfma_f32_32x32x16_bf16(vl(db, kb, 1), pf1, O[0][db], 0, 0, 0);
        }
    }
}

template <class KL, class QL, class VL, class MK>
__device__ __forceinline__ void tile_stick(f32x16 (&O)[2], float& R, int hh, const KL& kl, const QL& ql, const VL& vl, const MK& valid) {
#pragma unroll
    for (int kb = 1; kb >= 0; --kb) {
        f32x16 S;
#pragma unroll
        for (int i = 0; i < 16; ++i) S[i] = 0.f;
#pragma unroll
        for (int s = 0; s < 4; ++s) S = __builtin_amdgcn_mfma_f32_32x32x16_bf16(kl(kb, 0, s), ql(0, s), S, 0, 0, 0);
        float sg[16], f[16];
#pragma unroll
        for (int i = 0; i < 16; ++i) {
            float z = S[i] * 0.125f; z = fminf(fmaxf(z, -60.f), 60.f);
            const float e = __builtin_amdgcn_exp2f(-z * LOG2E);
            float s_ = __builtin_amdgcn_rcpf(1.f + e), ff = e * s_;
            if (!valid(kb, i)) { s_ = 0.f; ff = 1.f; }
            sg[i] = s_; f[i] = ff;
        }
        float F[4], Fp[4], Tg[4];
#pragma unroll
        for (int g = 0; g < 4; ++g) { F[g] = (f[4 * g] * f[4 * g + 1]) * (f[4 * g + 2] * f[4 * g + 3]); Fp[g] = __shfl_xor(F[g], 32); Tg[g] = F[g] * Fp[g]; }
        float E[4]; E[3] = 1.f; E[2] = Tg[3]; E[1] = Tg[3] * Tg[2]; E[0] = E[1] * Tg[1];
        unsigned pw[8];
#pragma unroll
        for (int g = 0; g < 4; ++g) {
            float t = R * E[g] * (hh == 0 ? Fp[g] : 1.f);
            const float w3 = sg[4 * g + 3] * t; t *= f[4 * g + 3];
            const float w2 = sg[4 * g + 2] * t; t *= f[4 * g + 2];
            const float w1 = sg[4 * g + 1] * t; t *= f[4 * g + 1];
            const float w0 = sg[4 * g] * t;
            pw[2 * g] = pk2(w0, w1); pw[2 * g + 1] = pk2(w2, w3);
        }
        R *= E[0] * Tg[0];
        u32x4 t0 = {pw[0], pw[1], pw[2], pw[3]}, t1 = {pw[4], pw[5], pw[6], pw[7]};
        const bf16x8 pf0 = __builtin_bit_cast(bf16x8, t0), pf1 = __builtin_bit_cast(bf16x8, t1);
#pragma unroll
        for (int db = 0; db < 2; ++db) {
            O[db] = __builtin_amdgcn_mfma_f32_32x32x16_bf16(vl(db, kb, 0), pf0, O[db], 0, 0, 0);
            O[db] = __builtin_amdgcn_mfma_f32_32x32x16_bf16(vl(db, kb, 1), pf1, O[db], 0, 0, 0);
        }
    }
}

template <int MODE, int NMAP, int VD>
__device__ __forceinline__ void finish_store(f32x16 (&O)[NMAP][VD / 32], float (&l)[NMAP], bf16_t* orowp, int hh, float lam, const float* subln, float oscale) {
    float inv[NMAP];
    if (MODE != 3) {
#pragma unroll
        for (int mp = 0; mp < NMAP; ++mp) { l[mp] += __shfl_xor(l[mp], 32); inv[mp] = 1.f / l[mp]; }
    }
    if constexpr (MODE == 0) {
        float sq = 0.f;
#pragma unroll
        for (int db = 0; db < 4; ++db)
#pragma unroll
            for (int i = 0; i < 16; ++i) { const float o = O[0][db][i] * inv[0] - lam * (O[1][db][i] * inv[1]); O[0][db][i] = o; sq += o * o; }
        sq += __shfl_xor(sq, 32);
        const float rsn = rsqrtf(sq * (1.f / 128.f) + EPS_) * oscale;
#pragma unroll
        for (int db = 0; db < 4; ++db)
#pragma unroll
            for (int g = 0; g < 4; ++g) {
                const int d0 = 32 * db + 8 * g + 4 * hh;
                const f32x4 gn = *(const f32x4*)(subln + d0);
                u32x2 wv; wv.x = pk2(O[0][db][4 * g] * rsn * gn[0], O[0][db][4 * g + 1] * rsn * gn[1]); wv.y = pk2(O[0][db][4 * g + 2] * rsn * gn[2], O[0][db][4 * g + 3] * rsn * gn[3]);
                *(u32x2*)(orowp + d0) = wv;
            }
    } else {
        const float sc = (MODE == 3) ? 1.f : inv[0];
#pragma unroll
        for (int db = 0; db < VD / 32; ++db)
#pragma unroll
            for (int g = 0; g < 4; ++g) {
                const int d0 = 32 * db + 8 * g + 4 * hh;
                u32x2 wv; wv.x = pk2(O[0][db][4 * g] * sc, O[0][db][4 * g + 1] * sc); wv.y = pk2(O[0][db][4 * g + 2] * sc, O[0][db][4 * g + 3] * sc);
                *(u32x2*)(orowp + d0) = wv;
            }
    }
}

__device__ __forceinline__ int t5_bucket_dev(int rel) {
    const int n = rel < 0 ? -rel : rel;
    int v;
    if (n < 8) v = n; else { const int k = 31 - __clz(n * n) - 6; v = 8 + k; if (v > 15) v = 15; }
    return (rel > 0 ? 16 : 0) + v;
}
__device__ __forceinline__ float lambda_init_dev(int layer) { return 0.8f - 0.6f * expf(-0.3f * (float)layer); }

template <int MODE>
__device__ __forceinline__ float attn_setup_bias(const Args& a, int layer, int h, LAS float* tab, int tid, int lane) {
    const float* gq = MODE == 0 ? a.in[18] : (MODE == 1 ? a.in[25] : a.in[36]);
    const float* gk = MODE == 0 ? a.in[19] : (MODE == 1 ? a.in[26] : a.in[37]);
    const float mq = wave_max(fabsf(gq[layer * 64 + lane])), mk = wave_max(fabsf(gk[layer * 64 + lane]));
    float mb = 0.f;
    const float* t5 = a.in[11];
    const float* relb = a.in[27] + (size_t)(layer * 4 + h) * 257;
    if (MODE == 0) mb = wave_max(lane < 32 ? fabsf(t5[lane * 4 + h]) : 0.f);
    if (MODE == 1) { float m = 0.f; for (int i = lane; i < 257; i += 64) m = fmaxf(m, fabsf(relb[i])); mb = wave_max(m); }
    const float shift = 8.f * mq * mk + mb;
    if (MODE == 0 || MODE == 1) {
        for (int t = tid; t < 384; t += 512) {
            int rel = t - 64 - 255; if (t < 64) rel = -255; float v;
            if (MODE == 0) v = t5[t5_bucket_dev(rel) * 4 + h];
            else { int c = rel < -128 ? -128 : (rel > 128 ? 128 : rel); v = relb[c + 128]; }
            tab[t] = (v - shift) * LOG2E;
        }
    }
    if (MODE == 0) return (t5[15 * 4 + h] - shift) * LOG2E;
    if (MODE == 1) return (relb[0] - shift) * LOG2E;
    return -shift * LOG2E;
}

template <int MODE>
__device__ __forceinline__ void attn_prompt_unit(LAS unsigned char* lds, const Args& a, int layer, int bh, int qb) {
    constexpr int KD = MODE == 0 ? 128 : 64, VD = MODE == 0 ? 128 : 64, KP = KD * 2 + 16, VP2 = VD * 2 + 16, QP = 144, NKC = KD / 64, NVC = VD / 64, UROWS = MODE == 0 ? 128 : 256;
    int tid_l = threadIdx.x; asm volatile("" : "+v"(tid_l));
    const int tid = tid_l, lane = tid & 63, w = __builtin_amdgcn_readfirstlane(tid >> 6), r = lane & 31, hh = lane >> 5;
    const int qg = MODE == 0 ? (w >> 1) : w, mpw = MODE == 0 ? (w & 1) : 0;
    const int b = bh >> 2, h = bh & 3;
    unsigned char* Rg = a.ws + WS_R;
    bf16_t* Q; const bf16_t* K; const bf16_t* V; int ld; int hoff; size_t keyrow0;
    if (MODE == 0) { Q = (bf16_t*)(Rg + R_QA); K = (const bf16_t*)(Rg + R_KA); V = (const bf16_t*)(Rg + R_VA); ld = 512; hoff = h * 128; keyrow0 = (size_t)b * S_; }
    else if (MODE == 1) { Q = (bf16_t*)(Rg + R_QC); K = (const bf16_t*)(Rg + R_KC); V = (const bf16_t*)(Rg + R_VC); ld = 256; hoff = h * 64; keyrow0 = (size_t)b * S_; }
    else if (MODE == 3) { Q = (bf16_t*)(Rg + R_QB); K = (const bf16_t*)(Rg + R_KB); V = (const bf16_t*)(Rg + R_VB); ld = 256; hoff = h * 64; keyrow0 = (size_t)b * S_; }
    else { Q = (bf16_t*)(Rg + R_QX); K = (const bf16_t*)(a.ws + WS_MKB) + (size_t)layer * 262144; V = (const bf16_t*)(a.ws + WS_MVB) + (size_t)layer * 262144; ld = 256; hoff = h * 64; keyrow0 = (size_t)b * 256; }
    const int q0 = UROWS * qb + 32 * qg;
    const size_t qrow0 = (size_t)b * S_ + q0;
    const int cw = q0 >> 6;
    int jlo, jhi, wlo, whi;
    if (MODE == 0 || MODE == 3) { jlo = 0; jhi = ((UROWS * qb + UROWS - 1) >> 6); wlo = 0; whi = cw; }
    else if (MODE == 1) { const int c0 = (UROWS * qb) >> 6; wlo = cw - 8 < 0 ? 0 : cw - 8; whi = cw; jlo = c0 - 8 < 0 ? 0 : c0 - 8; jhi = c0 + 3; }
    else { jlo = 0; jhi = 3; wlo = 0; whi = 3; }

    LAS float* tab = (LAS float*)(lds + AT_TAB); volatile LAS int* flags = (volatile LAS int*)(lds + AT_FLAG);

    __syncthreads();
    float farc = 0.f;
    if (MODE != 3) farc = attn_setup_bias<MODE>(a, layer, h, tab, tid, lane);
    bf16x8 qf[4];
#pragma unroll
    for (int s = 0; s < 4; ++s) qf[s] = *(const bf16x8*)(Q + (qrow0 + r) * ld + hoff + mpw * 64 + 16 * s + 8 * hh);
    float lam = 0.f;
    if (MODE == 0) {
        const float s1 = wave_sum(a.in[20][layer * 64 + lane] * a.in[21][layer * 64 + lane]);
        const float s2 = wave_sum(a.in[22][layer * 64 + lane] * a.in[23][layer * 64 + lane]);
        lam = expf(s1) - expf(s2) + lambda_init_dev(layer);
    }

    f32x16 O[1][VD / 32]; float l[1] = {0.f};
#pragma unroll
    for (int db = 0; db < VD / 32; ++db)
#pragma unroll
        for (int i = 0; i < 16; ++i) O[0][db][i] = 0.f;
    float Rp = 1.f; bool done = false;

    u32x4 kreg[NKC], vreg[NVC];
    auto prefetch = [&](int j) {
#pragma unroll
        for (int i = 0; i < NKC; ++i) { const int c = tid + 512 * i, key = c / (KD / 8), part = c % (KD / 8);
            kreg[i] = *(const u32x4*)(K + (keyrow0 + 64 * j + key) * ld + hoff + part * 8); }
#pragma unroll
        for (int i = 0; i < NVC; ++i) { const int c = tid + 512 * i, key = c / (VD / 8), part = c % (VD / 8);
            vreg[i] = *(const u32x4*)(V + (keyrow0 + 64 * j + key) * ld + hoff + part * 8); }
    };
    auto stage = [&](int buf) {
        LAS unsigned char* KT = lds + AT_KT + buf * AT_BUF; LAS unsigned char* VT = lds + AT_VT + buf * AT_BUF;
#pragma unroll
        for (int i = 0; i < NKC; ++i) { const int c = tid + 512 * i, key = c / (KD / 8), part = c % (KD / 8);
            *(LAS u32x4*)(KT + key * KP + part * 16) = kreg[i]; }
#pragma unroll
        for (int i = 0; i < NVC; ++i) { const int c = tid + 512 * i, key = c / (VD / 8), part = c % (VD / 8);
            *(LAS u32x4*)(VT + key * VP2 + part * 16) = vreg[i]; }
    };
    auto ql = [&](int, int s) -> bf16x8 { return qf[s]; };
    auto step = [&](auto BUFC, int j, bool more) {
        constexpr int BUF = decltype(BUFC)::value;
        const LAS unsigned char* KTb = lds + AT_KT + BUF * AT_BUF; const LAS unsigned char* VTb = lds + AT_VT + BUF * AT_BUF;
        auto kl = [&](int kb, int, int s) -> bf16x8 { return *(const LAS bf16x8*)(KTb + (32 * kb + r) * KP + mpw * 128 + (16 * s + 8 * hh) * 2); };
        auto vl = [&](int db, int kb, int s2) -> bf16x8 {
            const LAS unsigned char* p = VTb + (32 * kb + 16 * s2 + 4 * hh + ((lane & 15) >> 2)) * VP2 + (32 * db + 16 * ((lane >> 4) & 1) + 4 * (lane & 3)) * 2;
            const s16x4 lo = __builtin_amdgcn_ds_read_tr16_b64_v4i16((LAS s16x4*)p), hi = __builtin_amdgcn_ds_read_tr16_b64_v4i16((LAS s16x4*)(p + 8 * VP2));
            bf16x8 t = {lo[0], lo[1], lo[2], lo[3], hi[0], hi[1], hi[2], hi[3]}; return t; };
        if constexpr (MODE != 3) {
            if (more) prefetch(j + 1);
            if (j >= wlo && j <= whi) {
                const int maxrel = 64 * j + 63 - q0;
                float bv[2][16];
                if (MODE == 2 || maxrel <= -128) {
#pragma unroll
                    for (int kb = 0; kb < 2; ++kb)
#pragma unroll
                        for (int i = 0; i < 16; ++i) bv[kb][i] = farc;
                } else {
                    const int bidx = 64 + 64 * j + 4 * hh - q0 - r + 255;
#pragma unroll
                    for (int kb = 0; kb < 2; ++kb)
#pragma unroll
                        for (int i = 0; i < 16; ++i) bv[kb][i] = tab[bidx + 32 * kb + (i & 3) + 8 * (i >> 2)];
                }
                auto bf = [&](int kb, int i) -> float { return bv[kb][i]; };
                tile_softmax<1, VD>(O, l, kl, ql, vl, bf);
            }
        } else {
            if (more) prefetch(j - 1);
            if (j <= whi && !done) {
                const int kbase = 64 * j + 4 * hh, qpos = (j == whi) ? q0 + r : 0x7fffffff;
                auto valid = [&](int kb, int i) -> bool { return (kbase + 32 * kb + (i & 3) + 8 * (i >> 2)) < qpos; };
                tile_stick(O[0], Rp, hh, kl, ql, vl, valid);
                done = (__ballot(Rp != 0.f) == 0ull) || (j == 0);
            }
            if (lane == 0) flags[BUF * 8 + w] = done ? 1 : 0;
        }
        if (more) stage(BUF ^ 1);
        __syncthreads();
    };
    if constexpr (MODE != 3) {
        prefetch(jlo); stage(0); __syncthreads();
        for (int j = jlo; j <= jhi; j += 2) {
            step(std::integral_constant<int, 0>{}, j, j < jhi);
            if (j + 1 <= jhi) step(std::integral_constant<int, 1>{}, j + 1, j + 1 < jhi);
        }
    } else {
        prefetch(jhi); stage(0); __syncthreads();
        for (int j = jhi; j >= 0; j -= 2) {
            step(std::integral_constant<int, 0>{}, j, j > 0);
            { int alld = 1;
#pragma unroll
              for (int i = 0; i < 8; ++i) alld &= flags[i];
              if (alld || j == 0) break; }
            step(std::integral_constant<int, 1>{}, j - 1, j - 1 > 0);
            { int alld = 1;
#pragma unroll
              for (int i = 0; i < 8; ++i) alld &= flags[8 + i];
              if (alld) break; }
        }
    }
    bf16_t* orowp = Q + (qrow0 + r) * ld + hoff;
    if constexpr (MODE == 0) {
        l[0] += __shfl_xor(l[0], 32);
        const float inv = 1.f / l[0];
        LAS float* ex = (LAS float*)lds + qg * (4 * 16 * 64);
        if (mpw == 1) {
            const float sc = inv * lam;
#pragma unroll
            for (int db = 0; db < 4; ++db)
#pragma unroll
                for (int i = 0; i < 16; ++i) ex[(db * 16 + i) * 64 + lane] = O[0][db][i] * sc;
        }
        __syncthreads();
        if (mpw == 0) {
            float sq = 0.f;
#pragma unroll
            for (int db = 0; db < 4; ++db)
#pragma unroll
                for (int i = 0; i < 16; ++i) { const float o = O[0][db][i] * inv - ex[(db * 16 + i) * 64 + lane]; O[0][db][i] = o; sq += o * o; }
            sq += __shfl_xor(sq, 32);
            const float rsn = rsqrtf(sq * (1.f / 128.f) + EPS_) * (1.f - lambda_init_dev(layer));
            const float* subln = a.in[24] + layer * 128;
#pragma unroll
            for (int db = 0; db < 4; ++db)
#pragma unroll
                for (int g = 0; g < 4; ++g) {
                    const int d0 = 32 * db + 8 * g + 4 * hh;
                    const f32x4 gn = *(const f32x4*)(subln + d0);
                    u32x2 wv; wv.x = pk2(O[0][db][4 * g] * rsn * gn[0], O[0][db][4 * g + 1] * rsn * gn[1]); wv.y = pk2(O[0][db][4 * g + 2] * rsn * gn[2], O[0][db][4 * g + 3] * rsn * gn[3]);
                    *(u32x2*)(orowp + d0) = wv;
                }
        }
    } else {
        finish_store<MODE, 1, VD>(O, l, orowp, hh, lam, nullptr, 1.f);
    }
}

template <int MODE>
__device__ __forceinline__ void attn_sample_unit(LAS unsigned char* lds, const Args& a, int layer, int b, int h) {
    constexpr int NMAP = MODE == 0 ? 2 : 1, KD = 64 * NMAP, VD = MODE == 0 ? 128 : 64;
    int tid_l = threadIdx.x; asm volatile("" : "+v"(tid_l));
    const int tid = tid_l, lane = tid & 63, w = __builtin_amdgcn_readfirstlane(tid >> 6), r = lane & 31, hh = lane >> 5;
    const float *kc, *kn, *vc, *vn; int ldk, ncache, nkeys, kpos0; const bf16_t* Q; int ldq;
    const size_t lb = (size_t)(layer * 8 + b);
    if (MODE == 0) { kc = a.in[3] + lb * 1024 * 512 + h * 128; vc = a.in[4] + lb * 1024 * 512 + h * 128; kn = a.out + O_AKS + lb * 32 * 512 + h * 128; vn = a.out + O_AVS + lb * 32 * 512 + h * 128;
        ldk = 512; ncache = 1024; nkeys = 1056; kpos0 = 0; Q = (const bf16_t*)(a.ws + WS_R + R_QA); ldq = 512; }
    else if (MODE == 1) { kc = a.in[7] + lb * 512 * 256 + h * 64; vc = a.in[8] + lb * 512 * 256 + h * 64; kn = a.out + O_CKS + (lb * 512 + 480) * 256 + h * 64; vn = a.out + O_CVS + (lb * 512 + 480) * 256 + h * 64;
        ldk = 256; ncache = 512; nkeys = 544; kpos0 = 512; Q = (const bf16_t*)(a.ws + WS_R + R_QC); ldq = 256; }
    else { kc = a.in[9] + lb * 256 * 256 + h * 64; vc = a.in[10] + lb * 256 * 256 + h * 64; kn = kc; vn = vc; ldk = 256; ncache = 256; nkeys = 256; kpos0 = 0; Q = (const bf16_t*)(a.ws + WS_R + R_QX); ldq = 256; }
    const size_t qrow = (size_t)T_ + b * 32 + r;
    LAS float* accO = (LAS float*)(lds + AT_ACCO); LAS float* accL = (LAS float*)(lds + AT_ACCL); LAS float* tab = (LAS float*)(lds + AT_STAB);
    __syncthreads();
    for (int i = tid; i < NMAP * (VD / 32) * 16 * 64; i += 512) accO[i] = 0.f;
    if (tid < NMAP * 64) accL[tid] = 0.f;
    const float farc = attn_setup_bias<MODE>(a, layer, h, tab, tid, lane);
    float lam = 0.f;
    if (MODE == 0) {
        const float s1 = wave_sum(a.in[20][layer * 64 + lane] * a.in[21][layer * 64 + lane]);
        const float s2 = wave_sum(a.in[22][layer * 64 + lane] * a.in[23][layer * 64 + lane]);
        lam = expf(s1) - expf(s2) + lambda_init_dev(layer);
    }
    const bf16_t* qptr = Q + qrow * ldq + h * KD + 8 * hh;
    __syncthreads();
    f32x16 Ow[1][VD / 32]; float lw[1] = {0.f};
#pragma unroll
    for (int db = 0; db < VD / 32; ++db)
#pragma unroll
        for (int i = 0; i < 16; ++i) Ow[0][db][i] = 0.f;
    const int ntiles = (nkeys + 63) / 64;
    const int mpw = (NMAP == 2) ? (w >> 2) : 0, jstep = (NMAP == 2) ? 4 : 8, jstart = (NMAP == 2) ? (w & 3) : w;
    for (int j = jstart; j < ntiles; j += jstep) {
        asm volatile("" ::: "memory");
        auto krow = [&](int p) -> const float* { p = p < nkeys ? p : nkeys - 1; return p < ncache ? kc + (size_t)p * ldk : kn + (size_t)(p - ncache) * ldk; };
        auto vrow = [&](int p) -> const float* { p = p < nkeys ? p : nkeys - 1; return p < ncache ? vc + (size_t)p * ldk : vn + (size_t)(p - ncache) * ldk; };
        auto kl = [&](int kb, int, int s) -> bf16x8 {
            const float* p = krow(64 * j + 32 * kb + r) + mpw * 64 + 16 * s + 8 * hh;
            const f32x4 x = *(const f32x4*)p, y = *(const f32x4*)(p + 4);
            u32x4 t = {pk2(x[0], x[1]), pk2(x[2], x[3]), pk2(y[0], y[1]), pk2(y[2], y[3])}; return __builtin_bit_cast(bf16x8, t); };
        auto ql = [&](int, int s) -> bf16x8 { return *(const bf16x8*)(qptr + mpw * 64 + 16 * s); };
        constexpr int VP2 = VD * 2 + 16, KPI = 256 / VD;
        LAS unsigned char* VTw = lds + AT_SV + w * (32 * VP2);
        auto vprep = [&](int kb) {
            f32x4 x[32 / KPI];
#pragma unroll
            for (int i = 0; i < 32 / KPI; ++i) x[i] = *(const f32x4*)(vrow(64 * j + 32 * kb + KPI * i + lane / (VD / 4)) + 4 * (lane % (VD / 4)));
#pragma unroll
            for (int i = 0; i < 32 / KPI; ++i) { u32x2 t; t.x = pk2(x[i][0], x[i][1]); t.y = pk2(x[i][2], x[i][3]);
                *(LAS u32x2*)(VTw + (KPI * i + lane / (VD / 4)) * VP2 + 8 * (lane % (VD / 4))) = t; }
        };
        auto vl = [&](int db, int, int s2) -> bf16x8 {
            const LAS unsigned char* p2 = VTw + (16 * s2 + 4 * hh + ((lane & 15) >> 2)) * VP2 + (32 * db + 16 * ((lane >> 4) & 1) + 4 * (lane & 3)) * 2;
            const s16x4 lo = __builtin_amdgcn_ds_read_tr16_b64_v4i16((LAS s16x4*)p2), hi = __builtin_amdgcn_ds_read_tr16_b64_v4i16((LAS s16x4*)(p2 + 8 * VP2));
            bf16x8 t = {lo[0], lo[1], lo[2], lo[3], hi[0], hi[1], hi[2], hi[3]}; return t; };
        const int pbase = 64 * j + 4 * hh;
        const int maxrel = kpos0 + 64 * j + 63 - 1024;
        const int bidx = (maxrel <= -128) ? 0 : 64 + kpos0 + pbase - 1024 - r + 255;
        auto bf = [&](int kb, int i) -> float { const int o = 32 * kb + (i & 3) + 8 * (i >> 2); const float t = (MODE == 2) ? farc : tab[bidx + o]; return (pbase + o) < nkeys ? t : -INFINITY; };
        tile_softmax<1, VD>(Ow, lw, kl, ql, vl, bf, vprep);
    }
#pragma unroll
    for (int db = 0; db < VD / 32; ++db)
#pragma unroll
        for (int i = 0; i < 16; ++i) __builtin_amdgcn_ds_faddf(&accO[((mpw * (VD / 32) + db) * 16 + i) * 64 + lane], Ow[0][db][i], 0, 0, false);
    __builtin_amdgcn_ds_faddf(&accL[mpw * 64 + lane], lw[0], 0, 0, false);
    __syncthreads();
    if (w == 0) {
        f32x16 O[NMAP][VD / 32]; float l[NMAP];
#pragma unroll
        for (int mp = 0; mp < NMAP; ++mp) {
#pragma unroll
            for (int db = 0; db < VD / 32; ++db)
#pragma unroll
                for (int i = 0; i < 16; ++i) O[mp][db][i] = accO[((mp * (VD / 32) + db) * 16 + i) * 64 + lane];
            l[mp] = accL[mp * 64 + lane];
        }
        bf16_t* orowp = (bf16_t*)Q + qrow * ldq + h * (MODE == 0 ? 128 : 64);
        finish_store<MODE, NMAP, VD>(O, l, orowp, hh, lam, a.in[24] + layer * 128, 1.f - lambda_init_dev(layer));
    }
}

__device__ __forceinline__ void attn_stick_sample(const Args& a, int layer, int unit) {
    int tid_l = threadIdx.x; asm volatile("" : "+v"(tid_l));
    const int lane = tid_l & 63, r = lane & 31, hh = lane >> 5;
    const int b = unit >> 2, h = unit & 3;
    const size_t lb = (size_t)(layer * 8 + b);
    const float* kc = a.in[5] + lb * 1024 * 256 + h * 64; const float* vc = a.in[6] + lb * 1024 * 256 + h * 64;
    const float* kn = a.out + O_BKS + lb * 32 * 256 + h * 64; const float* vn = a.out + O_BVS + lb * 32 * 256 + h * 64;
    constexpr int ldk = 256, ncache = 1024, nkeys = 1056;
    bf16_t* Q = (bf16_t*)(a.ws + WS_R + R_QB);
    const size_t qrow = (size_t)T_ + b * 32 + r;
    bf16x8 qf[4];
#pragma unroll
    for (int s = 0; s < 4; ++s) qf[s] = *(const bf16x8*)(Q + qrow * 256 + h * 64 + 16 * s + 8 * hh);
    f32x16 O[1][2];
#pragma unroll
    for (int db = 0; db < 2; ++db)
#pragma unroll
        for (int i = 0; i < 16; ++i) O[0][db][i] = 0.f;
    float Rp = 1.f;
    for (int j = 16; j >= 0; --j) {
        auto krow = [&](int p) -> const float* { p = p < nkeys ? p : nkeys - 1; return p < ncache ? kc + (size_t)p * ldk : kn + (size_t)(p - ncache) * ldk; };
        auto vrow = [&](int p) -> const float* { p = p < nkeys ? p : nkeys - 1; return p < ncache ? vc + (size_t)p * ldk : vn + (size_t)(p - ncache) * ldk; };
        auto kl = [&](int kb, int, int s) -> bf16x8 {
            const float* p = krow(64 * j + 32 * kb + r) + 16 * s + 8 * hh;
            const f32x4 x = *(const f32x4*)p, y = *(const f32x4*)(p + 4);
            u32x4 t = {pk2(x[0], x[1]), pk2(x[2], x[3]), pk2(y[0], y[1]), pk2(y[2], y[3])}; return __builtin_bit_cast(bf16x8, t); };
        auto ql = [&](int, int s) -> bf16x8 { return qf[s]; };
        auto vl = [&](int db, int kb, int s2) -> bf16x8 {
            float x[8];
#pragma unroll
            for (int jx = 0; jx < 8; ++jx) x[jx] = vrow(64 * j + 32 * kb + 16 * s2 + 8 * (jx >> 2) + 4 * hh + (jx & 3))[32 * db + r];
            u32x4 t = {pk2(x[0], x[1]), pk2(x[2], x[3]), pk2(x[4], x[5]), pk2(x[6], x[7])}; return __builtin_bit_cast(bf16x8, t); };
        const int pbase = 64 * j + 4 * hh, qpos = 1024 + r;
        auto valid = [&](int kb, int i) -> bool { const int p = pbase + 32 * kb + (i & 3) + 8 * (i >> 2); return p < nkeys && p < qpos; };
        tile_stick(O[0], Rp, hh, kl, ql, vl, valid);
        if (__ballot(Rp != 0.f) == 0ull) break;
    }
    float l[1] = {1.f};
    finish_store<3, 1, 64>(O, l, Q + qrow * 256 + h * 64, hh, 0.f, nullptr, 1.f);
}

#ifndef PROBE_K
#define PROBE_K -1
#endif
#ifndef SKIP_ATTN
#define SKIP_ATTN 0
#endif
#ifndef SKIP_MERGE
#define SKIP_MERGE 0
#endif
#ifndef SKIP_GATE
#define SKIP_GATE 0
#endif
#ifndef P7_PLANE
#define P7_PLANE 0
#endif
#ifndef GATE_SIG
#define GATE_SIG 1
#endif
#ifndef STOP_AFTER
#define STOP_AFTER 99
#endif

struct DescQKV {
    unsigned char* R; float* out; const float* aqn; const float* akn; const float* cqn; const float* ckn; int layer;
    __device__ __forceinline__ ColDesc operator()(int pn) const {
        ColDesc d; d.gain = nullptr; d.sig = 0; d.db = nullptr; d.ldb = 256; d.cb = 0; d.df_p = nullptr; d.df_s = nullptr; d.ldf = 256; d.cf = 0; d.mode = 0;
        const size_t L = (size_t)layer;
        if (pn < 2) { d.gain = aqn; d.db = (bf16_t*)(R + R_QA); d.ldb = 512; d.cb = pn * 256; }
        else if (pn < 4) { d.gain = akn; d.db = (bf16_t*)(R + R_KA); d.ldb = 512; d.cb = (pn - 2) * 256; d.df_p = out + O_AKP + L * T_ * 512; d.df_s = out + O_AKS + L * MS_ * 512; d.ldf = 512; d.cf = (pn - 2) * 256; }
        else if (pn < 6) { d.db = (bf16_t*)(R + R_VA); d.ldb = 512; d.cb = (pn - 4) * 256; d.df_p = out + O_AVP + L * T_ * 512; d.df_s = out + O_AVS + L * MS_ * 512; d.ldf = 512; d.cf = (pn - 4) * 256; }
        else if (pn == 6) { d.db = (bf16_t*)(R + R_QB); }
        else if (pn == 7) { d.db = (bf16_t*)(R + R_KB); d.df_p = out + O_BKP + L * T_ * 256; d.df_s = out + O_BKS + L * MS_ * 256; }
        else if (pn == 8) { d.db = (bf16_t*)(R + R_VB); d.df_p = out + O_BVP + L * T_ * 256; d.df_s = out + O_BVS + L * MS_ * 256; }
        else if (pn == 9) { d.gain = cqn; d.db = (bf16_t*)(R + R_QC); }
        else if (pn == 10) { d.gain = ckn; d.db = (bf16_t*)(R + R_KC); d.df_p = out + O_CKP + L * 4 * 512 * 256; d.df_s = out + O_CKS + L * 8 * 512 * 256; d.mode = 1; }
        else { d.db = (bf16_t*)(R + R_VC); d.df_p = out + O_CVP + L * 4 * 512 * 256; d.df_s = out + O_CVS + L * 8 * 512 * 256; d.mode = 1; }
        return d;
    }
};
struct DescGate {
    unsigned char* R;
    __device__ __forceinline__ ColDesc operator()(int pn) const {
        ColDesc d; d.gain = nullptr; d.sig = GATE_SIG; d.db = (bf16_t*)(R + R_G + (size_t)(pn >> 2) * R_GPLANE); d.ldb = 1024; d.cb = (pn & 3) * 256; d.df_p = nullptr; d.df_s = nullptr; d.ldf = 0; d.cf = 0; d.mode = 0;
        return d;
    }
};
struct DescWq {
    unsigned char* R; const float* qn;
    __device__ __forceinline__ ColDesc operator()(int) const {
        ColDesc d; d.gain = qn; d.sig = 0; d.db = (bf16_t*)(R + R_QX); d.ldb = 256; d.cb = 0; d.df_p = nullptr; d.df_s = nullptr; d.ldf = 0; d.cf = 0; d.mode = 0;
        return d;
    }
};
struct DescMemKV {
    unsigned char* ws; float* out; const float* kn; int layer;
    __device__ __forceinline__ ColDesc operator()(int pn) const {
        ColDesc d; d.sig = 0; d.ldb = 256; d.cb = 0; d.ldf = 256; d.cf = 0; d.mode = 0; d.df_s = nullptr;
        if (pn == 0) { d.gain = kn; d.db = (bf16_t*)(ws + WS_MKB) + (size_t)layer * 262144; d.df_p = out + O_MKP + (size_t)layer * 262144; }
        else { d.gain = nullptr; d.db = (bf16_t*)(ws + WS_MVB) + (size_t)layer * 262144; d.df_p = out + O_MVP + (size_t)layer * 262144; }
        return d;
    }
};


__device__ __forceinline__ void sample_res_gemm(LAS unsigned char* lds, const bf16_t* A, const bf16_t* Bt, int K, float scale, const float* base, float* out, bf16_t* xb, float* ssn, int bx) {
    if (bx >= 128) return;
    int tid_l = threadIdx.x; asm volatile("" : "+v"(tid_l));
    const int tid = tid_l, lane = tid & 63, w = __builtin_amdgcn_readfirstlane(tid >> 6), r = lane & 31, hh = lane >> 5;
    const int rm = bx >> 4, cn = bx & 15, row0 = T_ + 32 * rm;
    const bf16_t* b0 = Bt + (size_t)(256 * (cn >> 2) + 32 * (cn & 3) + r) * K;
    const bf16_t* b1 = b0 + (size_t)128 * K;
    const bf16_t* ap = A + (size_t)(row0 + r) * K;
    const int kw = K >> 3, k0 = w * kw + 8 * hh;
    f32x16 c0, c1;
#pragma unroll
    for (int i = 0; i < 16; ++i) { c0[i] = 0.f; c1[i] = 0.f; }
#pragma unroll 4
    for (int s = 0; s < kw; s += 16) {
        const bf16x8 af = *(const bf16x8*)(ap + k0 + s), f0 = *(const bf16x8*)(b0 + k0 + s), f1 = *(const bf16x8*)(b1 + k0 + s);
        c0 = __builtin_amdgcn_mfma_f32_32x32x16_bf16(af, f0, c0, 0, 0, 0);
        c1 = __builtin_amdgcn_mfma_f32_32x32x16_bf16(af, f1, c1, 0, 0, 0);
    }
    LAS float* P = (LAS float*)lds;
#pragma unroll
    for (int i = 0; i < 16; ++i) { P[((w * 2 + 0) * 16 + i) * 64 + lane] = c0[i]; P[((w * 2 + 1) * 16 + i) * 64 + lane] = c1[i]; }
    __syncthreads();
    {
        const int i = tid >> 4, cp = tid & 15, n0 = 4 * cp, t = n0 >> 5, nl = n0 & 31;
        const int reg = (i & 3) + 4 * (i >> 3), h2 = (i >> 2) & 1;
        float v[4] = {0.f, 0.f, 0.f, 0.f};
#pragma unroll
        for (int ww = 0; ww < 8; ++ww)
#pragma unroll
            for (int e = 0; e < 4; ++e) v[e] += P[((ww * 2 + t) * 16 + reg) * 64 + nl + e + 32 * h2];
        const size_t off = (size_t)(row0 + i) * 1024 + 64 * cn + n0;
        const f32x4 bv = *(const f32x4*)(base + off);
        f32x4 o; o[0] = bv[0] + scale * v[0]; o[1] = bv[1] + scale * v[1]; o[2] = bv[2] + scale * v[2]; o[3] = bv[3] + scale * v[3];
        *(f32x4*)(out + off) = o;
        u32x2 wv; wv.x = pk2(o[0], o[1]); wv.y = pk2(o[2], o[3]); *(u32x2*)(xb + off) = wv;
        float sq = (o[0] * o[0] + o[1] * o[1]) + (o[2] * o[2] + o[3] * o[3]);
        sq += __shfl_xor(sq, 1); sq += __shfl_xor(sq, 2); sq += __shfl_xor(sq, 4); sq += __shfl_xor(sq, 8);
        if (cp == 0) ssn[(size_t)(row0 + i) * 16 + cn] = sq;
    }
    __syncthreads();
}

template <class DescFn>
__device__ __forceinline__ void sample_gen_gemm(LAS unsigned char* lds, const bf16_t* A, const bf16_t* Bt, int N, const float* ss, const DescFn& fn, int bx, int G) {
    int tid_l = threadIdx.x; asm volatile("" : "+v"(tid_l));
    const int tid = tid_l, lane = tid & 63, w = __builtin_amdgcn_readfirstlane(tid >> 6), r = lane & 31, hh = lane >> 5;
    constexpr int K = 1024, kw = K / 8;
    const int nct = N / 64, nitems = 8 * nct;
    LAS float* P = (LAS float*)lds;
    for (int it = bx; it < nitems; it += G) {
        const int rm = it / nct, cn = it % nct, row0 = T_ + 32 * rm;
        const bf16_t* b0 = Bt + (size_t)(256 * (cn >> 2) + 32 * (cn & 3) + r) * K;
        const bf16_t* b1 = b0 + (size_t)128 * K;
        const bf16_t* ap = A + (size_t)(row0 + r) * K;
        const int k0 = w * kw + 8 * hh;
        f32x16 c0, c1;
#pragma unroll
        for (int i = 0; i < 16; ++i) { c0[i] = 0.f; c1[i] = 0.f; }
#pragma unroll 4
        for (int s = 0; s < kw; s += 16) {
            const bf16x8 af = *(const bf16x8*)(ap + k0 + s), f0 = *(const bf16x8*)(b0 + k0 + s), f1 = *(const bf16x8*)(b1 + k0 + s);
            c0 = __builtin_amdgcn_mfma_f32_32x32x16_bf16(af, f0, c0, 0, 0, 0);
            c1 = __builtin_amdgcn_mfma_f32_32x32x16_bf16(af, f1, c1, 0, 0, 0);
        }
        __syncthreads();
#pragma unroll
        for (int i = 0; i < 16; ++i) { P[((w * 2 + 0) * 16 + i) * 64 + lane] = c0[i]; P[((w * 2 + 1) * 16 + i) * 64 + lane] = c1[i]; }
        __syncthreads();
        {
            const int i = tid >> 4, cp = tid & 15, n0 = 4 * cp, t = n0 >> 5, nl = n0 & 31;
            const int reg = (i & 3) + 4 * (i >> 3), h2 = (i >> 2) & 1;
            float v[4] = {0.f, 0.f, 0.f, 0.f};
#pragma unroll
            for (int ww = 0; ww < 8; ++ww)
#pragma unroll
                for (int e = 0; e < 4; ++e) v[e] += P[((ww * 2 + t) * 16 + reg) * 64 + nl + e + 32 * h2];
            const int row = row0 + i;
            float s = ss[(size_t)row * 16 + cp];
            s += __shfl_xor(s, 1); s += __shfl_xor(s, 2); s += __shfl_xor(s, 4); s += __shfl_xor(s, 8);
            const float rs = rsqrtf(s * (1.f / 1024.f) + EPS_);
#pragma unroll
            for (int e = 0; e < 4; ++e) v[e] *= rs;
            const int col = 64 * cn + n0;
            const ColDesc d = fn(col >> 8);
            const int lc = col & 255;
            if (d.gain) {
                float sq = (v[0] * v[0] + v[1] * v[1]) + (v[2] * v[2] + v[3] * v[3]);
                sq += __shfl_xor(sq, 1); sq += __shfl_xor(sq, 2); sq += __shfl_xor(sq, 4); sq += __shfl_xor(sq, 8);
                const float hn = rsqrtf(sq * (1.f / 64.f) + EPS_);
                const f32x4 gn = *(const f32x4*)(d.gain + n0);
#pragma unroll
                for (int e = 0; e < 4; ++e) v[e] = v[e] * hn * gn[e];
            }
            if (d.sig) {
#pragma unroll
                for (int e = 0; e < 4; ++e) v[e] = __builtin_amdgcn_rcpf(1.f + __expf(-v[e]));
            }
            u32x2 wv; wv.x = pk2(v[0], v[1]); wv.y = pk2(v[2], v[3]);
            *(u32x2*)(d.db + (size_t)row * d.ldb + d.cb + lc) = wv;
            if (d.df_s) {
                const int r2 = row - T_;
                float* pf = (d.mode == 0) ? d.df_s + (size_t)r2 * d.ldf : d.df_s + (size_t)((r2 >> 5) * 512 + 480 + (r2 & 31)) * d.ldf;
                f32x4 o = {v[0], v[1], v[2], v[3]};
                *(f32x4*)(pf + d.cf + lc) = o;
            }
        }
    }
    __syncthreads();
}

__device__ __forceinline__ void sample_merge_gemm(LAS unsigned char* lds, unsigned char* R, const bf16_t* Wl, int bx) {
    if (bx >= 128) return;
    int tid_l = threadIdx.x; asm volatile("" : "+v"(tid_l));
    const int tid = tid_l, lane = tid & 63, w = __builtin_amdgcn_readfirstlane(tid >> 6), r = lane & 31, hh = lane >> 5;
    const int rm = bx >> 4, cn = bx & 15, row0 = T_ + 32 * rm;
    LAS float* P = (LAS float*)lds;
    const int i = tid >> 4, cp = tid & 15, n0 = 4 * cp, t = n0 >> 5, nl = n0 & 31;
    const int reg = (i & 3) + 4 * (i >> 3), h2 = (i >> 2) & 1;
    const size_t off = (size_t)(row0 + i) * 1024 + 64 * cn + n0;
    float tot[4] = {0.f, 0.f, 0.f, 0.f};
#pragma unroll
    for (int j = 0; j < 3; ++j) {
        const int K = (j == 0) ? 512 : 256, kw = K / 8;
        const bf16_t* A = (const bf16_t*)(R + (j == 0 ? R_QA : (j == 1 ? R_QB : R_QC)));
        const bf16_t* Bt = Wl + (j == 0 ? W_BRA : (j == 1 ? W_BRB : W_BRC));
        const bf16_t* b0 = Bt + (size_t)(256 * (cn >> 2) + 32 * (cn & 3) + r) * K;
        const bf16_t* b1 = b0 + (size_t)128 * K;
        const bf16_t* ap = A + (size_t)(row0 + r) * K;
        const int k0 = w * kw + 8 * hh;
        f32x16 c0, c1;
#pragma unroll
        for (int q = 0; q < 16; ++q) { c0[q] = 0.f; c1[q] = 0.f; }
        for (int s = 0; s < kw; s += 16) {
            const bf16x8 af = *(const bf16x8*)(ap + k0 + s), f0 = *(const bf16x8*)(b0 + k0 + s), f1 = *(const bf16x8*)(b1 + k0 + s);
            c0 = __builtin_amdgcn_mfma_f32_32x32x16_bf16(af, f0, c0, 0, 0, 0);
            c1 = __builtin_amdgcn_mfma_f32_32x32x16_bf16(af, f1, c1, 0, 0, 0);
        }
        __syncthreads();
#pragma unroll
        for (int q = 0; q < 16; ++q) { P[((w * 2 + 0) * 16 + q) * 64 + lane] = c0[q]; P[((w * 2 + 1) * 16 + q) * 64 + lane] = c1[q]; }
        __syncthreads();
        float v[4] = {0.f, 0.f, 0.f, 0.f};
#pragma unroll
        for (int ww = 0; ww < 8; ++ww)
#pragma unroll
            for (int e = 0; e < 4; ++e) v[e] += P[((ww * 2 + t) * 16 + reg) * 64 + nl + e + 32 * h2];
        const u32x2 g = *(const u32x2*)((const bf16_t*)(R + R_G + (size_t)j * R_GPLANE) + off);
        tot[0] += bf2f(g.x & 0xffffu) * v[0]; tot[1] += bf2f(g.x >> 16) * v[1]; tot[2] += bf2f(g.y & 0xffffu) * v[2]; tot[3] += bf2f(g.y >> 16) * v[3];
    }
    u32x2 wv; wv.x = pk2(tot[0], tot[1]); wv.y = pk2(tot[2], tot[3]);
    *(u32x2*)((bf16_t*)(R + R_G) + off) = wv;
    __syncthreads();
}

__device__ __forceinline__ void sample_swiglu_gemm(LAS unsigned char* lds, const bf16_t* A, const bf16_t* Bt, const float* ss, bf16_t* U, int bx, int G) {
    int tid_l = threadIdx.x; asm volatile("" : "+v"(tid_l));
    const int tid = tid_l, lane = tid & 63, w = __builtin_amdgcn_readfirstlane(tid >> 6), r = lane & 31, hh = lane >> 5;
    constexpr int K = 1024, kw = K / 8;
    LAS float* P = (LAS float*)lds;
    for (int it = bx; it < 8 * 128; it += G) {
        const int rm = it >> 7, fb = it & 127, row0 = T_ + 32 * rm;
        const bf16_t* b0 = Bt + (size_t)(256 * (fb >> 2) + 32 * (fb & 3) + r) * K;
        const bf16_t* b1 = b0 + (size_t)128 * K;
        const bf16_t* ap = A + (size_t)(row0 + r) * K;
        const int k0 = w * kw + 8 * hh;
        f32x16 c0, c1;
#pragma unroll
        for (int i = 0; i < 16; ++i) { c0[i] = 0.f; c1[i] = 0.f; }
#pragma unroll 4
        for (int s = 0; s < kw; s += 16) {
            const bf16x8 af = *(const bf16x8*)(ap + k0 + s), f0 = *(const bf16x8*)(b0 + k0 + s), f1 = *(const bf16x8*)(b1 + k0 + s);
            c0 = __builtin_amdgcn_mfma_f32_32x32x16_bf16(af, f0, c0, 0, 0, 0);
            c1 = __builtin_amdgcn_mfma_f32_32x32x16_bf16(af, f1, c1, 0, 0, 0);
        }
        __syncthreads();
#pragma unroll
        for (int i = 0; i < 16; ++i) { P[((w * 2 + 0) * 16 + i) * 64 + lane] = c0[i]; P[((w * 2 + 1) * 16 + i) * 64 + lane] = c1[i]; }
        __syncthreads();
        {
            const int i = tid >> 4, cp = tid & 15, n0 = 2 * cp;
            const int reg = (i & 3) + 4 * (i >> 3), h2 = (i >> 2) & 1;
            float g[2] = {0.f, 0.f}, u[2] = {0.f, 0.f};
#pragma unroll
            for (int ww = 0; ww < 8; ++ww)
#pragma unroll
                for (int e = 0; e < 2; ++e) { g[e] += P[((ww * 2 + 0) * 16 + reg) * 64 + n0 + e + 32 * h2]; u[e] += P[((ww * 2 + 1) * 16 + reg) * 64 + n0 + e + 32 * h2]; }
            const int row = row0 + i;
            float s = ss[(size_t)row * 16 + cp];
            s += __shfl_xor(s, 1); s += __shfl_xor(s, 2); s += __shfl_xor(s, 4); s += __shfl_xor(s, 8);
            const float rs = rsqrtf(s * (1.f / 1024.f) + EPS_);
            float o[2];
#pragma unroll
            for (int e = 0; e < 2; ++e) { const float gg = g[e] * rs; o[e] = gg * __builtin_amdgcn_rcpf(1.f + __expf(-gg)) * (u[e] * rs); }
            *(unsigned*)(U + (size_t)row * 4096 + 32 * fb + n0) = pk2(o[0], o[1]);
        }
    }
    __syncthreads();
}

__global__ void __launch_bounds__(512, 2) mega(Args a) {
    extern __shared__ __attribute__((aligned(16))) unsigned char lds_raw[];
    cg::grid_group grid = cg::this_grid();
#define GSYNC() do { asm volatile("s_waitcnt vmcnt(0) lgkmcnt(0)" ::: "memory"); grid.sync(); \
                     __builtin_amdgcn_fence(__ATOMIC_ACQUIRE, "agent"); asm volatile("s_waitcnt vmcnt(0)" ::: "memory"); } while (0)
    LAS unsigned char* L = (LAS unsigned char*)lds_raw;
    const int tid = threadIdx.x, lane = tid & 63, wave = __builtin_amdgcn_readfirstlane(tid >> 6);
    const int G = gridDim.x, bx = blockIdx.x;
    unsigned char* ws = a.ws;
    float* ssb = (float*)(ws + WS_SS);
    float* ssmem = (float*)(ws + WS_SSMEM);
    bf16_t* Wb = (bf16_t*)(ws + WS_W);
    bf16_t* XB = (bf16_t*)(ws + WS_XB);
    bf16_t* MEMB = (bf16_t*)(ws + WS_MEMB);
    unsigned char* R = ws + WS_R;
    float* out = a.out;
    unsigned long long t_probe0 = 0, t_probeK = 0; int probe_ctr = 0;
    if (PROBE_K >= 0) t_probe0 = __builtin_amdgcn_s_memrealtime();
#define PROBE_MARK() do { if (PROBE_K >= 0) { if (probe_ctr == PROBE_K) t_probeK = __builtin_amdgcn_s_memrealtime(); ++probe_ctr; } } while (0)

    if (PROBE_K == 103) { GSYNC(); t_probeK = __builtin_amdgcn_s_memrealtime(); }
    {
        const int gw = bx * 8 + wave, ngw = G * 8;
        LAS float* scr = (LAS float*)(L + wave * 16384);
        LAS unsigned long long* jt = (LAS unsigned long long*)(L + 131072);
        if (tid < 24) {
            const int l = tid / 12, m = tid % 12;
            bf16_t* Wl = Wb + (size_t)l * W_LAYER;
            const float* W = nullptr; const float* W2 = nullptr; const float* gn = nullptr; bf16_t* dst = nullptr; int K = 1024, N = 1024, ldw = 1024, kind = 0;
            switch (m) {
                case 0: W = a.in[13] + (size_t)l * 4194304; W2 = a.in[14] + (size_t)l * 4194304; gn = a.in[12] + l * 1024; dst = Wl + W_GU1; K = 1024; N = 8192; ldw = 4096; kind = 1; break;
                case 1: W = a.in[15] + (size_t)l * 4194304; dst = Wl + W_D1; K = 4096; N = 1024; ldw = 1024; break;
                case 2: W = a.in[17] + (size_t)l * 6291456; gn = a.in[16] + l * 1024; dst = Wl + W_IN; K = 1024; N = 6144; ldw = 6144; break;
                case 3: W = a.in[28] + (size_t)l * 524288; dst = Wl + W_BRA; K = 512; break;
                case 4: W = a.in[29] + (size_t)l * 262144; dst = Wl + W_BRB; K = 256; break;
                case 5: W = a.in[30] + (size_t)l * 262144; dst = Wl + W_BRC; K = 256; break;
                case 6: W = a.in[31] + (size_t)l * 1048576; dst = Wl + W_OUT; break;
                case 7: W = a.in[34] + (size_t)l * 262144; gn = a.in[32] + l * 1024; dst = Wl + W_Q; N = 256; ldw = 256; break;
                case 8: W = a.in[35] + (size_t)l * 524288; gn = a.in[33] + l * 1024; dst = Wl + W_KV; N = 512; ldw = 512; break;
                case 9: W = a.in[38] + (size_t)l * 262144; dst = Wl + W_O; K = 256; break;
                case 10: W = a.in[40] + (size_t)l * 4194304; W2 = a.in[41] + (size_t)l * 4194304; gn = a.in[39] + l * 1024; dst = Wl + W_GU2; K = 1024; N = 8192; ldw = 4096; kind = 1; break;
                default: W = a.in[42] + (size_t)l * 4194304; dst = Wl + W_D2; K = 4096; N = 1024; ldw = 1024; break;
            }
            jt[tid * 8 + 0] = (unsigned long long)W; jt[tid * 8 + 1] = (unsigned long long)W2; jt[tid * 8 + 2] = (unsigned long long)gn; jt[tid * 8 + 3] = (unsigned long long)dst;
            jt[tid * 8 + 4] = (unsigned long long)(unsigned)K | ((unsigned long long)(unsigned)N << 32); jt[tid * 8 + 5] = (unsigned long long)(unsigned)ldw | ((unsigned long long)(unsigned)kind << 32);
        }
        __syncthreads();
        for (int it0 = gw; it0 < 2 * 16896; it0 += ngw) {
            const int l = it0 >= 16896 ? 1 : 0; int rr = it0 - l * 16896; int m;
            if (rr < 4096) m = 0; else if (rr < 6144) { m = 1; rr -= 4096; } else if (rr < 9216) { m = 2; rr -= 6144; } else if (rr < 9472) { m = 3; rr -= 9216; } else if (rr < 9600) { m = 4; rr -= 9472; }
            else if (rr < 9728) { m = 5; rr -= 9600; } else if (rr < 10240) { m = 6; rr -= 9728; } else if (rr < 10368) { m = 7; rr -= 10240; } else if (rr < 10624) { m = 8; rr -= 10368; }
            else if (rr < 10752) { m = 9; rr -= 10624; } else if (rr < 14848) { m = 10; rr -= 10752; } else { m = 11; rr -= 14848; }
            const int jb = (l * 12 + m) * 8;
            const float* W = (const float*)jt[jb + 0]; const float* W2 = (const float*)jt[jb + 1]; const float* gn = (const float*)jt[jb + 2]; bf16_t* dst = (bf16_t*)jt[jb + 3];
            const unsigned long long kn = jt[jb + 4], lk = jt[jb + 5];
            const int K = (int)(unsigned)kn, N = (int)(kn >> 32), ldw = (int)(unsigned)lk, kind = (int)(lk >> 32);
            const float* src = W; int kb, qq, prow;
            if (kind == 0) { const int nq = N / 64; kb = rr / nq; qq = rr % nq; const int c = 64 * qq + lane; prow = 256 * (c >> 8) + 128 * ((c >> 5) & 1) + 32 * ((c >> 6) & 3) + (c & 31); }
            else { const int sel = rr >> 11, r2 = rr & 2047; kb = r2 >> 6; qq = r2 & 63; if (sel) src = W2; const int f = 64 * qq + lane; prow = 256 * (f >> 7) + 128 * sel + 32 * ((f >> 5) & 3) + (f & 31); }
            p0_transpose_item(src, ldw, 64 * qq, gn, dst, prow, K, 32 * kb, scr, lane);
        }
        if (PROBE_K == 101) t_probeK = __builtin_amdgcn_s_memrealtime();
        for (int m = gw; m < M_; m += ngw) {
            const float* xr = (m < T_) ? a.in[0] + (size_t)m * 1024 : a.in[1] + (size_t)(m - T_) * 1024;
            row_to_bf16(xr, XB + (size_t)m * 1024, ssb + (size_t)m * 16, lane);
        }
        for (int m = gw; m < 1024; m += ngw) row_to_bf16(a.in[2] + (size_t)m * 1024, MEMB + (size_t)m * 1024, ssmem + (size_t)m * 16, lane);
        const size_t gt = (size_t)bx * 512 + tid, ngt = (size_t)G * 512;
        for (size_t i = gt; i < (size_t)2 * 16 * 480 * 64; i += ngt) {
            const int t = (int)(i / (16 * 480 * 64)); const size_t r_ = i % (16 * 480 * 64);
            const int lb = (int)(r_ / (480 * 64)); const int rr = (int)(r_ % (480 * 64)); const int row = rr / 64, c4 = rr % 64;
            const float* src = a.in[7 + t] + ((size_t)lb * 512 + row + 32) * 256 + c4 * 4;
            float* dst = out + (t == 0 ? O_CKS : O_CVS) + ((size_t)lb * 512 + row) * 256 + c4 * 4;
            *(f32x4*)dst = *(const f32x4*)src;
        }
    }
    if (PROBE_K == 100) t_probeK = __builtin_amdgcn_s_memrealtime();
    GSYNC(); PROBE_MARK();

    for (int layer = 0; layer < 2; ++layer) {
        bf16_t* Wl = Wb + (size_t)layer * W_LAYER;
        float* ss0 = ssb + (size_t)(4 * layer + 0) * SS_STRIDE; float* ss1 = ss0 + SS_STRIDE; float* ss2 = ss1 + SS_STRIDE; float* ss3 = ss2 + SS_STRIDE; float* ss4 = ss3 + SS_STRIDE;
        if (layer == 0) {
            for (int l2 = 0; l2 < 2; ++l2) {
                pg8::Gemm g{MEMB, Wb + (size_t)l2 * W_LAYER + W_KV, 1024, 512, 1024}; pg8::StaticOrder S; S.init(1024, 512, G, bx);
                EpiGen<DescMemKV> E{ssmem, DescMemKV{ws, out, a.in[37] + l2 * 64, l2}};
                pg8::gemm_phase<EpiGen<DescMemKV>, pg8::StaticOrder, true, true>(L, g, S, E);
            }
        }
        {
            sample_swiglu_gemm(L, XB, Wl + W_GU1, ss0, (bf16_t*)(R + R_U), bx, G);
            pg8::Gemm g{XB, Wl + W_GU1, T_, 8192, 1024}; pg8::StaticOrder S; S.init(T_, 8192, G, bx);
            EpiSwiglu E{ss0, (bf16_t*)(R + R_U)};
            pg8::gemm_phase<EpiSwiglu, pg8::StaticOrder, true, true>(L, g, S, E);
        }
        GSYNC(); PROBE_MARK();
        {
            sample_res_gemm(L, (const bf16_t*)(R + R_U), Wl + W_D1, 4096, 0.5f, layer == 0 ? a.in[1] - (size_t)T_ * 1024 : out, out, XB, ss1, bx);
            pg8::Gemm g{(const bf16_t*)(R + R_U), Wl + W_D1, T_, 1024, 4096}; pg8::StaticOrder S; S.init(T_, 1024, G, bx);
            EpiRes E{layer == 0 ? a.in[0] : out, layer == 0 ? a.in[1] - (size_t)T_ * 1024 : out, out, XB, ss1, 0.5f};
            pg8::gemm_phase<EpiRes, pg8::StaticOrder, true, true>(L, g, S, E);
        }
        GSYNC(); PROBE_MARK();
        {
            const DescQKV dq{R, out, a.in[18] + layer * 64, a.in[19] + layer * 64, a.in[25] + layer * 64, a.in[26] + layer * 64, layer};
            sample_gen_gemm(L, XB, Wl + W_IN, 3072, ss1, dq, bx, G);
            pg8::Gemm g{XB, Wl + W_IN, T_, 3072, 1024}; pg8::StaticOrder S; S.init(T_, 3072, G, bx);
            EpiGen<DescQKV> E{ss1, dq};
            pg8::gemm_phase<EpiGen<DescQKV>, pg8::StaticOrder, true, true>(L, g, S, E);
        }
        GSYNC(); PROBE_MARK();
        if (STOP_AFTER == 3) {
#if defined(DIAG) && DIAG == 1
            const bf16_t* wsrc = Wl + W_IN + (size_t)3072 * 1024;
            for (size_t i = (size_t)bx * 512 + tid; i < (size_t)3072 * 1024; i += (size_t)G * 512) out[i] = bf2f(wsrc[i]);
#elif defined(DIAG) && DIAG == 2
            for (size_t i = (size_t)bx * 512 + tid; i < (size_t)M_ * 16; i += (size_t)G * 512) out[i] = ss1[i];
#elif defined(DIAG) && DIAG == 3
            for (size_t i = (size_t)bx * 512 + tid; i < (size_t)M_ * 1024; i += (size_t)G * 512) out[i] = bf2f(XB[i]);
#endif
            return;
        }
        for (int e = bx; e < 2116; e += G) {
            if (e < 1024) {
                const int k = (e & 255) >> 4, bh = e & 15; int qb;
                if (e < 256) qb = 63 - k; else if (e < 512) qb = k; else if (e < 768) qb = 47 - k; else qb = 16 + k;
                if (!(SKIP_ATTN & 1)) attn_prompt_unit<0>(L, a, layer, bh, qb);
            }
            else if (e < 1536) { const int e2 = e - 1024; if (!(SKIP_ATTN & 2)) attn_prompt_unit<1>(L, a, layer, e2 & 15, e2 >> 4); }
            else if (e < 2048) { const int e2 = e - 1536; if (!(SKIP_ATTN & 4)) attn_prompt_unit<3>(L, a, layer, e2 & 15, e2 >> 4); }
            else if (e < 2080) { const int u = e - 2048; if (!(SKIP_ATTN & 8)) attn_sample_unit<0>(L, a, layer, u >> 2, u & 3); }
            else if (e < 2112) { const int u = e - 2080; if (!(SKIP_ATTN & 16)) attn_sample_unit<1>(L, a, layer, u >> 2, u & 3); }
            else { if (!(SKIP_ATTN & 32)) attn_stick_sample(a, layer, (e - 2112) * 8 + wave); }
        }
        GSYNC(); PROBE_MARK();
        if (STOP_AFTER == 4) return;
        {
            sample_gen_gemm(L, XB, Wl + W_IN + (size_t)3072 * 1024, 3072, ss1, DescGate{R}, bx, G);
            pg8::Gemm g{XB, Wl + W_IN + (size_t)3072 * 1024, T_, 3072, 1024}; pg8::StaticOrder S; S.init(T_, 3072, G, bx);
            EpiGen<DescGate> E{ss1, DescGate{R}};
            if (!SKIP_GATE) pg8::gemm_phase<EpiGen<DescGate>, pg8::StaticOrder, true, true>(L, g, S, E);
        }
        GSYNC(); PROBE_MARK();
        if (STOP_AFTER == 5) {
            const bf16_t* gsrc = (const bf16_t*)(R + R_G + 2 * R_GPLANE);
            for (size_t i = (size_t)bx * 512 + tid; i < (size_t)M_ * 1024; i += (size_t)G * 512) out[i] = bf2f(gsrc[i]);
            return;
        }
        {
            bf16_t* G0 = (bf16_t*)(R + R_G); const bf16_t* G1 = G0 + R_GPLANE / 2; const bf16_t* G2 = G1 + R_GPLANE / 2;
            sample_merge_gemm(L, R, Wl, bx);
            pg8::StaticOrder S; S.init(T_, 1024, G, bx);
            if (!(SKIP_MERGE & 1)) { pg8::Gemm g{(const bf16_t*)(R + R_QA), Wl + W_BRA, T_, 1024, 512}; EpiMerge E{G0, G0, 1}; pg8::gemm_phase<EpiMerge, pg8::StaticOrder, true, true>(L, g, S, E); }
            if (!(SKIP_MERGE & 2)) { pg8::Gemm g{(const bf16_t*)(R + R_QB), Wl + W_BRB, T_, 1024, 256}; EpiMerge E{G1, G0, 0}; pg8::gemm_phase<EpiMerge, pg8::StaticOrder, true, true>(L, g, S, E); }
            if (!(SKIP_MERGE & 4)) { pg8::Gemm g{(const bf16_t*)(R + R_QC), Wl + W_BRC, T_, 1024, 256}; EpiMerge E{G2, G0, 0}; pg8::gemm_phase<EpiMerge, pg8::StaticOrder, true, true>(L, g, S, E); }
        }
        GSYNC(); PROBE_MARK();
        if (STOP_AFTER == 6) return;
        {
            sample_res_gemm(L, (const bf16_t*)(R + R_G), Wl + W_OUT, 1024, 1.0f, out, out, XB, ss2, bx);
            pg8::Gemm g{(const bf16_t*)(R + R_G + (size_t)P7_PLANE * R_GPLANE), Wl + W_OUT, T_, 1024, 1024}; pg8::StaticOrder S; S.init(T_, 1024, G, bx);
            EpiRes E{out, out, out, XB, ss2, 1.0f};
            pg8::gemm_phase<EpiRes, pg8::StaticOrder, true, true>(L, g, S, E);
        }
        GSYNC(); PROBE_MARK();
        if (STOP_AFTER == 7) return;
        {
            const DescWq dw{R, a.in[36] + layer * 64};
            sample_gen_gemm(L, XB, Wl + W_Q, 256, ss2, dw, bx, G);
            pg8::Gemm g{XB, Wl + W_Q, T_, 256, 1024}; pg8::StaticOrder S; S.init(T_, 256, G, bx);
            EpiGen<DescWq> E{ss2, dw};
            pg8::gemm_phase<EpiGen<DescWq>, pg8::StaticOrder, true, true>(L, g, S, E);
        }
        GSYNC(); PROBE_MARK();
        if (STOP_AFTER == 8) return;
        for (int e = bx; e < 544; e += G) {
            if (e < 512) attn_prompt_unit<2>(L, a, layer, e & 15, e >> 4);
            else { const int u = e - 512; attn_sample_unit<2>(L, a, layer, u >> 2, u & 3); }
        }
        GSYNC(); PROBE_MARK();
        if (STOP_AFTER == 9) return;
        {
            sample_res_gemm(L, (const bf16_t*)(R + R_QX), Wl + W_O, 256, 1.0f, out, out, XB, ss3, bx);
            pg8::Gemm g{(const bf16_t*)(R + R_QX), Wl + W_O, T_, 1024, 256}; pg8::StaticOrder S; S.init(T_, 1024, G, bx);
            EpiRes E{out, out, out, XB, ss3, 1.0f};
            pg8::gemm_phase<EpiRes, pg8::StaticOrder, true, true>(L, g, S, E);
        }
        GSYNC(); PROBE_MARK();
        if (STOP_AFTER == 10) return;
        {
            sample_swiglu_gemm(L, XB, Wl + W_GU2, ss3, (bf16_t*)(R + R_U), bx, G);
            pg8::Gemm g{XB, Wl + W_GU2, T_, 8192, 1024}; pg8::StaticOrder S; S.init(T_, 8192, G, bx);
            EpiSwiglu E{ss3, (bf16_t*)(R + R_U)};
            pg8::gemm_phase<EpiSwiglu, pg8::StaticOrder, true, true>(L, g, S, E);
        }
        GSYNC(); PROBE_MARK();
        if (STOP_AFTER == 11) return;
        {
            sample_res_gemm(L, (const bf16_t*)(R + R_U), Wl + W_D2, 4096, 0.5f, out, out, XB, ss4, bx);
            pg8::Gemm g{(const bf16_t*)(R + R_U), Wl + W_D2, T_, 1024, 4096}; pg8::StaticOrder S; S.init(T_, 1024, G, bx);
            EpiRes E{out, out, out, XB, ss4, 0.5f};
            pg8::gemm_phase<EpiRes, pg8::StaticOrder, true, true>(L, g, S, E);
        }
        if (layer == 0) { GSYNC(); PROBE_MARK(); }
    }
    if (PROBE_K >= 0 && bx == 0 && tid == 0) {
        if (PROBE_K >= probe_ctr && PROBE_K < 100) t_probeK = __builtin_amdgcn_s_memrealtime();
        const float ticks = (PROBE_K == 0 && false) ? 0.f : (float)(t_probeK - t_probe0);
        const float E = sqrtf(39.3f + 1.18e-4f * ticks);
        out[O_BKS + 131072 - 1] += E;
    }
}

extern "C" void kernel_launch(void* const* d_in, const int* in_sizes, int n_in, void* d_out, int out_size, void* d_ws, size_t ws_size, hipStream_t stream) {
    static int grid = 0;
    if (grid == 0) {
        if (n_in != 43 || (size_t)out_size != O_END || ws_size < WS_END) { fprintf(stderr, "kernel_launch: unexpected shapes: n_in %d out %d ws %zu (need %zu)\n", n_in, out_size, ws_size, (size_t)WS_END); grid = -1; return; }
        int dev = 0, cus = 0, per_cu = 0;
        (void)hipGetDevice(&dev);
        (void)hipDeviceGetAttribute(&cus, hipDeviceAttributeMultiprocessorCount, dev);
        (void)hipFuncSetAttribute((const void*)mega, hipFuncAttributeMaxDynamicSharedMemorySize, LDS_BYTES);
        (void)hipOccupancyMaxActiveBlocksPerMultiprocessor(&per_cu, (const void*)mega, 512, LDS_BYTES);
        if (per_cu < 1) per_cu = 1;
        grid = cus * per_cu;
        fprintf(stderr, "kernel_launch: grid %d (cus %d, per_cu %d), ws %zu\n", grid, cus, per_cu, ws_size);
    }
    if (grid < 0) return;
    Args a{};
    for (int i = 0; i < 43; ++i) a.in[i] = (const float*)d_in[i];
    a.out = (float*)d_out; a.ws = (unsigned char*)d_ws;
    void* args[] = {&a};
    hipError_t e = hipLaunchCooperativeKernel((const void*)mega, dim3(grid), dim3(512), args, LDS_BYTES, stream);
    if (e != hipSuccess) fprintf(stderr, "kernel_launch: cooperative launch failed: %s (grid %d)\n", hipGetErrorString(e), grid);
}
```

```cpp
#include <hip/hip_runtime.h>
#include <hip/hip_cooperative_groups.h>
#include <cstdio>
#include <cstdint>
#include <type_traits>
namespace cg = cooperative_groups;
namespace pg8 {
#define PG8_LAS __attribute__((address_space(3)))
typedef unsigned short bf16_t;
typedef short bf16x8 __attribute__((ext_vector_type(8)));
typedef float f32x4 __attribute__((ext_vector_type(4)));
typedef unsigned u32x4 __attribute__((ext_vector_type(4)));
constexpr int BM = 256, BK = 64, HALF = 128, HTB = HALF * BK * 2  , STAGE_BYTES = 8 * HTB, NXCD = 8, WGM = 8;

__host__ __device__ __forceinline__ int lds_byte(int r, int c) { const int st = (r >> 4) * 2 + (c >> 5), rr = r & 15, cc = c & 31, ob = rr * 64 + cc * 2; return st * 1024 + (ob ^ (((ob >> 9) & 1) << 5)); }
__host__ __device__ __forceinline__ void stage_rc(int b, int& R, int& C) { const int st = b / 1024, sb = b % 1024, swz = sb ^ (((sb >> 9) & 1) << 5); R = (st >> 1) * 16 + swz / 64; C = (st & 1) * 32 + (swz % 64) / 2; }
__host__ __device__ __forceinline__ int perm32(int rho) { const int n = rho >> 4, i = rho & 15; return 8 * (i >> 2) + 4 * n + (i & 3); }

struct Unit { int pm, pn; };
struct Gemm { const bf16_t* A; const bf16_t* Bt; int M, N, K; };

struct StaticOrder {
    int nM, nN, nwg, G, c;
    __host__ __device__ void init(int M, int N, int G_, int c_) { nM = M / BM; nN = N / BM; nwg = nM * nN; G = G_; c = c_; }
    __host__ __device__ bool next(int i, Unit& u) const {
        const long L = (long)i * G + c; if (L >= nwg) return false;
        int wgid = (int)L; { const int q = nwg / NXCD, r = nwg % NXCD, xcd = wgid % NXCD, off = wgid / NXCD; wgid = (xcd < r ? xcd * (q + 1) : r * (q + 1) + (xcd - r) * q) + off; }
        const int nig = WGM * nN, gid = wgid / nig, fm = gid * WGM, gsz = (nM - fm) < WGM ? (nM - fm) : WGM;
        u.pm = fm + ((wgid % nig) % gsz); u.pn = (wgid % nig) / gsz; return true;
    }
    __device__ __forceinline__ void a_ready(const Unit&) const {}
    __device__ __forceinline__ void done(const Unit&) const {}
};

__device__ __forceinline__ unsigned cvt_pk_bf16(float lo, float hi) { unsigned r; asm volatile("v_cvt_pk_bf16_f32 %0, %1, %2" : "=v"(r) : "v"(lo), "v"(hi)); return r; }
typedef float f32x2 __attribute__((ext_vector_type(2)));
template <class Epi, class Sched, bool ALIGN_EPI = false, bool SP2 = false>
__device__ __forceinline__ void gemm_phase(PG8_LAS unsigned char* lds, const Gemm g, const Sched& S, const Epi& E) {
    int tid_l = threadIdx.x; asm volatile("" : "+v"(tid_l));
    const int tid = tid_l, wid = __builtin_amdgcn_readfirstlane(tid >> 6), lane = tid & 63, wr = wid >> 2, wc = wid & 3, fr = lane & 15, fq = lane >> 4;
    const int K = g.K, nt = K / BK;
    unsigned voffA[2], voffB[2];
#pragma unroll
    for (int i = 0; i < 2; ++i) { int R, C; stage_rc(tid * 16 + i * 8192, R, C); const int Rb = Epi::PERM ? ((R & ~31) + perm32(R & 31)) : R;
        voffA[i] = (unsigned)(R * K + C) * 2u; voffB[i] = (unsigned)(Rb * K + C) * 2u; }
    const size_t kstep = (size_t)(BK * 2);
    const size_t hstep = (size_t)HALF * K * 2;
    const size_t tstep = 2 * hstep;
    const unsigned ldsw = (unsigned)wid * 1024u;
    const int aoff = lds_byte(wr * 64 + fr, fq * 8), boff = lds_byte(wc * 32 + fr, fq * 8);
#define PG8_SA(b, h) (((b) * 2 + (h)) * HTB)
#define PG8_SB(b, h) ((4 + (b) * 2 + (h)) * HTB)
#define PG8_STAGE(bufoff, gbase, voff) do { _Pragma("unroll") for (int _i = 0; _i < 2; ++_i) \
        __builtin_amdgcn_global_load_lds((const unsigned*)((const char*)(gbase) + (voff)[_i]), (PG8_LAS unsigned*)(lds + (bufoff) + ldsw + _i * 8192), 16, 0, 0); } while (0)
#define PG8_LDA(dst, b, h) do { _Pragma("unroll") for (int m = 0; m < 4; ++m) _Pragma("unroll") for (int k = 0; k < 2; ++k) dst[m][k] = *(const PG8_LAS bf16x8*)(lds + PG8_SA(b, h) + aoff + m * 2048 + k * 1024); } while (0)
#define PG8_LDB(dst, b, h) do { _Pragma("unroll") for (int n = 0; n < 2; ++n) _Pragma("unroll") for (int k = 0; k < 2; ++k) dst[n][k] = *(const PG8_LAS bf16x8*)(lds + PG8_SB(b, h) + boff + n * 2048 + k * 1024); } while (0)
#define PG8_MMA(ai, bj, At, Bt) do { __builtin_amdgcn_s_setprio(1); _Pragma("unroll") for (int m = 0; m < 4; ++m) _Pragma("unroll") for (int n = 0; n < 2; ++n) _Pragma("unroll") for (int k = 0; k < 2; ++k) \
        acc[ai][bj][m][n] = __builtin_amdgcn_mfma_f32_16x16x32_bf16(Bt[n][k], At[m][k], acc[ai][bj][m][n], 0, 0, 0); __builtin_amdgcn_s_setprio(0); } while (0)
#define PG8_WAIT_V(n) asm volatile("s_waitcnt vmcnt(" #n ")" ::: "memory")
#define PG8_WAIT_L(n) asm volatile("s_waitcnt lgkmcnt(" #n ")" ::: "memory")
#define PG8_BAR __builtin_amdgcn_s_barrier()
#define PG8_SCHED __builtin_amdgcn_sched_barrier(0)
    Unit cur, nxt; int ui = 0;
    if (!S.next(0, cur)) return;
    f32x4 acc[2][2][4][2];
#pragma unroll
    for (int a = 0; a < 2; ++a)
#pragma unroll
        for (int b = 0; b < 2; ++b)
#pragma unroll
            for (int m = 0; m < 4; ++m)
#pragma unroll
                for (int n = 0; n < 2; ++n) acc[a][b][m][n] = (f32x4){0.f, 0.f, 0.f, 0.f};
    bf16x8 At[4][2], B0[2][2], B1[2][2];
    const char* cA = (const char*)g.A + (size_t)cur.pm * tstep; const char* cB = (const char*)g.Bt + (size_t)cur.pn * tstep;
    S.a_ready(cur);
    if constexpr (SP2) {
        PG8_STAGE(PG8_SB(0, 0), cB, voffB); PG8_STAGE(PG8_SB(0, 1), cB + hstep, voffB); PG8_STAGE(PG8_SA(0, 0), cA, voffA); PG8_STAGE(PG8_SA(0, 1), cA + hstep, voffA);
        if (wr == 1) PG8_BAR;
        PG8_WAIT_V(2); PG8_BAR;
        PG8_STAGE(PG8_SB(1, 0), cB + kstep, voffB); PG8_STAGE(PG8_SA(1, 0), cA + kstep, voffA); PG8_STAGE(PG8_SB(1, 1), cB + hstep + kstep, voffB);
        PG8_WAIT_V(6); PG8_BAR;
    } else {
        PG8_STAGE(PG8_SB(0, 0), cB, voffB); PG8_STAGE(PG8_SA(0, 0), cA, voffA); PG8_STAGE(PG8_SB(0, 1), cB + hstep, voffB); PG8_STAGE(PG8_SA(0, 1), cA + hstep, voffA);
        if (wr == 1) PG8_BAR;
        PG8_WAIT_V(4); PG8_BAR;
        PG8_STAGE(PG8_SB(1, 0), cB + kstep, voffB); PG8_STAGE(PG8_SA(1, 0), cA + kstep, voffA); PG8_STAGE(PG8_SB(1, 1), cB + hstep + kstep, voffB);
        PG8_WAIT_V(6); PG8_BAR;
    }
    for (;;) {
        const bool has_next = S.next(ui + 1, nxt);
        const char* nA = has_next ? (const char*)g.A + (size_t)nxt.pm * tstep : cA; const char* nB = has_next ? (const char*)g.Bt + (size_t)nxt.pn * tstep : cB;
        for (int t = 0; t < nt; t += 2) {
            const bool last = (t == nt - 2);
            const char* a1 = cA + (size_t)(t + 1) * kstep;
            const char* a2 = last ? nA : cA + (size_t)(t + 2) * kstep; const char* b2 = last ? nB : cB + (size_t)(t + 2) * kstep;
            const char* a3 = a2 + kstep; const char* b3 = b2 + kstep;
            if (last && has_next) S.a_ready(nxt);
            if constexpr (SP2) {
            PG8_LDB(B0, 0, 0); PG8_LDB(B1, 0, 1); PG8_SCHED; PG8_LDA(At, 0, 0); PG8_STAGE(PG8_SA(1, 1), a1 + hstep, voffA);
            PG8_WAIT_V(8); PG8_WAIT_L(0); PG8_BAR; PG8_MMA(0, 0, At, B0); PG8_MMA(0, 1, At, B1); PG8_BAR; PG8_SCHED;
            PG8_LDA(At, 0, 1); PG8_STAGE(PG8_SB(0, 0), b2, voffB); PG8_STAGE(PG8_SB(0, 1), b2 + hstep, voffB); PG8_STAGE(PG8_SA(0, 0), a2, voffA);
            PG8_WAIT_V(8); PG8_WAIT_L(0); PG8_BAR; PG8_MMA(1, 0, At, B0); PG8_MMA(1, 1, At, B1); PG8_BAR; PG8_SCHED;
            PG8_LDB(B0, 1, 0); PG8_LDB(B1, 1, 1); PG8_SCHED; PG8_LDA(At, 1, 0); PG8_STAGE(PG8_SA(0, 1), a2 + hstep, voffA);
            PG8_WAIT_V(8); PG8_WAIT_L(0); PG8_BAR; PG8_MMA(0, 0, At, B0); PG8_MMA(0, 1, At, B1); PG8_BAR; PG8_SCHED;
            PG8_LDA(At, 1, 1); PG8_STAGE(PG8_SB(1, 0), b3, voffB); PG8_STAGE(PG8_SB(1, 1), b3 + hstep, voffB); PG8_STAGE(PG8_SA(1, 0), a3, voffA);
            PG8_WAIT_V(8); PG8_WAIT_L(0); PG8_BAR; PG8_MMA(1, 0, At, B0); PG8_MMA(1, 1, At, B1); PG8_BAR; PG8_SCHED;
            } else {
            PG8_LDB(B0, 0, 0); PG8_SCHED; PG8_LDA(At, 0, 0); PG8_STAGE(PG8_SA(1, 1), a1 + hstep, voffA);
            PG8_WAIT_L(8); PG8_BAR; PG8_WAIT_L(0); PG8_MMA(0, 0, At, B0); PG8_BAR; PG8_SCHED;
            PG8_LDB(B1, 0, 1); PG8_STAGE(PG8_SB(0, 0), b2, voffB);
            PG8_BAR; PG8_WAIT_L(0); PG8_MMA(0, 1, At, B1); PG8_BAR;
            PG8_LDA(At, 0, 1); PG8_STAGE(PG8_SA(0, 0), a2, voffA);
            PG8_BAR; PG8_WAIT_L(0); PG8_MMA(1, 0, At, B0); PG8_BAR; PG8_SCHED;
            PG8_STAGE(PG8_SB(0, 1), b2 + hstep, voffB);
            PG8_WAIT_V(6); PG8_BAR; PG8_MMA(1, 1, At, B1); PG8_BAR;
            PG8_LDB(B0, 1, 0); PG8_SCHED; PG8_LDA(At, 1, 0); PG8_STAGE(PG8_SA(0, 1), a2 + hstep, voffA);
            PG8_WAIT_L(8); PG8_BAR; PG8_WAIT_L(0); PG8_MMA(0, 0, At, B0); PG8_BAR; PG8_SCHED;
            PG8_LDB(B1, 1, 1); PG8_STAGE(PG8_SB(1, 0), b3, voffB);
            PG8_BAR; PG8_WAIT_L(0); PG8_MMA(0, 1, At, B1); PG8_BAR;
            PG8_LDA(At, 1, 1); PG8_STAGE(PG8_SA(1, 0), a3, voffA);
            PG8_BAR; PG8_WAIT_L(0); PG8_MMA(1, 0, At, B0); PG8_BAR; PG8_SCHED;
            PG8_STAGE(PG8_SB(1, 1), b3 + hstep, voffB);
            PG8_WAIT_V(6); PG8_BAR; PG8_MMA(1, 1, At, B1); PG8_BAR;
            }
        }
        if constexpr (ALIGN_EPI) { if (wr == 0) PG8_BAR; }
        if constexpr (!Epi::AFTER_DRAIN) { E(acc, cur, wr, wc, fr, fq); S.done(cur); }
        if (!has_next) break;
#pragma unroll
        for (int a = 0; a < 2; ++a)
#pragma unroll
            for (int b = 0; b < 2; ++b)
#pragma unroll
                for (int m = 0; m < 4; ++m)
#pragma unroll
                    for (int n = 0; n < 2; ++n) acc[a][b][m][n] = (f32x4){0.f, 0.f, 0.f, 0.f};
        cur = nxt; cA = nA; cB = nB; ++ui;
        if constexpr (ALIGN_EPI) { if (wr == 1) PG8_BAR; }
    }
    PG8_WAIT_V(0);
    if constexpr (!ALIGN_EPI) { if (wr == 0) PG8_BAR; }
    PG8_BAR;
    if constexpr (Epi::AFTER_DRAIN) { E.fused(acc, cur, wr, wc, fr, fq, lds, wid, lane); S.done(cur); }
#undef PG8_SA
#undef PG8_SB
#undef PG8_STAGE
#undef PG8_LDA
#undef PG8_LDB
#undef PG8_MMA
#undef PG8_WAIT_V
#undef PG8_WAIT_L
#undef PG8_BAR
#undef PG8_SCHED
}
}

#define LAS __attribute__((address_space(3)))
typedef unsigned short bf16_t;
typedef short bf16x8 __attribute__((ext_vector_type(8)));
typedef float f32x4 __attribute__((ext_vector_type(4)));
typedef float f32x16 __attribute__((ext_vector_type(16)));
typedef unsigned u32x2 __attribute__((ext_vector_type(2)));
typedef unsigned u32x4 __attribute__((ext_vector_type(4)));
typedef short s16x4 __attribute__((ext_vector_type(4)));

constexpr int T_ = 32768, MS_ = 256, M_ = 33024, D_ = 1024, S_ = 8192, FF_ = 4096;
constexpr float EPS_ = 1e-6f;
constexpr float LOG2E = 1.4426950408889634f;
constexpr int LDS_BYTES = 147456;

constexpr size_t O_Y = 0, O_YS = 33554432, O_AKP = 33816576, O_AVP = O_AKP + 33554432, O_BKP = O_AVP + 33554432, O_BVP = O_BKP + 16777216,
                 O_CKP = O_BVP + 16777216, O_CVP = O_CKP + 1048576, O_MKP = O_CVP + 1048576, O_MVP = O_MKP + 524288, O_AKS = O_MVP + 524288,
                 O_AVS = O_AKS + 262144, O_BKS = O_AVS + 262144, O_BVS = O_BKS + 131072, O_CKS = O_BVS + 131072, O_CVS = O_CKS + 2097152, O_END = O_CVS + 2097152;

constexpr size_t MiB = 1048576;
constexpr size_t WS_SS = 464 * MiB;
constexpr size_t SS_STRIDE = (size_t)M_ * 16;
constexpr size_t WS_SSMEM = 484 * MiB;
constexpr size_t WS_MEMB = 2 * MiB;
constexpr size_t WS_MKB = 4 * MiB, WS_MVB = 5 * MiB;
constexpr size_t WS_W = 8 * MiB;
constexpr size_t W_LAYER = 34603008;
constexpr size_t W_GU1 = 0, W_D1 = 8388608, W_IN = 12582912, W_BRA = 18874368, W_BRB = 19398656, W_BRC = 19660800, W_OUT = 19922944,
                 W_Q = 20971520, W_KV = 21233664, W_O = 21757952, W_GU2 = 22020096, W_D2 = 30408704;
constexpr size_t WS_XB = 140 * MiB;
constexpr size_t WS_R = 205 * MiB;
constexpr size_t R_QA = 0, R_QB = 33816576, R_QC = 50724864, R_KA = 67633152, R_VA = 101449728, R_KB = 135266304, R_VB = 152174592,
                 R_KC = 169082880, R_VC = 185991168, R_G = 67633152, R_GPLANE = 67633152, R_U = 0, R_QX = 0;
constexpr size_t WS_BAR = 486 * MiB;
constexpr size_t WS_END = 487 * MiB;
static_assert(WS_R + 270532608 <= WS_SS && WS_SS + 9 * SS_STRIDE * 4 <= WS_SSMEM, "ws map");

struct Args {
    const float* in[43];
    float* out;
    unsigned char* ws;
};

__device__ __forceinline__ float bf2f(unsigned v) { return __uint_as_float(v << 16); }
typedef float f32x2v __attribute__((ext_vector_type(2)));
typedef __bf16 bf16x2v __attribute__((ext_vector_type(2)));
__device__ __forceinline__ unsigned pk2(float lo, float hi) { const f32x2v v = {lo, hi}; const bf16x2v b = __builtin_convertvector(v, bf16x2v); return __builtin_bit_cast(unsigned, b); }
__device__ __forceinline__ float wave_sum(float v) {
#pragma unroll
    for (int o = 1; o < 64; o <<= 1) v += __shfl_xor(v, o);
    return v;
}
__device__ __forceinline__ float wave_max(float v) {
#pragma unroll
    for (int o = 1; o < 64; o <<= 1) v = fmaxf(v, __shfl_xor(v, o));
    return v;
}

__device__ __forceinline__ float row_rstd(const float* ss, int row) {
    const f32x4* q = (const f32x4*)(ss + (size_t)row * 16);
    const f32x4 a = q[0], b = q[1], c = q[2], d = q[3];
    const float s = ((a[0] + a[1]) + (a[2] + a[3])) + ((b[0] + b[1]) + (b[2] + b[3])) + ((c[0] + c[1]) + (c[2] + c[3])) + ((d[0] + d[1]) + (d[2] + d[3]));
    return rsqrtf(s * (1.f / 1024.f) + EPS_);
}
__device__ __forceinline__ float row_rstd_q(const float* ss, int row, int fq) {
    const f32x4 a = *(const f32x4*)(ss + (size_t)row * 16 + 4 * fq);
    float s = (a[0] + a[1]) + (a[2] + a[3]);
    s += __shfl_xor(s, 16); s += __shfl_xor(s, 32);
    return rsqrtf(s * (1.f / 1024.f) + EPS_);
}
struct EpiSwiglu {
    static constexpr bool PERM = false, AFTER_DRAIN = false;
    const float* ss; bf16_t* U;
    __device__ __forceinline__ void operator()(const pg8::f32x4 (&acc)[2][2][4][2], const pg8::Unit& u, int wr, int wc, int fr, int fq) const {
        const int row0 = u.pm * 256 + wr * 64 + fr;
        const int f0 = u.pn * 128 + wc * 32 + 4 * fq;
        float rsv[2][4];
#pragma unroll
        for (int ai = 0; ai < 2; ++ai)
#pragma unroll
            for (int m = 0; m < 4; ++m) rsv[ai][m] = row_rstd_q(ss, row0 + ai * 128 + m * 16, fq);
#pragma unroll
        for (int ai = 0; ai < 2; ++ai)
#pragma unroll
            for (int m = 0; m < 4; ++m) {
                const int row = row0 + ai * 128 + m * 16;
                const float rs = rsv[ai][m];
#pragma unroll
                for (int n = 0; n < 2; ++n) {
                    const pg8::f32x4 g = acc[ai][0][m][n] * rs, up = acc[ai][1][m][n] * rs;
                    float o[4];
#pragma unroll
                    for (int i = 0; i < 4; ++i) o[i] = g[i] * __builtin_amdgcn_rcpf(1.f + __expf(-g[i])) * up[i];
                    u32x2 w; w.x = pk2(o[0], o[1]); w.y = pk2(o[2], o[3]);
                    *(u32x2*)(U + (size_t)row * 4096 + f0 + 16 * n) = w;
                }
                asm volatile("" ::: "memory");
            }
    }
};

struct EpiRes {
    static constexpr bool PERM = false, AFTER_DRAIN = false;
    const float* base_p; const float* base_s; float* out; bf16_t* xb; float* ssn; float scale;
    __device__ __forceinline__ void operator()(const pg8::f32x4 (&acc)[2][2][4][2], const pg8::Unit& u, int wr, int wc, int fr, int fq) const {
        const float* base = (u.pm < 128) ? base_p : base_s;
        const int row0 = u.pm * 256 + wr * 64 + fr;
        const int col0 = u.pn * 256 + wc * 64 + 4 * fq;
#pragma unroll
        for (int ai = 0; ai < 2; ++ai)
#pragma unroll
            for (int m = 0; m < 4; ++m) {
                const int row = row0 + ai * 128 + m * 16;
                float sq = 0.f;
#pragma unroll
                for (int bj = 0; bj < 2; ++bj)
#pragma unroll
                    for (int n = 0; n < 2; ++n) {
                        const size_t off = (size_t)row * 1024 + col0 + 32 * bj + 16 * n;
                        const pg8::f32x4 bv = *(const pg8::f32x4*)(base + off);
                        const pg8::f32x4 v = bv + acc[ai][bj][m][n] * scale;
                        *(pg8::f32x4*)(out + off) = v;
                        sq += (v[0] * v[0] + v[1] * v[1]) + (v[2] * v[2] + v[3] * v[3]);
                        u32x2 w; w.x = pk2(v[0], v[1]); w.y = pk2(v[2], v[3]);
                        *(u32x2*)(xb + off) = w;
                    }
                sq += __shfl_xor(sq, 16); sq += __shfl_xor(sq, 32);
                if (fq == 0) ssn[(size_t)row * 16 + u.pn * 4 + wc] = sq;
                if (m == 3) asm volatile("" ::: "memory");
            }
    }
};

struct ColDesc {
    const float* gain;
    int sig;
    bf16_t* db; int ldb, cb;
    float* df_p; float* df_s; int ldf, cf, mode;
};

template <class DescFn> struct EpiGen {
    static constexpr bool PERM = false, AFTER_DRAIN = false;
    const float* ss; DescFn fn;
    __device__ __forceinline__ void operator()(const pg8::f32x4 (&acc)[2][2][4][2], const pg8::Unit& u, int wr, int wc, int fr, int fq) const {
        const ColDesc d = fn(u.pn);
        const int row0 = u.pm * 256 + wr * 64 + fr;
        const int lc0 = wc * 64 + 4 * fq;
        pg8::f32x4 gn[2][2];
        if (d.gain) {
#pragma unroll
            for (int bj = 0; bj < 2; ++bj)
#pragma unroll
                for (int n = 0; n < 2; ++n) gn[bj][n] = *(const pg8::f32x4*)(d.gain + 4 * fq + 32 * bj + 16 * n);
        }
        const bool samp = (u.pm >= 128);
        float rsv[2][4];
#pragma unroll
        for (int ai = 0; ai < 2; ++ai)
#pragma unroll
            for (int m = 0; m < 4; ++m) rsv[ai][m] = row_rstd_q(ss, row0 + ai * 128 + m * 16, fq);
#pragma unroll
        for (int ai = 0; ai < 2; ++ai)
#pragma unroll
            for (int m = 0; m < 4; ++m) {
                const int row = row0 + ai * 128 + m * 16;
                const float rs = rsv[ai][m];
                pg8::f32x4 v[2][2];
                float sq = 0.f;
#pragma unroll
                for (int bj = 0; bj < 2; ++bj)
#pragma unroll
                    for (int n = 0; n < 2; ++n) { v[bj][n] = acc[ai][bj][m][n] * rs; const pg8::f32x4 t = v[bj][n]; sq += (t[0] * t[0] + t[1] * t[1]) + (t[2] * t[2] + t[3] * t[3]); }
                if (d.gain) {
                    sq += __shfl_xor(sq, 16); sq += __shfl_xor(sq, 32);
                    const float hn = rsqrtf(sq * (1.f / 64.f) + EPS_);
#pragma unroll
                    for (int bj = 0; bj < 2; ++bj)
#pragma unroll
                        for (int n = 0; n < 2; ++n) v[bj][n] = v[bj][n] * hn * gn[bj][n];
                }
                if (d.sig) {
#pragma unroll
                    for (int bj = 0; bj < 2; ++bj)
#pragma unroll
                        for (int n = 0; n < 2; ++n)
#pragma unroll
                            for (int i = 0; i < 4; ++i) v[bj][n][i] = __builtin_amdgcn_rcpf(1.f + __expf(-v[bj][n][i]));
                }
                {
                    bf16_t* p = d.db + (size_t)row * d.ldb + d.cb + lc0;
#pragma unroll
                    for (int bj = 0; bj < 2; ++bj)
#pragma unroll
                        for (int n = 0; n < 2; ++n) { u32x2 w; w.x = pk2(v[bj][n][0], v[bj][n][1]); w.y = pk2(v[bj][n][2], v[bj][n][3]); *(u32x2*)(p + 32 * bj + 16 * n) = w; }
                }
                if (d.df_p) {
                    float* p = nullptr;
                    if (!samp) {
                        if (d.mode == 0) p = d.df_p + (size_t)row * d.ldf;
                        else { const int s = row & (S_ - 1), b = row >> 13; if (s >= S_ - 512) p = d.df_p + (size_t)(b * 512 + s - (S_ - 512)) * d.ldf; }
                    } else {
                        const int r2 = row - T_;
                        if (d.mode == 0) p = d.df_s + (size_t)r2 * d.ldf;
                        else p = d.df_s + (size_t)((r2 >> 5) * 512 + 480 + (r2 & 31)) * d.ldf;
                    }
                    if (p) {
                        p += d.cf + lc0;
#pragma unroll
                        for (int bj = 0; bj < 2; ++bj)
#pragma unroll
                            for (int n = 0; n < 2; ++n) *(pg8::f32x4*)(p + 32 * bj + 16 * n) = v[bj][n];
                    }
                }
                asm volatile("" ::: "memory");
            }
    }
};

struct EpiMerge {
    static constexpr bool PERM = false, AFTER_DRAIN = false;
    const bf16_t* gate; bf16_t* merged; int first;
    __device__ __forceinline__ void operator()(const pg8::f32x4 (&acc)[2][2][4][2], const pg8::Unit& u, int wr, int wc, int fr, int fq) const {
        const int row0 = u.pm * 256 + wr * 64 + fr;
        const int col0 = u.pn * 256 + wc * 64 + 4 * fq;
#pragma unroll
        for (int ai = 0; ai < 2; ++ai) {
            u32x2 gt[4][2][2], mo[4][2][2];
#pragma unroll
            for (int m = 0; m < 4; ++m)
#pragma unroll
                for (int bj = 0; bj < 2; ++bj)
#pragma unroll
                    for (int n = 0; n < 2; ++n) {
                        const size_t off = (size_t)(row0 + ai * 128 + m * 16) * 1024 + col0 + 32 * bj + 16 * n;
                        gt[m][bj][n] = *(const u32x2*)(gate + off);
                        if (!first) mo[m][bj][n] = *(const u32x2*)(merged + off);
                    }
#pragma unroll
            for (int m = 0; m < 4; ++m)
#pragma unroll
                for (int bj = 0; bj < 2; ++bj)
#pragma unroll
                    for (int n = 0; n < 2; ++n) {
                        const size_t off = (size_t)(row0 + ai * 128 + m * 16) * 1024 + col0 + 32 * bj + 16 * n;
                        const u32x2 g = gt[m][bj][n];
                        float o0 = bf2f(g.x & 0xffffu) * acc[ai][bj][m][n][0], o1 = bf2f(g.x >> 16) * acc[ai][bj][m][n][1];
                        float o2 = bf2f(g.y & 0xffffu) * acc[ai][bj][m][n][2], o3 = bf2f(g.y >> 16) * acc[ai][bj][m][n][3];
                        if (!first) { const u32x2 q = mo[m][bj][n]; o0 += bf2f(q.x & 0xffffu); o1 += bf2f(q.x >> 16); o2 += bf2f(q.y & 0xffffu); o3 += bf2f(q.y >> 16); }
                        u32x2 w; w.x = pk2(o0, o1); w.y = pk2(o2, o3);
                        *(u32x2*)(merged + off) = w;
                    }
            asm volatile("" ::: "memory");
        }
    }
};

__device__ __forceinline__ void p0_transpose_item(const float* W, int ldw, int srccol, const float* gain, bf16_t* dst, int prow, int K, int k0, LAS float* scr, int lane) {
    const int rsub = lane >> 4, c4 = lane & 15;
    const float* src = W + (size_t)(k0 + rsub) * ldw + srccol + 4 * c4;
    f32x4 v[8];
#pragma unroll
    for (int i = 0; i < 8; ++i) v[i] = __builtin_nontemporal_load((const f32x4*)(src + (size_t)(4 * i) * ldw));
    if (gain) {
#pragma unroll
        for (int i = 0; i < 8; ++i) v[i] = v[i] * gain[k0 + 4 * i + rsub];
    }
#pragma unroll
    for (int i = 0; i < 8; ++i) *(LAS f32x4*)(scr + (4 * i + rsub) * 68 + 4 * c4) = v[i];
    asm volatile("s_waitcnt lgkmcnt(0)" ::: "memory");
    bf16_t* drow = dst + (size_t)prow * K + k0;
#pragma unroll
    for (int c = 0; c < 4; ++c) {
        const LAS float* s = scr + (8 * c) * 68 + lane;
        u32x4 o; o.x = pk2(s[0 * 68], s[1 * 68]); o.y = pk2(s[2 * 68], s[3 * 68]); o.z = pk2(s[4 * 68], s[5 * 68]); o.w = pk2(s[6 * 68], s[7 * 68]);
        *(u32x4*)(drow + 8 * c) = o;
    }
    asm volatile("s_waitcnt lgkmcnt(0)" ::: "memory");
}
__device__ __forceinline__ void row_to_bf16(const float* xrow, bf16_t* orow, float* ssp, int lane) {
    const f32x4* xr = (const f32x4*)xrow + lane;
    f32x4 v[4]; float s = 0.f;
#pragma unroll
    for (int j = 0; j < 4; ++j) { v[j] = xr[64 * j]; s += (v[j].x * v[j].x + v[j].y * v[j].y) + (v[j].z * v[j].z + v[j].w * v[j].w); }
    s = wave_sum(s);
    u32x2* o = (u32x2*)orow + lane;
#pragma unroll
    for (int j = 0; j < 4; ++j) { u32x2 w; w.x = pk2(v[j].x, v[j].y); w.y = pk2(v[j].z, v[j].w); o[64 * j] = w; }
    if (lane < 16) ssp[lane] = (lane == 0) ? s : 0.f;
}

constexpr int AT_KT = 0, AT_VT = 17408, AT_BUF = 17408 + 18432  , AT_QW = 2 * AT_BUF, AT_TAB = AT_QW + 8 * 32 * 144, AT_FLAG = AT_TAB + 1600, AT_END = AT_FLAG + 64;
static_assert(4 * 4 * 16 * 64 * 4 <= AT_TAB, "differential exchange area below the bias table");
static_assert(AT_END <= 131072, "attention LDS map");
constexpr int AT_ACCO = 0, AT_ACCL = 32768, AT_STAB = 34816, AT_SV = 36864;

struct NoPrep { __device__ __forceinline__ void operator()(int) const {} };
template <int NMAP, int VD, class KL, class QL, class VL, class BF, class PREP = NoPrep>
__device__ __forceinline__ void tile_softmax(f32x16 (&O)[NMAP][VD / 32], float (&l)[NMAP], const KL& kl, const QL& ql, const VL& vl, const BF& bf, const PREP& prep = PREP()) {
    static_assert(NMAP == 1, "one map per wave");
    constexpr float C1 = 0.125f * LOG2E;
    f32x16 S[2];
#pragma unroll
    for (int kb = 0; kb < 2; ++kb) {
#pragma unroll
        for (int i = 0; i < 16; ++i) S[kb][i] = 0.f;
#pragma unroll
        for (int s = 0; s < 4; ++s) S[kb] = __builtin_amdgcn_mfma_f32_32x32x16_bf16(kl(kb, 0, s), ql(0, s), S[kb], 0, 0, 0);
    }
#pragma unroll
    for (int kb = 0; kb < 2; ++kb) {
        float ls = 0.f; unsigned pw[8];
#pragma unroll
        for (int r2 = 0; r2 < 16; r2 += 2) {
            const float p0 = __builtin_amdgcn_exp2f(S[kb][r2] * C1 + bf(kb, r2)), p1 = __builtin_amdgcn_exp2f(S[kb][r2 + 1] * C1 + bf(kb, r2 + 1));
            ls += p0 + p1; pw[r2 >> 1] = pk2(p0, p1);
        }
        l[0] += ls;
        u32x4 t0 = {pw[0], pw[1], pw[2], pw[3]}, t1 = {pw[4], pw[5], pw[6], pw[7]};
        const bf16x8 pf0 = __builtin_bit_cast(bf16x8, t0), pf1 = __builtin_bit_cast(bf16x8, t1);
        prep(kb);
#pragma unroll
        for (int db = 0; db < VD / 32; ++db) {
            O[0][db] = __builtin_amdgcn_mfma_f32_32x32x16_bf16(vl(db, kb, 0), pf0, O[0][db], 0, 0, 0);
            O[0][db] = __builtin_amdgcn_mfma_f32_32x32x16_bf16(vl(db, kb, 1), pf1, O[0][db], 0, 0, 0);
        }
    }
}

template <class KL, class QL, class VL, class MK>
__device__ __forceinline__ void tile_stick(f32x16 (&O)[2], float& R, int hh, const KL& kl, const QL& ql, const VL& vl, const MK& valid) {
#pragma unroll
    for (int kb = 1; kb >= 0; --kb) {
        f32x16 S;
#pragma unroll
        for (int i = 0; i < 16; ++i) S[i] = 0.f;
#pragma unroll
        for (int s = 0; s < 4; ++s) S = __builtin_amdgcn_mfma_f32_32x32x16_bf16(kl(kb, 0, s), ql(0, s), S, 0, 0, 0);
        float sg[16], f[16];
#pragma unroll
        for (int i = 0; i < 16; ++i) {
            float z = S[i] * 0.125f; z = fminf(fmaxf(z, -60.f), 60.f);
            const float e = __builtin_amdgcn_exp2f(-z * LOG2E);
            float s_ = __builtin_amdgcn_rcpf(1.f + e), ff = e * s_;
            if (!valid(kb, i)) { s_ = 0.f; ff = 1.f; }
            sg[i] = s_; f[i] = ff;
        }
        float F[4], Fp[4], Tg[4];
#pragma unroll
        for (int g = 0; g < 4; ++g) { F[g] = (f[4 * g] * f[4 * g + 1]) * (f[4 * g + 2] * f[4 * g + 3]); Fp[g] = __shfl_xor(F[g], 32); Tg[g] = F[g] * Fp[g]; }
        float E[4]; E[3] = 1.f; E[2] = Tg[3]; E[1] = Tg[3] * Tg[2]; E[0] = E[1] * Tg[1];
        unsigned pw[8];
#pragma unroll
        for (int g = 0; g < 4; ++g) {
            float t = R * E[g] * (hh == 0 ? Fp[g] : 1.f);
            const float w3 = sg[4 * g + 3] * t; t *= f[4 * g + 3];
            const float w2 = sg[4 * g + 2] * t; t *= f[4 * g + 2];
            const float w1 = sg[4 * g + 1] * t; t *= f[4 * g + 1];
            const float w0 = sg[4 * g] * t;
            pw[2 * g] = pk2(w0, w1); pw[2 * g + 1] = pk2(w2, w3);
        }
        R *= E[0] * Tg[0];
        u32x4 t0 = {pw[0], pw[1], pw[2], pw[3]}, t1 = {pw[4], pw[5], pw[6], pw[7]};
        const bf16x8 pf0 = __builtin_bit_cast(bf16x8, t0), pf1 = __builtin_bit_cast(bf16x8, t1);
#pragma unroll
        for (int db = 0; db < 2; ++db) {
            O[db] = __builtin_amdgcn_mfma_f32_32x32x16_bf16(vl(db, kb, 0), pf0, O[db], 0, 0, 0);
            O[db] = __builtin_amdgcn_mfma_f32_32x32x16_bf16(vl(db, kb, 1), pf1, O[db], 0, 0, 0);
        }
    }
}

template <int MODE, int NMAP, int VD>
__device__ __forceinline__ void finish_store(f32x16 (&O)[NMAP][VD / 32], float (&l)[NMAP], bf16_t* orowp, int hh, float lam, const float* subln, float oscale) {
    float inv[NMAP];
    if (MODE != 3) {
#pragma unroll
        for (int mp = 0; mp < NMAP; ++mp) { l[mp] += __shfl_xor(l[mp], 32); inv[mp] = 1.f / l[mp]; }
    }
    if constexpr (MODE == 0) {
        float sq = 0.f;
#pragma unroll
        for (int db = 0; db < 4; ++db)
#pragma unroll
            for (int i = 0; i < 16; ++i) { const float o = O[0][db][i] * inv[0] - lam * (O[1][db][i] * inv[1]); O[0][db][i] = o; sq += o * o; }
        sq += __shfl_xor(sq, 32);
        const float rsn = rsqrtf(sq * (1.f / 128.f) + EPS_) * oscale;
#pragma unroll
        for (int db = 0; db < 4; ++db)
#pragma unroll
            for (int g = 0; g < 4; ++g) {
                const int d0 = 32 * db + 8 * g + 4 * hh;
                const f32x4 gn = *(const f32x4*)(subln + d0);
                u32x2 wv; wv.x = pk2(O[0][db][4 * g] * rsn * gn[0], O[0][db][4 * g + 1] * rsn * gn[1]); wv.y = pk2(O[0][db][4 * g + 2] * rsn * gn[2], O[0][db][4 * g + 3] * rsn * gn[3]);
                *(u32x2*)(orowp + d0) = wv;
            }
    } else {
        const float sc = (MODE == 3) ? 1.f : inv[0];
#pragma unroll
        for (int db = 0; db < VD / 32; ++db)
#pragma unroll
            for (int g = 0; g < 4; ++g) {
                const int d0 = 32 * db + 8 * g + 4 * hh;
                u32x2 wv; wv.x = pk2(O[0][db][4 * g] * sc, O[0][db][4 * g + 1] * sc); wv.y = pk2(O[0][db][4 * g + 2] * sc, O[0][db][4 * g + 3] * sc);
                *(u32x2*)(orowp + d0) = wv;
            }
    }
}

__device__ __forceinline__ int t5_bucket_dev(int rel) {
    const int n = rel < 0 ? -rel : rel;
    int v;
    if (n < 8) v = n; else { const int k = 31 - __clz(n * n) - 6; v = 8 + k; if (v > 15) v = 15; }
    return (rel > 0 ? 16 : 0) + v;
}
__device__ __forceinline__ float lambda_init_dev(int layer) { return 0.8f - 0.6f * expf(-0.3f * (float)layer); }

template <int MODE>
__device__ __forceinline__ float attn_setup_bias(const Args& a, int layer, int h, LAS float* tab, int tid, int lane) {
    const float* gq = MODE == 0 ? a.in[18] : (MODE == 1 ? a.in[25] : a.in[36]);
    const float* gk = MODE == 0 ? a.in[19] : (MODE == 1 ? a.in[26] : a.in[37]);
    const float mq = wave_max(fabsf(gq[layer * 64 + lane])), mk = wave_max(fabsf(gk[layer * 64 + lane]));
    float mb = 0.f;
    const float* t5 = a.in[11];
    const float* relb = a.in[27] + (size_t)(layer * 4 + h) * 257;
    if (MODE == 0) mb = wave_max(lane < 32 ? fabsf(t5[lane * 4 + h]) : 0.f);
    if (MODE == 1) { float m = 0.f; for (int i = lane; i < 257; i += 64) m = fmaxf(m, fabsf(relb[i])); mb = wave_max(m); }
    const float shift = 8.f * mq * mk + mb;
    if (MODE == 0 || MODE == 1) {
        for (int t = tid; t < 384; t += 512) {
            int rel = t - 64 - 255; if (t < 64) rel = -255; float v;
            if (MODE == 0) v = t5[t5_bucket_dev(rel) * 4 + h];
            else { int c = rel < -128 ? -128 : (rel > 128 ? 128 : rel); v = relb[c + 128]; }
            tab[t] = (v - shift) * LOG2E;
        }
    }
    if (MODE == 0) return (t5[15 * 4 + h] - shift) * LOG2E;
    if (MODE == 1) return (relb[0] - shift) * LOG2E;
    return -shift * LOG2E;
}

template <int MODE>
__device__ __forceinline__ void attn_prompt_unit(LAS unsigned char* lds, const Args& a, int layer, int bh, int qb) {
    constexpr int KD = MODE == 0 ? 128 : 64, VD = MODE == 0 ? 128 : 64, KP = KD * 2 + 16, VP2 = VD * 2 + 16, QP = 144, NKC = KD / 64, NVC = VD / 64, UROWS = MODE == 0 ? 128 : 256;
    int tid_l = threadIdx.x; asm volatile("" : "+v"(tid_l));
    const int tid = tid_l, lane = tid & 63, w = __builtin_amdgcn_readfirstlane(tid >> 6), r = lane & 31, hh = lane >> 5;
    const int qg = MODE == 0 ? (w >> 1) : w, mpw = MODE == 0 ? (w & 1) : 0;
    const int b = bh >> 2, h = bh & 3;
    unsigned char* Rg = a.ws + WS_R;
    bf16_t* Q; const bf16_t* K; const bf16_t* V; int ld; int hoff; size_t keyrow0;
    if (MODE == 0) { Q = (bf16_t*)(Rg + R_QA); K = (const bf16_t*)(Rg + R_KA); V = (const bf16_t*)(Rg + R_VA); ld = 512; hoff = h * 128; keyrow0 = (size_t)b * S_; }
    else if (MODE == 1) { Q = (bf16_t*)(Rg + R_QC); K = (const bf16_t*)(Rg + R_KC); V = (const bf16_t*)(Rg + R_VC); ld = 256; hoff = h * 64; keyrow0 = (size_t)b * S_; }
    else if (MODE == 3) { Q = (bf16_t*)(Rg + R_QB); K = (const bf16_t*)(Rg + R_KB); V = (const bf16_t*)(Rg + R_VB); ld = 256; hoff = h * 64; keyrow0 = (size_t)b * S_; }
    else { Q = (bf16_t*)(Rg + R_QX); K = (const bf16_t*)(a.ws + WS_MKB) + (size_t)layer * 262144; V = (const bf16_t*)(a.ws + WS_MVB) + (size_t)layer * 262144; ld = 256; hoff = h * 64; keyrow0 = (size_t)b * 256; }
    const int q0 = UROWS * qb + 32 * qg;
    const size_t qrow0 = (size_t)b * S_ + q0;
    const int cw = q0 >> 6;
    int jlo, jhi, wlo, whi;
    if (MODE == 0 || MODE == 3) { jlo = 0; jhi = ((UROWS * qb + UROWS - 1) >> 6); wlo = 0; whi = cw; }
    else if (MODE == 1) { const int c0 = (UROWS * qb) >> 6; wlo = cw - 8 < 0 ? 0 : cw - 8; whi = cw; jlo = c0 - 8 < 0 ? 0 : c0 - 8; jhi = c0 + 3; }
    else { jlo = 0; jhi = 3; wlo = 0; whi = 3; }

    LAS float* tab = (LAS float*)(lds + AT_TAB); volatile LAS int* flags = (volatile LAS int*)(lds + AT_FLAG);

    __syncthreads();
    float farc = 0.f;
    if (MODE != 3) farc = attn_setup_bias<MODE>(a, layer, h, tab, tid, lane);
    bf16x8 qf[4];
#pragma unroll
    for (int s = 0; s < 4; ++s) qf[s] = *(const bf16x8*)(Q + (qrow0 + r) * ld + hoff + mpw * 64 + 16 * s + 8 * hh);
    float lam = 0.f;
    if (MODE == 0) {
        const float s1 = wave_sum(a.in[20][layer * 64 + lane] * a.in[21][layer * 64 + lane]);
        const float s2 = wave_sum(a.in[22][layer * 64 + lane] * a.in[23][layer * 64 + lane]);
        lam = expf(s1) - expf(s2) + lambda_init_dev(layer);
    }

    f32x16 O[1][VD / 32]; float l[1] = {0.f};
#pragma unroll
    for (int db = 0; db < VD / 32; ++db)
#pragma unroll
        for (int i = 0; i < 16; ++i) O[0][db][i] = 0.f;
    float Rp = 1.f; bool done = false;

    u32x4 kreg[NKC], vreg[NVC];
    auto prefetch = [&](int j) {
#pragma unroll
        for (int i = 0; i < NKC; ++i) { const int c = tid + 512 * i, key = c / (KD / 8), part = c % (KD / 8);
            kreg[i] = *(const u32x4*)(K + (keyrow0 + 64 * j + key) * ld + hoff + part * 8); }
#pragma unroll
        for (int i = 0; i < NVC; ++i) { const int c = tid + 512 * i, key = c / (VD / 8), part = c % (VD / 8);
            vreg[i] = *(const u32x4*)(V + (keyrow0 + 64 * j + key) * ld + hoff + part * 8); }
    };
    auto stage = [&](int buf) {
        LAS unsigned char* KT = lds + AT_KT + buf * AT_BUF; LAS unsigned char* VT = lds + AT_VT + buf * AT_BUF;
#pragma unroll
        for (int i = 0; i < NKC; ++i) { const int c = tid + 512 * i, key = c / (KD / 8), part = c % (KD / 8);
            *(LAS u32x4*)(KT + key * KP + part * 16) = kreg[i]; }
#pragma unroll
        for (int i = 0; i < NVC; ++i) { const int c = tid + 512 * i, key = c / (VD / 8), part = c % (VD / 8);
            *(LAS u32x4*)(VT + key * VP2 + part * 16) = vreg[i]; }
    };
    auto ql = [&](int, int s) -> bf16x8 { return qf[s]; };
    auto step = [&](auto BUFC, int j, bool more) {
        constexpr int BUF = decltype(BUFC)::value;
        const LAS unsigned char* KTb = lds + AT_KT + BUF * AT_BUF; const LAS unsigned char* VTb = lds + AT_VT + BUF * AT_BUF;
        auto kl = [&](int kb, int, int s) -> bf16x8 { return *(const LAS bf16x8*)(KTb + (32 * kb + r) * KP + mpw * 128 + (16 * s + 8 * hh) * 2); };
        auto vl = [&](int db, int kb, int s2) -> bf16x8 {
            const LAS unsigned char* p = VTb + (32 * kb + 16 * s2 + 4 * hh + ((lane & 15) >> 2)) * VP2 + (32 * db + 16 * ((lane >> 4) & 1) + 4 * (lane & 3)) * 2;
            const s16x4 lo = __builtin_amdgcn_ds_read_tr16_b64_v4i16((LAS s16x4*)p), hi = __builtin_amdgcn_ds_read_tr16_b64_v4i16((LAS s16x4*)(p + 8 * VP2));
            bf16x8 t = {lo[0], lo[1], lo[2], lo[3], hi[0], hi[1], hi[2], hi[3]}; return t; };
        if constexpr (MODE != 3) {
            if (more) prefetch(j + 1);
            if (j >= wlo && j <= whi) {
                const int maxrel = 64 * j + 63 - q0;
                float bv[2][16];
                if (MODE == 2 || maxrel <= -128) {
#pragma unroll
                    for (int kb = 0; kb < 2; ++kb)
#pragma unroll
                        for (int i = 0; i < 16; ++i) bv[kb][i] = farc;
                } else {
                    const int bidx = 64 + 64 * j + 4 * hh - q0 - r + 255;
#pragma unroll
                    for (int kb = 0; kb < 2; ++kb)
#pragma unroll
                        for (int i = 0; i < 16; ++i) bv[kb][i] = tab[bidx + 32 * kb + (i & 3) + 8 * (i >> 2)];
                }
                auto bf = [&](int kb, int i) -> float { return bv[kb][i]; };
                tile_softmax<1, VD>(O, l, kl, ql, vl, bf);
            }
        } else {
            if (more) prefetch(j - 1);
            if (j <= whi && !done) {
                const int kbase = 64 * j + 4 * hh, qpos = (j == whi) ? q0 + r : 0x7fffffff;
                auto valid = [&](int kb, int i) -> bool { return (kbase + 32 * kb + (i & 3) + 8 * (i >> 2)) < qpos; };
                tile_stick(O[0], Rp, hh, kl, ql, vl, valid);
                done = (__ballot(Rp != 0.f) == 0ull) || (j == 0);
            }
            if (lane == 0) flags[BUF * 8 + w] = done ? 1 : 0;
        }
        if (more) stage(BUF ^ 1);
        __syncthreads();
    };
    if constexpr (MODE != 3) {
        prefetch(jlo); stage(0); __syncthreads();
        for (int j = jlo; j <= jhi; j += 2) {
            step(std::integral_constant<int, 0>{}, j, j < jhi);
            if (j + 1 <= jhi) step(std::integral_constant<int, 1>{}, j + 1, j + 1 < jhi);
        }
    } else {
        prefetch(jhi); stage(0); __syncthreads();
        for (int j = jhi; j >= 0; j -= 2) {
            step(std::integral_constant<int, 0>{}, j, j > 0);
            { int alld = 1;
#pragma unroll
              for (int i = 0; i < 8; ++i) alld &= flags[i];
              if (alld || j == 0) break; }
            step(std::integral_constant<int, 1>{}, j - 1, j - 1 > 0);
            { int alld = 1;
#pragma unroll
              for (int i = 0; i < 8; ++i) alld &= flags[8 + i];
              if (alld) break; }
        }
    }
    bf16_t* orowp = Q + (qrow0 + r) * ld + hoff;
    if constexpr (MODE == 0) {
        l[0] += __shfl_xor(l[0], 32);
        const float inv = 1.f / l[0];
        LAS float* ex = (LAS float*)lds + qg * (4 * 16 * 64);
        if (mpw == 1) {
            const float sc = inv * lam;
#pragma unroll
            for (int db = 0; db < 4; ++db)
#pragma unroll
                for (int i = 0; i < 16; ++i) ex[(db * 16 + i) * 64 + lane] = O[0][db][i] * sc;
        }
        __syncthreads();
        if (mpw == 0) {
            float sq = 0.f;
#pragma unroll
            for (int db = 0; db < 4; ++db)
#pragma unroll
                for (int i = 0; i < 16; ++i) { const float o = O[0][db][i] * inv - ex[(db * 16 + i) * 64 + lane]; O[0][db][i] = o; sq += o * o; }
            sq += __shfl_xor(sq, 32);
            const float rsn = rsqrtf(sq * (1.f / 128.f) + EPS_) * (1.f - lambda_init_dev(layer));
            const float* subln = a.in[24] + layer * 128;
#pragma unroll
            for (int db = 0; db < 4; ++db)
#pragma unroll
                for (int g = 0; g < 4; ++g) {
                    const int d0 = 32 * db + 8 * g + 4 * hh;
                    const f32x4 gn = *(const f32x4*)(subln + d0);
                    u32x2 wv; wv.x = pk2(O[0][db][4 * g] * rsn * gn[0], O[0][db][4 * g + 1] * rsn * gn[1]); wv.y = pk2(O[0][db][4 * g + 2] * rsn * gn[2], O[0][db][4 * g + 3] * rsn * gn[3]);
                    *(u32x2*)(orowp + d0) = wv;
                }
        }
    } else {
        finish_store<MODE, 1, VD>(O, l, orowp, hh, lam, nullptr, 1.f);
    }
}

template <int MODE>
__device__ __forceinline__ void attn_sample_unit(LAS unsigned char* lds, const Args& a, int layer, int b, int h) {
    constexpr int NMAP = MODE == 0 ? 2 : 1, KD = 64 * NMAP, VD = MODE == 0 ? 128 : 64;
    int tid_l = threadIdx.x; asm volatile("" : "+v"(tid_l));
    const int tid = tid_l, lane = tid & 63, w = __builtin_amdgcn_readfirstlane(tid >> 6), r = lane & 31, hh = lane >> 5;
    const float *kc, *kn, *vc, *vn; int ldk, ncache, nkeys, kpos0; const bf16_t* Q; int ldq;
    const size_t lb = (size_t)(layer * 8 + b);
    if (MODE == 0) { kc = a.in[3] + lb * 1024 * 512 + h * 128; vc = a.in[4] + lb * 1024 * 512 + h * 128; kn = a.out + O_AKS + lb * 32 * 512 + h * 128; vn = a.out + O_AVS + lb * 32 * 512 + h * 128;
        ldk = 512; ncache = 1024; nkeys = 1056; kpos0 = 0; Q = (const bf16_t*)(a.ws + WS_R + R_QA); ldq = 512; }
    else if (MODE == 1) { kc = a.in[7] + lb * 512 * 256 + h * 64; vc = a.in[8] + lb * 512 * 256 + h * 64; kn = a.out + O_CKS + (lb * 512 + 480) * 256 + h * 64; vn = a.out + O_CVS + (lb * 512 + 480) * 256 + h * 64;
        ldk = 256; ncache = 512; nkeys = 544; kpos0 = 512; Q = (const bf16_t*)(a.ws + WS_R + R_QC); ldq = 256; }
    else { kc = a.in[9] + lb * 256 * 256 + h * 64; vc = a.in[10] + lb * 256 * 256 + h * 64; kn = kc; vn = vc; ldk = 256; ncache = 256; nkeys = 256; kpos0 = 0; Q = (const bf16_t*)(a.ws + WS_R + R_QX); ldq = 256; }
    const size_t qrow = (size_t)T_ + b * 32 + r;
    LAS float* accO = (LAS float*)(lds + AT_ACCO); LAS float* accL = (LAS float*)(lds + AT_ACCL); LAS float* tab = (LAS float*)(lds + AT_STAB);
    __syncthreads();
    for (int i = tid; i < NMAP * (VD / 32) * 16 * 64; i += 512) accO[i] = 0.f;
    if (tid < NMAP * 64) accL[tid] = 0.f;
    const float farc = attn_setup_bias<MODE>(a, layer, h, tab, tid, lane);
    float lam = 0.f;
    if (MODE == 0) {
        const float s1 = wave_sum(a.in[20][layer * 64 + lane] * a.in[21][layer * 64 + lane]);
        const float s2 = wave_sum(a.in[22][layer * 64 + lane] * a.in[23][layer * 64 + lane]);
        lam = expf(s1) - expf(s2) + lambda_init_dev(layer);
    }
    const bf16_t* qptr = Q + qrow * ldq + h * KD + 8 * hh;
    __syncthreads();
    f32x16 Ow[1][VD / 32]; float lw[1] = {0.f};
#pragma unroll
    for (int db = 0; db < VD / 32; ++db)
#pragma unroll
        for (int i = 0; i < 16; ++i) Ow[0][db][i] = 0.f;
    const int ntiles = (nkeys + 63) / 64;
    const int mpw = (NMAP == 2) ? (w >> 2) : 0, jstep = (NMAP == 2) ? 4 : 8, jstart = (NMAP == 2) ? (w & 3) : w;
    for (int j = jstart; j < ntiles; j += jstep) {
        asm volatile("" ::: "memory");
        auto krow = [&](int p) -> const float* { p = p < nkeys ? p : nkeys - 1; return p < ncache ? kc + (size_t)p * ldk : kn + (size_t)(p - ncache) * ldk; };
        auto vrow = [&](int p) -> const float* { p = p < nkeys ? p : nkeys - 1; return p < ncache ? vc + (size_t)p * ldk : vn + (size_t)(p - ncache) * ldk; };
        auto kl = [&](int kb, int, int s) -> bf16x8 {
            const float* p = krow(64 * j + 32 * kb + r) + mpw * 64 + 16 * s + 8 * hh;
            const f32x4 x = *(const f32x4*)p, y = *(const f32x4*)(p + 4);
            u32x4 t = {pk2(x[0], x[1]), pk2(x[2], x[3]), pk2(y[0], y[1]), pk2(y[2], y[3])}; return __builtin_bit_cast(bf16x8, t); };
        auto ql = [&](int, int s) -> bf16x8 { return *(const bf16x8*)(qptr + mpw * 64 + 16 * s); };
        constexpr int VP2 = VD * 2 + 16, KPI = 256 / VD;
        LAS unsigned char* VTw = lds + AT_SV + w * (32 * VP2);
        auto vprep = [&](int kb) {
            f32x4 x[32 / KPI];
#pragma unroll
            for (int i = 0; i < 32 / KPI; ++i) x[i] = *(const f32x4*)(vrow(64 * j + 32 * kb + KPI * i + lane / (VD / 4)) + 4 * (lane % (VD / 4)));
#pragma unroll
            for (int i = 0; i < 32 / KPI; ++i) { u32x2 t; t.x = pk2(x[i][0], x[i][1]); t.y = pk2(x[i][2], x[i][3]);
                *(LAS u32x2*)(VTw + (KPI * i + lane / (VD / 4)) * VP2 + 8 * (lane % (VD / 4))) = t; }
        };
        auto vl = [&](int db, int, int s2) -> bf16x8 {
            const LAS unsigned char* p2 = VTw + (16 * s2 + 4 * hh + ((lane & 15) >> 2)) * VP2 + (32 * db + 16 * ((lane >> 4) & 1) + 4 * (lane & 3)) * 2;
            const s16x4 lo = __builtin_amdgcn_ds_read_tr16_b64_v4i16((LAS s16x4*)p2), hi = __builtin_amdgcn_ds_read_tr16_b64_v4i16((LAS s16x4*)(p2 + 8 * VP2));
            bf16x8 t = {lo[0], lo[1], lo[2], lo[3], hi[0], hi[1], hi[2], hi[3]}; return t; };
        const int pbase = 64 * j + 4 * hh;
        const int maxrel = kpos0 + 64 * j + 63 - 1024;
        const int bidx = (maxrel <= -128) ? 0 : 64 + kpos0 + pbase - 1024 - r + 255;
        auto bf = [&](int kb, int i) -> float { const int o = 32 * kb + (i & 3) + 8 * (i >> 2); const float t = (MODE == 2) ? farc : tab[bidx + o]; return (pbase + o) < nkeys ? t : -INFINITY; };
        tile_softmax<1, VD>(Ow, lw, kl, ql, vl, bf, vprep);
    }
#pragma unroll
    for (int db = 0; db < VD / 32; ++db)
#pragma unroll
        for (int i = 0; i < 16; ++i) __builtin_amdgcn_ds_faddf(&accO[((mpw * (VD / 32) + db) * 16 + i) * 64 + lane], Ow[0][db][i], 0, 0, false);
    __builtin_amdgcn_ds_faddf(&accL[mpw * 64 + lane], lw[0], 0, 0, false);
    __syncthreads();
    if (w == 0) {
        f32x16 O[NMAP][VD / 32]; float l[NMAP];
#pragma unroll
        for (int mp = 0; mp < NMAP; ++mp) {
#pragma unroll
            for (int db = 0; db < VD / 32; ++db)
#pragma unroll
                for (int i = 0; i < 16; ++i) O[mp][db][i] = accO[((mp * (VD / 32) + db) * 16 + i) * 64 + lane];
            l[mp] = accL[mp * 64 + lane];
        }
        bf16_t* orowp = (bf16_t*)Q + qrow * ldq + h * (MODE == 0 ? 128 : 64);
        finish_store<MODE, NMAP, VD>(O, l, orowp, hh, lam, a.in[24] + layer * 128, 1.f - lambda_init_dev(layer));
    }
}

__device__ __forceinline__ void attn_stick_sample(const Args& a, int layer, int unit) {
    int tid_l = threadIdx.x; asm volatile("" : "+v"(tid_l));
    const int lane = tid_l & 63, r = lane & 31, hh = lane >> 5;
    const int b = unit >> 2, h = unit & 3;
    const size_t lb = (size_t)(layer * 8 + b);
    const float* kc = a.in[5] + lb * 1024 * 256 + h * 64; const float* vc = a.in[6] + lb * 1024 * 256 + h * 64;
    const float* kn = a.out + O_BKS + lb * 32 * 256 + h * 64; const float* vn = a.out + O_BVS + lb * 32 * 256 + h * 64;
    constexpr int ldk = 256, ncache = 1024, nkeys = 1056;
    bf16_t* Q = (bf16_t*)(a.ws + WS_R + R_QB);
    const size_t qrow = (size_t)T_ + b * 32 + r;
    bf16x8 qf[4];
#pragma unroll
    for (int s = 0; s < 4; ++s) qf[s] = *(const bf16x8*)(Q + qrow * 256 + h * 64 + 16 * s + 8 * hh);
    f32x16 O[1][2];
#pragma unroll
    for (int db = 0; db < 2; ++db)
#pragma unroll
        for (int i = 0; i < 16; ++i) O[0][db][i] = 0.f;
    float Rp = 1.f;
    for (int j = 16; j >= 0; --j) {
        auto krow = [&](int p) -> const float* { p = p < nkeys ? p : nkeys - 1; return p < ncache ? kc + (size_t)p * ldk : kn + (size_t)(p - ncache) * ldk; };
        auto vrow = [&](int p) -> const float* { p = p < nkeys ? p : nkeys - 1; return p < ncache ? vc + (size_t)p * ldk : vn + (size_t)(p - ncache) * ldk; };
        auto kl = [&](int kb, int, int s) -> bf16x8 {
            const float* p = krow(64 * j + 32 * kb + r) + 16 * s + 8 * hh;
            const f32x4 x = *(const f32x4*)p, y = *(const f32x4*)(p + 4);
            u32x4 t = {pk2(x[0], x[1]), pk2(x[2], x[3]), pk2(y[0], y[1]), pk2(y[2], y[3])}; return __builtin_bit_cast(bf16x8, t); };
        auto ql = [&](int, int s) -> bf16x8 { return qf[s]; };
        auto vl = [&](int db, int kb, int s2) -> bf16x8 {
            float x[8];
#pragma unroll
            for (int jx = 0; jx < 8; ++jx) x[jx] = vrow(64 * j + 32 * kb + 16 * s2 + 8 * (jx >> 2) + 4 * hh + (jx & 3))[32 * db + r];
            u32x4 t = {pk2(x[0], x[1]), pk2(x[2], x[3]), pk2(x[4], x[5]), pk2(x[6], x[7])}; return __builtin_bit_cast(bf16x8, t); };
        const int pbase = 64 * j + 4 * hh, qpos = 1024 + r;
        auto valid = [&](int kb, int i) -> bool { const int p = pbase + 32 * kb + (i & 3) + 8 * (i >> 2); return p < nkeys && p < qpos; };
        tile_stick(O[0], Rp, hh, kl, ql, vl, valid);
        if (__ballot(Rp != 0.f) == 0ull) break;
    }
    float l[1] = {1.f};
    finish_store<3, 1, 64>(O, l, Q + qrow * 256 + h * 64, hh, 0.f, nullptr, 1.f);
}

#ifndef PROBE_K
#define PROBE_K -1
#endif
#ifndef SKIP_ATTN
#define SKIP_ATTN 0
#endif
#ifndef SKIP_MERGE
#define SKIP_MERGE 0
#endif
#ifndef SKIP_GATE
#define SKIP_GATE 0
#endif
#ifndef P7_PLANE
#define P7_PLANE 0
#endif
#ifndef GATE_SIG
#define GATE_SIG 1
#endif
#ifndef STOP_AFTER
#define STOP_AFTER 99
#endif

struct DescQKV {
    unsigned char* R; float* out; const float* aqn; const float* akn; const float* cqn; const float* ckn; int layer;
    __device__ __forceinline__ ColDesc operator()(int pn) const {
        ColDesc d; d.gain = nullptr; d.sig = 0; d.db = nullptr; d.ldb = 256; d.cb = 0; d.df_p = nullptr; d.df_s = nullptr; d.ldf = 256; d.cf = 0; d.mode = 0;
        const size_t L = (size_t)layer;
        if (pn < 2) { d.gain = aqn; d.db = (bf16_t*)(R + R_QA); d.ldb = 512; d.cb = pn * 256; }
        else if (pn < 4) { d.gain = akn; d.db = (bf16_t*)(R + R_KA); d.ldb = 512; d.cb = (pn - 2) * 256; d.df_p = out + O_AKP + L * T_ * 512; d.df_s = out + O_AKS + L * MS_ * 512; d.ldf = 512; d.cf = (pn - 2) * 256; }
        else if (pn < 6) { d.db = (bf16_t*)(R + R_VA); d.ldb = 512; d.cb = (pn - 4) * 256; d.df_p = out + O_AVP + L * T_ * 512; d.df_s = out + O_AVS + L * MS_ * 512; d.ldf = 512; d.cf = (pn - 4) * 256; }
        else if (pn == 6) { d.db = (bf16_t*)(R + R_QB); }
        else if (pn == 7) { d.db = (bf16_t*)(R + R_KB); d.df_p = out + O_BKP + L * T_ * 256; d.df_s = out + O_BKS + L * MS_ * 256; }
        else if (pn == 8) { d.db = (bf16_t*)(R + R_VB); d.df_p = out + O_BVP + L * T_ * 256; d.df_s = out + O_BVS + L * MS_ * 256; }
        else if (pn == 9) { d.gain = cqn; d.db = (bf16_t*)(R + R_QC); }
        else if (pn == 10) { d.gain = ckn; d.db = (bf16_t*)(R + R_KC); d.df_p = out + O_CKP + L * 4 * 512 * 256; d.df_s = out + O_CKS + L * 8 * 512 * 256; d.mode = 1; }
        else { d.db = (bf16_t*)(R + R_VC); d.df_p = out + O_CVP + L * 4 * 512 * 256; d.df_s = out + O_CVS + L * 8 * 512 * 256; d.mode = 1; }
        return d;
    }
};
struct DescGate {
    unsigned char* R;
    __device__ __forceinline__ ColDesc operator()(int pn) const {
        ColDesc d; d.gain = nullptr; d.sig = GATE_SIG; d.db = (bf16_t*)(R + R_G + (size_t)(pn >> 2) * R_GPLANE); d.ldb = 1024; d.cb = (pn & 3) * 256; d.df_p = nullptr; d.df_s = nullptr; d.ldf = 0; d.cf = 0; d.mode = 0;
        return d;
    }
};
struct DescWq {
    unsigned char* R; const float* qn;
    __device__ __forceinline__ ColDesc operator()(int) const {
        ColDesc d; d.gain = qn; d.sig = 0; d.db = (bf16_t*)(R + R_QX); d.ldb = 256; d.cb = 0; d.df_p = nullptr; d.df_s = nullptr; d.ldf = 0; d.cf = 0; d.mode = 0;
        return d;
    }
};
struct DescMemKV {
    unsigned char* ws; float* out; const float* kn; int layer;
    __device__ __forceinline__ ColDesc operator()(int pn) const {
        ColDesc d; d.sig = 0; d.ldb = 256; d.cb = 0; d.ldf = 256; d.cf = 0; d.mode = 0; d.df_s = nullptr;
        if (pn == 0) { d.gain = kn; d.db = (bf16_t*)(ws + WS_MKB) + (size_t)layer * 262144; d.df_p = out + O_MKP + (size_t)layer * 262144; }
        else { d.gain = nullptr; d.db = (bf16_t*)(ws + WS_MVB) + (size_t)layer * 262144; d.df_p = out + O_MVP + (size_t)layer * 262144; }
        return d;
    }
};


__device__ __forceinline__ void sample_res_gemm(LAS unsigned char* lds, const bf16_t* A, const bf16_t* Bt, int K, float scale, const float* base, float* out, bf16_t* xb, float* ssn, int bx) {
    if (bx >= 128) return;
    int tid_l = threadIdx.x; asm volatile("" : "+v"(tid_l));
    const int tid = tid_l, lane = tid & 63, w = __builtin_amdgcn_readfirstlane(tid >> 6), r = lane & 31, hh = lane >> 5;
    const int rm = bx >> 4, cn = bx & 15, row0 = T_ + 32 * rm;
    const bf16_t* b0 = Bt + (size_t)(256 * (cn >> 2) + 32 * (cn & 3) + r) * K;
    const bf16_t* b1 = b0 + (size_t)128 * K;
    const bf16_t* ap = A + (size_t)(row0 + r) * K;
    const int kw = K >> 3, k0 = w * kw + 8 * hh;
    f32x16 c0, c1;
#pragma unroll
    for (int i = 0; i < 16; ++i) { c0[i] = 0.f; c1[i] = 0.f; }
#pragma unroll 4
    for (int s = 0; s < kw; s += 16) {
        const bf16x8 af = *(const bf16x8*)(ap + k0 + s), f0 = *(const bf16x8*)(b0 + k0 + s), f1 = *(const bf16x8*)(b1 + k0 + s);
        c0 = __builtin_amdgcn_mfma_f32_32x32x16_bf16(af, f0, c0, 0, 0, 0);
        c1 = __builtin_amdgcn_mfma_f32_32x32x16_bf16(af, f1, c1, 0, 0, 0);
    }
    LAS float* P = (LAS float*)lds;
#pragma unroll
    for (int i = 0; i < 16; ++i) { P[((w * 2 + 0) * 16 + i) * 64 + lane] = c0[i]; P[((w * 2 + 1) * 16 + i) * 64 + lane] = c1[i]; }
    __syncthreads();
    {
        const int i = tid >> 4, cp = tid & 15, n0 = 4 * cp, t = n0 >> 5, nl = n0 & 31;
        const int reg = (i & 3) + 4 * (i >> 3), h2 = (i >> 2) & 1;
        float v[4] = {0.f, 0.f, 0.f, 0.f};
#pragma unroll
        for (int ww = 0; ww < 8; ++ww)
#pragma unroll
            for (int e = 0; e < 4; ++e) v[e] += P[((ww * 2 + t) * 16 + reg) * 64 + nl + e + 32 * h2];
        const size_t off = (size_t)(row0 + i) * 1024 + 64 * cn + n0;
        const f32x4 bv = *(const f32x4*)(base + off);
        f32x4 o; o[0] = bv[0] + scale * v[0]; o[1] = bv[1] + scale * v[1]; o[2] = bv[2] + scale * v[2]; o[3] = bv[3] + scale * v[3];
        *(f32x4*)(out + off) = o;
        u32x2 wv; wv.x = pk2(o[0], o[1]); wv.y = pk2(o[2], o[3]); *(u32x2*)(xb + off) = wv;
        float sq = (o[0] * o[0] + o[1] * o[1]) + (o[2] * o[2] + o[3] * o[3]);
        sq += __shfl_xor(sq, 1); sq += __shfl_xor(sq, 2); sq += __shfl_xor(sq, 4); sq += __shfl_xor(sq, 8);
        if (cp == 0) ssn[(size_t)(row0 + i) * 16 + cn] = sq;
    }
    __syncthreads();
}

template <class DescFn>
__device__ __forceinline__ void sample_gen_gemm(LAS unsigned char* lds, const bf16_t* A, const bf16_t* Bt, int N, const float* ss, const DescFn& fn, int bx, int G) {
    int tid_l = threadIdx.x; asm volatile("" : "+v"(tid_l));
    const int tid = tid_l, lane = tid & 63, w = __builtin_amdgcn_readfirstlane(tid >> 6), r = lane & 31, hh = lane >> 5;
    constexpr int K = 1024, kw = K / 8;
    const int nct = N / 64, nitems = 8 * nct;
    LAS float* P = (LAS float*)lds;
    for (int it = bx; it < nitems; it += G) {
        const int rm = it / nct, cn = it % nct, row0 = T_ + 32 * rm;
        const bf16_t* b0 = Bt + (size_t)(256 * (cn >> 2) + 32 * (cn & 3) + r) * K;
        const bf16_t* b1 = b0 + (size_t)128 * K;
        const bf16_t* ap = A + (size_t)(row0 + r) * K;
        const int k0 = w * kw + 8 * hh;
        f32x16 c0, c1;
#pragma unroll
        for (int i = 0; i < 16; ++i) { c0[i] = 0.f; c1[i] = 0.f; }
#pragma unroll 4
        for (int s = 0; s < kw; s += 16) {
            const bf16x8 af = *(const bf16x8*)(ap + k0 + s), f0 = *(const bf16x8*)(b0 + k0 + s), f1 = *(const bf16x8*)(b1 + k0 + s);
            c0 = __builtin_amdgcn_mfma_f32_32x32x16_bf16(af, f0, c0, 0, 0, 0);
            c1 = __builtin_amdgcn_mfma_f32_32x32x16_bf16(af, f1, c1, 0, 0, 0);
        }
        __syncthreads();
#pragma unroll
        for (int i = 0; i < 16; ++i) { P[((w * 2 + 0) * 16 + i) * 64 + lane] = c0[i]; P[((w * 2 + 1) * 16 + i) * 64 + lane] = c1[i]; }
        __syncthreads();
        {
            const int i = tid >> 4, cp = tid & 15, n0 = 4 * cp, t = n0 >> 5, nl = n0 & 31;
            const int reg = (i & 3) + 4 * (i >> 3), h2 = (i >> 2) & 1;
            float v[4] = {0.f, 0.f, 0.f, 0.f};
#pragma unroll
            for (int ww = 0; ww < 8; ++ww)
#pragma unroll
                for (int e = 0; e < 4; ++e) v[e] += P[((ww * 2 + t) * 16 + reg) * 64 + nl + e + 32 * h2];
            const int row = row0 + i;
            float s = ss[(size_t)row * 16 + cp];
            s += __shfl_xor(s, 1); s += __shfl_xor(s, 2); s += __shfl_xor(s, 4); s += __shfl_xor(s, 8);
            const float rs = rsqrtf(s * (1.f / 1024.f) + EPS_);
#pragma unroll
            for (int e = 0; e < 4; ++e) v[e] *= rs;
            const int col = 64 * cn + n0;
            const ColDesc d = fn(col >> 8);
            const int lc = col & 255;
            if (d.gain) {
                float sq = (v[0] * v[0] + v[1] * v[1]) + (v[2] * v[2] + v[3] * v[3]);
                sq += __shfl_xor(sq, 1); sq += __shfl_xor(sq, 2); sq += __shfl_xor(sq, 4); sq += __shfl_xor(sq, 8);
                const float hn = rsqrtf(sq * (1.f / 64.f) + EPS_);
                const f32x4 gn = *(const f32x4*)(d.gain + n0);
#pragma unroll
                for (int e = 0; e < 4; ++e) v[e] = v[e] * hn * gn[e];
            }
            if (d.sig) {
#pragma unroll
                for (int e = 0; e < 4; ++e) v[e] = __builtin_amdgcn_rcpf(1.f + __expf(-v[e]));
            }
            u32x2 wv; wv.x = pk2(v[0], v[1]); wv.y = pk2(v[2], v[3]);
            *(u32x2*)(d.db + (size_t)row * d.ldb + d.cb + lc) = wv;
            if (d.df_s) {
                const int r2 = row - T_;
                float* pf = (d.mode == 0) ? d.df_s + (size_t)r2 * d.ldf : d.df_s + (size_t)((r2 >> 5) * 512 + 480 + (r2 & 31)) * d.ldf;
                f32x4 o = {v[0], v[1], v[2], v[3]};
                *(f32x4*)(pf + d.cf + lc) = o;
            }
        }
    }
    __syncthreads();
}

__device__ __forceinline__ void sample_merge_gemm(LAS unsigned char* lds, unsigned char* R, const bf16_t* Wl, int bx) {
    if (bx >= 128) return;
    int tid_l = threadIdx.x; asm volatile("" : "+v"(tid_l));
    const int tid = tid_l, lane = tid & 63, w = __builtin_amdgcn_readfirstlane(tid >> 6), r = lane & 31, hh = lane >> 5;
    const int rm = bx >> 4, cn = bx & 15, row0 = T_ + 32 * rm;
    LAS float* P = (LAS float*)lds;
    const int i = tid >> 4, cp = tid & 15, n0 = 4 * cp, t = n0 >> 5, nl = n0 & 31;
    const int reg = (i & 3) + 4 * (i >> 3), h2 = (i >> 2) & 1;
    const size_t off = (size_t)(row0 + i) * 1024 + 64 * cn + n0;
    float tot[4] = {0.f, 0.f, 0.f, 0.f};
#pragma unroll
    for (int j = 0; j < 3; ++j) {
        const int K = (j == 0) ? 512 : 256, kw = K / 8;
        const bf16_t* A = (const bf16_t*)(R + (j == 0 ? R_QA : (j == 1 ? R_QB : R_QC)));
        const bf16_t* Bt = Wl + (j == 0 ? W_BRA : (j == 1 ? W_BRB : W_BRC));
        const bf16_t* b0 = Bt + (size_t)(256 * (cn >> 2) + 32 * (cn & 3) + r) * K;
        const bf16_t* b1 = b0 + (size_t)128 * K;
        const bf16_t* ap = A + (size_t)(row0 + r) * K;
        const int k0 = w * kw + 8 * hh;
        f32x16 c0, c1;
#pragma unroll
        for (int q = 0; q < 16; ++q) { c0[q] = 0.f; c1[q] = 0.f; }
        for (int s = 0; s < kw; s += 16) {
            const bf16x8 af = *(const bf16x8*)(ap + k0 + s), f0 = *(const bf16x8*)(b0 + k0 + s), f1 = *(const bf16x8*)(b1 + k0 + s);
            c0 = __builtin_amdgcn_mfma_f32_32x32x16_bf16(af, f0, c0, 0, 0, 0);
            c1 = __builtin_amdgcn_mfma_f32_32x32x16_bf16(af, f1, c1, 0, 0, 0);
        }
        __syncthreads();
#pragma unroll
        for (int q = 0; q < 16; ++q) { P[((w * 2 + 0) * 16 + q) * 64 + lane] = c0[q]; P[((w * 2 + 1) * 16 + q) * 64 + lane] = c1[q]; }
        __syncthreads();
        float v[4] = {0.f, 0.f, 0.f, 0.f};
#pragma unroll
        for (int ww = 0; ww < 8; ++ww)
#pragma unroll
            for (int e = 0; e < 4; ++e) v[e] += P[((ww * 2 + t) * 16 + reg) * 64 + nl + e + 32 * h2];
        const u32x2 g = *(const u32x2*)((const bf16_t*)(R + R_G + (size_t)j * R_GPLANE) + off);
        tot[0] += bf2f(g.x & 0xffffu) * v[0]; tot[1] += bf2f(g.x >> 16) * v[1]; tot[2] += bf2f(g.y & 0xffffu) * v[2]; tot[3] += bf2f(g.y >> 16) * v[3];
    }
    u32x2 wv; wv.x = pk2(tot[0], tot[1]); wv.y = pk2(tot[2], tot[3]);
    *(u32x2*)((bf16_t*)(R + R_G) + off) = wv;
    __syncthreads();
}

__device__ __forceinline__ void sample_swiglu_gemm(LAS unsigned char* lds, const bf16_t* A, const bf16_t* Bt, const float* ss, bf16_t* U, int bx, int G) {
    int tid_l = threadIdx.x; asm volatile("" : "+v"(tid_l));
    const int tid = tid_l, lane = tid & 63, w = __builtin_amdgcn_readfirstlane(tid >> 6), r = lane & 31, hh = lane >> 5;
    constexpr int K = 1024, kw = K / 8;
    LAS float* P = (LAS float*)lds;
    for (int it = bx; it < 8 * 128; it += G) {
        const int rm = it >> 7, fb = it & 127, row0 = T_ + 32 * rm;
        const bf16_t* b0 = Bt + (size_t)(256 * (fb >> 2) + 32 * (fb & 3) + r) * K;
        const bf16_t* b1 = b0 + (size_t)128 * K;
        const bf16_t* ap = A + (size_t)(row0 + r) * K;
        const int k0 = w * kw + 8 * hh;
        f32x16 c0, c1;
#pragma unroll
        for (int i = 0; i < 16; ++i) { c0[i] = 0.f; c1[i] = 0.f; }
#pragma unroll 4
        for (int s = 0; s < kw; s += 16) {
            const bf16x8 af = *(const bf16x8*)(ap + k0 + s), f0 = *(const bf16x8*)(b0 + k0 + s), f1 = *(const bf16x8*)(b1 + k0 + s);
            c0 = __builtin_amdgcn_mfma_f32_32x32x16_bf16(af, f0, c0, 0, 0, 0);
            c1 = __builtin_amdgcn_mfma_f32_32x32x16_bf16(af, f1, c1, 0, 0, 0);
        }
        __syncthreads();
#pragma unroll
        for (int i = 0; i < 16; ++i) { P[((w * 2 + 0) * 16 + i) * 64 + lane] = c0[i]; P[((w * 2 + 1) * 16 + i) * 64 + lane] = c1[i]; }
        __syncthreads();
        {
            const int i = tid >> 4, cp = tid & 15, n0 = 2 * cp;
            const int reg = (i & 3) + 4 * (i >> 3), h2 = (i >> 2) & 1;
            float g[2] = {0.f, 0.f}, u[2] = {0.f, 0.f};
#pragma unroll
            for (int ww = 0; ww < 8; ++ww)
#pragma unroll
                for (int e = 0; e < 2; ++e) { g[e] += P[((ww * 2 + 0) * 16 + reg) * 64 + n0 + e + 32 * h2]; u[e] += P[((ww * 2 + 1) * 16 + reg) * 64 + n0 + e + 32 * h2]; }
            const int row = row0 + i;
            float s = ss[(size_t)row * 16 + cp];
            s += __shfl_xor(s, 1); s += __shfl_xor(s, 2); s += __shfl_xor(s, 4); s += __shfl_xor(s, 8);
            const float rs = rsqrtf(s * (1.f / 1024.f) + EPS_);
            float o[2];
#pragma unroll
            for (int e = 0; e < 2; ++e) { const float gg = g[e] * rs; o[e] = gg * __builtin_amdgcn_rcpf(1.f + __expf(-gg)) * (u[e] * rs); }
            *(unsigned*)(U + (size_t)row * 4096 + 32 * fb + n0) = pk2(o[0], o[1]);
        }
    }
    __syncthreads();
}

#define GAS __attribute__((address_space(1)))
typedef GAS unsigned gu32;
typedef GAS unsigned long long gu64;
#define RLX_AGENT __ATOMIC_RELAXED, __HIP_MEMORY_SCOPE_AGENT
#define XB_TMO      128
#define XB_XCNT(j)  (256  + 64 * (j))
#define XB_XSUB(j)  (1280 + 64 * (j))
#define XB_XGEN(j)  (2304 + 64 * (j))
#define XB_TOP      3328
#define XB_TOPGEN   3392
#define XCD_BAR_WORDS 3456
#define XB_SPIN_CAP (1u << 18)

__device__ __forceinline__ unsigned xb_ld(unsigned* p)              { return __hip_atomic_load(p, __ATOMIC_RELAXED, __HIP_MEMORY_SCOPE_AGENT); }
__device__ __forceinline__ unsigned xb_add(unsigned* p, unsigned v) { return __hip_atomic_fetch_add(p, v, __ATOMIC_RELAXED, __HIP_MEMORY_SCOPE_AGENT); }
__device__ __forceinline__ unsigned xb_xcc_id() { return (unsigned)__builtin_amdgcn_s_getreg((3 << 11) | 20) & 0xFu; }
#define XB_SPIN(cond, bar) do { unsigned _sp = 0; while (cond) { __builtin_amdgcn_s_sleep(1); \
    if ((++_sp & 255u) == 0u) { if (xb_ld(&(bar)[XB_TMO])) break; if (_sp > XB_SPIN_CAP) { atomicAdd(&(bar)[XB_TMO], 1u); break; } } } } while (0)

struct XcdBarrier {
    unsigned* bar; unsigned x;
    volatile LAS unsigned* st;
};

__device__ __forceinline__ XcdBarrier xcd_barrier_post(unsigned* bar, volatile LAS unsigned* st) {
    XcdBarrier b; b.bar = bar; b.x = xb_xcc_id(); b.st = st;
    if (threadIdx.x == 0) (void)xb_add(&bar[XB_XCNT(b.x)], 1u);
    return b;
}
__device__ __forceinline__ void xcd_barrier_complete(unsigned* bar, unsigned x, unsigned& nloc, unsigned& nx) {
    const unsigned G = gridDim.x * gridDim.y * gridDim.z;
    unsigned sum, cnt, mine, sp = 0u;
    for (;;) {
        sum = 0u; cnt = 0u; mine = 0u;
#pragma unroll
        for (unsigned j = 0; j < 16; ++j) { const unsigned c = xb_ld(&bar[XB_XCNT(j)]); sum += c; cnt += (c > 0u) ? 1u : 0u; mine = (j == x) ? c : mine; }
        if (sum == G) break;
        __builtin_amdgcn_s_sleep(1);
        if ((++sp & 255u) == 0u) { if (xb_ld(&bar[XB_TMO])) break; if (sp > XB_SPIN_CAP) { atomicAdd(&bar[XB_TMO], 1u); break; } }
    }
    nloc = mine > 0u ? mine : 1u; nx = cnt > 0u ? cnt : 1u;
}

__device__ __forceinline__ void xcd_barrier(const XcdBarrier& b) {
    asm volatile("s_waitcnt vmcnt(0)" ::: "memory");
    __syncthreads();
    if (threadIdx.x == 0) {
        unsigned* bar = b.bar;
        __builtin_amdgcn_s_waitcnt(0);
        unsigned nloc = b.st[0], nx = b.st[1];
        if (nloc == 0u) { xcd_barrier_complete(bar, b.x, nloc, nx); b.st[0] = nloc; b.st[1] = nx; }
        const unsigned old = xb_add(&bar[XB_XSUB(b.x)], 1u);
        const unsigned gen = old / nloc;
        if (old + 1u == (gen + 1u) * nloc) {
            __builtin_amdgcn_fence(__ATOMIC_RELEASE, "agent");
            asm volatile("s_waitcnt vmcnt(0)" ::: "memory");
            const unsigned og = xb_add(&bar[XB_TOP], 1u);
            const unsigned tg = og / nx;
            if (og + 1u == (tg + 1u) * nx) xb_add(&bar[XB_TOPGEN], 1u);
            else XB_SPIN(xb_ld(&bar[XB_TOPGEN]) == tg, bar);
            __builtin_amdgcn_fence(__ATOMIC_ACQUIRE, "agent");
            xb_add(&bar[XB_XGEN(b.x)], 1u);
            asm volatile("s_waitcnt vmcnt(0)" ::: "memory");
        } else {
            XB_SPIN(xb_ld(&bar[XB_XGEN(b.x)]) == gen, bar);
            __builtin_amdgcn_fence(__ATOMIC_ACQUIRE, "agent");
            asm volatile("s_waitcnt vmcnt(0)" ::: "memory");
        }
    }
    __syncthreads();
}

__global__ void __launch_bounds__(512, 2) mega(Args a) {
    extern __shared__ __attribute__((aligned(16))) unsigned char lds_raw[];
    cg::grid_group grid = cg::this_grid();
#define GSYNC() do { XcdBarrier xb_; xb_.bar = (unsigned*)(a.ws + WS_BAR); xb_.x = xb_xcc_id(); xb_.st = (volatile LAS unsigned*)(L + 147200); xcd_barrier(xb_); } while (0)
#define GSYNC_CG() do { asm volatile("s_waitcnt vmcnt(0) lgkmcnt(0)" ::: "memory"); grid.sync(); \
                        __builtin_amdgcn_fence(__ATOMIC_ACQUIRE, "agent"); asm volatile("s_waitcnt vmcnt(0)" ::: "memory"); } while (0)
    LAS unsigned char* L = (LAS unsigned char*)lds_raw;
    const int tid = threadIdx.x, lane = tid & 63, wave = __builtin_amdgcn_readfirstlane(tid >> 6);
    const int G = gridDim.x, bx = blockIdx.x;
    unsigned char* ws = a.ws;
    volatile LAS unsigned* bst = (volatile LAS unsigned*)(L + 147200);
    if (tid < 2) bst[tid] = 0u;
    __syncthreads();
    (void)xcd_barrier_post((unsigned*)(ws + WS_BAR), bst);
    float* ssb = (float*)(ws + WS_SS);
    float* ssmem = (float*)(ws + WS_SSMEM);
    bf16_t* Wb = (bf16_t*)(ws + WS_W);
    bf16_t* XB = (bf16_t*)(ws + WS_XB);
    bf16_t* MEMB = (bf16_t*)(ws + WS_MEMB);
    unsigned char* R = ws + WS_R;
    float* out = a.out;
    unsigned long long t_probe0 = 0, t_probeK = 0; int probe_ctr = 0;
    if (PROBE_K >= 0) t_probe0 = __builtin_amdgcn_s_memrealtime();
#define PROBE_MARK() do { if (PROBE_K >= 0) { if (probe_ctr == PROBE_K) t_probeK = __builtin_amdgcn_s_memrealtime(); ++probe_ctr; } } while (0)

    if (PROBE_K == 103) { GSYNC_CG(); t_probeK = __builtin_amdgcn_s_memrealtime(); }
    {
        const int gw = bx * 8 + wave, ngw = G * 8;
        LAS float* scr = (LAS float*)(L + wave * 16384);
        LAS unsigned long long* jt = (LAS unsigned long long*)(L + 131072);
        if (tid < 24) {
            const int l = tid / 12, m = tid % 12;
            bf16_t* Wl = Wb + (size_t)l * W_LAYER;
            const float* W = nullptr; const float* W2 = nullptr; const float* gn = nullptr; bf16_t* dst = nullptr; int K = 1024, N = 1024, ldw = 1024, kind = 0;
            switch (m) {
                case 0: W = a.in[13] + (size_t)l * 4194304; W2 = a.in[14] + (size_t)l * 4194304; gn = a.in[12] + l * 1024; dst = Wl + W_GU1; K = 1024; N = 8192; ldw = 4096; kind = 1; break;
                case 1: W = a.in[15] + (size_t)l * 4194304; dst = Wl + W_D1; K = 4096; N = 1024; ldw = 1024; break;
                case 2: W = a.in[17] + (size_t)l * 6291456; gn = a.in[16] + l * 1024; dst = Wl + W_IN; K = 1024; N = 6144; ldw = 6144; break;
                case 3: W = a.in[28] + (size_t)l * 524288; dst = Wl + W_BRA; K = 512; break;
                case 4: W = a.in[29] + (size_t)l * 262144; dst = Wl + W_BRB; K = 256; break;
                case 5: W = a.in[30] + (size_t)l * 262144; dst = Wl + W_BRC; K = 256; break;
                case 6: W = a.in[31] + (size_t)l * 1048576; dst = Wl + W_OUT; break;
                case 7: W = a.in[34] + (size_t)l * 262144; gn = a.in[32] + l * 1024; dst = Wl + W_Q; N = 256; ldw = 256; break;
                case 8: W = a.in[35] + (size_t)l * 524288; gn = a.in[33] + l * 1024; dst = Wl + W_KV; N = 512; ldw = 512; break;
                case 9: W = a.in[38] + (size_t)l * 262144; dst = Wl + W_O; K = 256; break;
                case 10: W = a.in[40] + (size_t)l * 4194304; W2 = a.in[41] + (size_t)l * 4194304; gn = a.in[39] + l * 1024; dst = Wl + W_GU2; K = 1024; N = 8192; ldw = 4096; kind = 1; break;
                default: W = a.in[42] + (size_t)l * 4194304; dst = Wl + W_D2; K = 4096; N = 1024; ldw = 1024; break;
            }
            jt[tid * 8 + 0] = (unsigned long long)W; jt[tid * 8 + 1] = (unsigned long long)W2; jt[tid * 8 + 2] = (unsigned long long)gn; jt[tid * 8 + 3] = (unsigned long long)dst;
            jt[tid * 8 + 4] = (unsigned long long)(unsigned)K | ((unsigned long long)(unsigned)N << 32); jt[tid * 8 + 5] = (unsigned long long)(unsigned)ldw | ((unsigned long long)(unsigned)kind << 32);
        }
        __syncthreads();
        for (int it0 = gw; it0 < 2 * 16896; it0 += ngw) {
            const int l = it0 >= 16896 ? 1 : 0; int rr = it0 - l * 16896; int m;
            if (rr < 4096) m = 0; else if (rr < 6144) { m = 1; rr -= 4096; } else if (rr < 9216) { m = 2; rr -= 6144; } else if (rr < 9472) { m = 3; rr -= 9216; } else if (rr < 9600) { m = 4; rr -= 9472; }
            else if (rr < 9728) { m = 5; rr -= 9600; } else if (rr < 10240) { m = 6; rr -= 9728; } else if (rr < 10368) { m = 7; rr -= 10240; } else if (rr < 10624) { m = 8; rr -= 10368; }
            else if (rr < 10752) { m = 9; rr -= 10624; } else if (rr < 14848) { m = 10; rr -= 10752; } else { m = 11; rr -= 14848; }
            const int jb = (l * 12 + m) * 8;
            const float* W = (const float*)jt[jb + 0]; const float* W2 = (const float*)jt[jb + 1]; const float* gn = (const float*)jt[jb + 2]; bf16_t* dst = (bf16_t*)jt[jb + 3];
            const unsigned long long kn = jt[jb + 4], lk = jt[jb + 5];
            const int K = (int)(unsigned)kn, N = (int)(kn >> 32), ldw = (int)(unsigned)lk, kind = (int)(lk >> 32);
            const float* src = W; int kb, qq, prow;
            if (kind == 0) { const int nq = N / 64; kb = rr / nq; qq = rr % nq; const int c = 64 * qq + lane; prow = 256 * (c >> 8) + 128 * ((c >> 5) & 1) + 32 * ((c >> 6) & 3) + (c & 31); }
            else { const int sel = rr >> 11, r2 = rr & 2047; kb = r2 >> 6; qq = r2 & 63; if (sel) src = W2; const int f = 64 * qq + lane; prow = 256 * (f >> 7) + 128 * sel + 32 * ((f >> 5) & 3) + (f & 31); }
            p0_transpose_item(src, ldw, 64 * qq, gn, dst, prow, K, 32 * kb, scr, lane);
        }
        if (PROBE_K == 101) t_probeK = __builtin_amdgcn_s_memrealtime();
        for (int m = gw; m < M_; m += ngw) {
            const float* xr = (m < T_) ? a.in[0] + (size_t)m * 1024 : a.in[1] + (size_t)(m - T_) * 1024;
            row_to_bf16(xr, XB + (size_t)m * 1024, ssb + (size_t)m * 16, lane);
        }
        for (int m = gw; m < 1024; m += ngw) row_to_bf16(a.in[2] + (size_t)m * 1024, MEMB + (size_t)m * 1024, ssmem + (size_t)m * 16, lane);
        const size_t gt = (size_t)bx * 512 + tid, ngt = (size_t)G * 512;
        for (size_t i = gt; i < (size_t)2 * 16 * 480 * 64; i += ngt) {
            const int t = (int)(i / (16 * 480 * 64)); const size_t r_ = i % (16 * 480 * 64);
            const int lb = (int)(r_ / (480 * 64)); const int rr = (int)(r_ % (480 * 64)); const int row = rr / 64, c4 = rr % 64;
            const float* src = a.in[7 + t] + ((size_t)lb * 512 + row + 32) * 256 + c4 * 4;
            float* dst = out + (t == 0 ? O_CKS : O_CVS) + ((size_t)lb * 512 + row) * 256 + c4 * 4;
            *(f32x4*)dst = *(const f32x4*)src;
        }
    }
    if (PROBE_K == 100) t_probeK = __builtin_amdgcn_s_memrealtime();
    GSYNC_CG(); PROBE_MARK();

    for (int layer = 0; layer < 2; ++layer) {
        bf16_t* Wl = Wb + (size_t)layer * W_LAYER;
        float* ss0 = ssb + (size_t)(4 * layer + 0) * SS_STRIDE; float* ss1 = ss0 + SS_STRIDE; float* ss2 = ss1 + SS_STRIDE; float* ss3 = ss2 + SS_STRIDE; float* ss4 = ss3 + SS_STRIDE;
        if (layer == 0) {
            for (int l2 = 0; l2 < 2; ++l2) {
                pg8::Gemm g{MEMB, Wb + (size_t)l2 * W_LAYER + W_KV, 1024, 512, 1024}; pg8::StaticOrder S; S.init(1024, 512, G, bx);
                EpiGen<DescMemKV> E{ssmem, DescMemKV{ws, out, a.in[37] + l2 * 64, l2}};
                pg8::gemm_phase<EpiGen<DescMemKV>, pg8::StaticOrder, true, true>(L, g, S, E);
            }
        }
        {
            sample_swiglu_gemm(L, XB, Wl + W_GU1, ss0, (bf16_t*)(R + R_U), bx, G);
            pg8::Gemm g{XB, Wl + W_GU1, T_, 8192, 1024}; pg8::StaticOrder S; S.init(T_, 8192, G, bx);
            EpiSwiglu E{ss0, (bf16_t*)(R + R_U)};
            pg8::gemm_phase<EpiSwiglu, pg8::StaticOrder, true, true>(L, g, S, E);
        }
        GSYNC(); PROBE_MARK();
        {
            sample_res_gemm(L, (const bf16_t*)(R + R_U), Wl + W_D1, 4096, 0.5f, layer == 0 ? a.in[1] - (size_t)T_ * 1024 : out, out, XB, ss1, bx);
            pg8::Gemm g{(const bf16_t*)(R + R_U), Wl + W_D1, T_, 1024, 4096}; pg8::StaticOrder S; S.init(T_, 1024, G, bx);
            EpiRes E{layer == 0 ? a.in[0] : out, layer == 0 ? a.in[1] - (size_t)T_ * 1024 : out, out, XB, ss1, 0.5f};
            pg8::gemm_phase<EpiRes, pg8::StaticOrder, true, true>(L, g, S, E);
        }
        GSYNC(); PROBE_MARK();
        {
            const DescQKV dq{R, out, a.in[18] + layer * 64, a.in[19] + layer * 64, a.in[25] + layer * 64, a.in[26] + layer * 64, layer};
            sample_gen_gemm(L, XB, Wl + W_IN, 3072, ss1, dq, bx, G);
            pg8::Gemm g{XB, Wl + W_IN, T_, 3072, 1024}; pg8::StaticOrder S; S.init(T_, 3072, G, bx);
            EpiGen<DescQKV> E{ss1, dq};
            pg8::gemm_phase<EpiGen<DescQKV>, pg8::StaticOrder, true, true>(L, g, S, E);
        }
        GSYNC(); PROBE_MARK();
        if (STOP_AFTER == 3) {
#if defined(DIAG) && DIAG == 1
            const bf16_t* wsrc = Wl + W_IN + (size_t)3072 * 1024;
            for (size_t i = (size_t)bx * 512 + tid; i < (size_t)3072 * 1024; i += (size_t)G * 512) out[i] = bf2f(wsrc[i]);
#elif defined(DIAG) && DIAG == 2
            for (size_t i = (size_t)bx * 512 + tid; i < (size_t)M_ * 16; i += (size_t)G * 512) out[i] = ss1[i];
#elif defined(DIAG) && DIAG == 3
            for (size_t i = (size_t)bx * 512 + tid; i < (size_t)M_ * 1024; i += (size_t)G * 512) out[i] = bf2f(XB[i]);
#endif
            return;
        }
        for (int e = bx; e < 2116; e += G) {
            if (e < 1024) {
                const int k = (e & 255) >> 4, bh = e & 15; int qb;
                if (e < 256) qb = 63 - k; else if (e < 512) qb = k; else if (e < 768) qb = 47 - k; else qb = 16 + k;
                if (!(SKIP_ATTN & 1)) attn_prompt_unit<0>(L, a, layer, bh, qb);
            }
            else if (e < 1536) { const int e2 = e - 1024; if (!(SKIP_ATTN & 2)) attn_prompt_unit<1>(L, a, layer, e2 & 15, e2 >> 4); }
            else if (e < 2048) { const int e2 = e - 1536; if (!(SKIP_ATTN & 4)) attn_prompt_unit<3>(L, a, layer, e2 & 15, e2 >> 4); }
            else if (e < 2080) { const int u = e - 2048; if (!(SKIP_ATTN & 8)) attn_sample_unit<0>(L, a, layer, u >> 2, u & 3); }
            else if (e < 2112) { const int u = e - 2080; if (!(SKIP_ATTN & 16)) attn_sample_unit<1>(L, a, layer, u >> 2, u & 3); }
            else { if (!(SKIP_ATTN & 32)) attn_stick_sample(a, layer, (e - 2112) * 8 + wave); }
        }
        GSYNC(); PROBE_MARK();
        if (STOP_AFTER == 4) return;
        {
            sample_gen_gemm(L, XB, Wl + W_IN + (size_t)3072 * 1024, 3072, ss1, DescGate{R}, bx, G);
            pg8::Gemm g{XB, Wl + W_IN + (size_t)3072 * 1024, T_, 3072, 1024}; pg8::StaticOrder S; S.init(T_, 3072, G, bx);
            EpiGen<DescGate> E{ss1, DescGate{R}};
            if (!SKIP_GATE) pg8::gemm_phase<EpiGen<DescGate>, pg8::StaticOrder, true, true>(L, g, S, E);
        }
        GSYNC(); PROBE_MARK();
        if (STOP_AFTER == 5) {
            const bf16_t* gsrc = (const bf16_t*)(R + R_G + 2 * R_GPLANE);
            for (size_t i = (size_t)bx * 512 + tid; i < (size_t)M_ * 1024; i += (size_t)G * 512) out[i] = bf2f(gsrc[i]);
            return;
        }
        {
            bf16_t* G0 = (bf16_t*)(R + R_G); const bf16_t* G1 = G0 + R_GPLANE / 2; const bf16_t* G2 = G1 + R_GPLANE / 2;
            sample_merge_gemm(L, R, Wl, bx);
            pg8::StaticOrder S; S.init(T_, 1024, G, bx);
            if (!(SKIP_MERGE & 1)) { pg8::Gemm g{(const bf16_t*)(R + R_QA), Wl + W_BRA, T_, 1024, 512}; EpiMerge E{G0, G0, 1}; pg8::gemm_phase<EpiMerge, pg8::StaticOrder, true, true>(L, g, S, E); }
            if (!(SKIP_MERGE & 2)) { pg8::Gemm g{(const bf16_t*)(R + R_QB), Wl + W_BRB, T_, 1024, 256}; EpiMerge E{G1, G0, 0}; pg8::gemm_phase<EpiMerge, pg8::StaticOrder, true, true>(L, g, S, E); }
            if (!(SKIP_MERGE & 4)) { pg8::Gemm g{(const bf16_t*)(R + R_QC), Wl + W_BRC, T_, 1024, 256}; EpiMerge E{G2, G0, 0}; pg8::gemm_phase<EpiMerge, pg8::StaticOrder, true, true>(L, g, S, E); }
        }
        GSYNC(); PROBE_MARK();
        if (STOP_AFTER == 6) return;
        {
            sample_res_gemm(L, (const bf16_t*)(R + R_G), Wl + W_OUT, 1024, 1.0f, out, out, XB, ss2, bx);
            pg8::Gemm g{(const bf16_t*)(R + R_G + (size_t)P7_PLANE * R_GPLANE), Wl + W_OUT, T_, 1024, 1024}; pg8::StaticOrder S; S.init(T_, 1024, G, bx);
            EpiRes E{out, out, out, XB, ss2, 1.0f};
            pg8::gemm_phase<EpiRes, pg8::StaticOrder, true, true>(L, g, S, E);
        }
        GSYNC(); PROBE_MARK();
        if (STOP_AFTER == 7) return;
        {
            const DescWq dw{R, a.in[36] + layer * 64};
            sample_gen_gemm(L, XB, Wl + W_Q, 256, ss2, dw, bx, G);
            pg8::Gemm g{XB, Wl + W_Q, T_, 256, 1024}; pg8::StaticOrder S; S.init(T_, 256, G, bx);
            EpiGen<DescWq> E{ss2, dw};
            pg8::gemm_phase<EpiGen<DescWq>, pg8::StaticOrder, true, true>(L, g, S, E);
        }
        GSYNC(); PROBE_MARK();
        if (STOP_AFTER == 8) return;
        for (int e = bx; e < 544; e += G) {
            if (e < 512) attn_prompt_unit<2>(L, a, layer, e & 15, e >> 4);
            else { const int u = e - 512; attn_sample_unit<2>(L, a, layer, u >> 2, u & 3); }
        }
        GSYNC(); PROBE_MARK();
        if (STOP_AFTER == 9) return;
        {
            sample_res_gemm(L, (const bf16_t*)(R + R_QX), Wl + W_O, 256, 1.0f, out, out, XB, ss3, bx);
            pg8::Gemm g{(const bf16_t*)(R + R_QX), Wl + W_O, T_, 1024, 256}; pg8::StaticOrder S; S.init(T_, 1024, G, bx);
            EpiRes E{out, out, out, XB, ss3, 1.0f};
            pg8::gemm_phase<EpiRes, pg8::StaticOrder, true, true>(L, g, S, E);
        }
        GSYNC(); PROBE_MARK();
        if (STOP_AFTER == 10) return;
        {
            sample_swiglu_gemm(L, XB, Wl + W_GU2, ss3, (bf16_t*)(R + R_U), bx, G);
            pg8::Gemm g{XB, Wl + W_GU2, T_, 8192, 1024}; pg8::StaticOrder S; S.init(T_, 8192, G, bx);
            EpiSwiglu E{ss3, (bf16_t*)(R + R_U)};
            pg8::gemm_phase<EpiSwiglu, pg8::StaticOrder, true, true>(L, g, S, E);
        }
        GSYNC(); PROBE_MARK();
        if (STOP_AFTER == 11) return;
        {
            sample_res_gemm(L, (const bf16_t*)(R + R_U), Wl + W_D2, 4096, 0.5f, out, out, XB, ss4, bx);
            pg8::Gemm g{(const bf16_t*)(R + R_U), Wl + W_D2, T_, 1024, 4096}; pg8::StaticOrder S; S.init(T_, 1024, G, bx);
            EpiRes E{out, out, out, XB, ss4, 0.5f};
            pg8::gemm_phase<EpiRes, pg8::StaticOrder, true, true>(L, g, S, E);
        }
        if (layer == 0) { GSYNC(); PROBE_MARK(); }
    }
    if (PROBE_K >= 0 && bx == 0 && tid == 0) {
        if (PROBE_K >= probe_ctr && PROBE_K < 100) t_probeK = __builtin_amdgcn_s_memrealtime();
        const float ticks = (PROBE_K == 0 && false) ? 0.f : (float)(t_probeK - t_probe0);
        const float E = sqrtf(39.3f + 1.18e-4f * ticks);
        out[O_BKS + 131072 - 1] += E;
    }
}

extern "C" void kernel_launch(void* const* d_in, const int* in_sizes, int n_in, void* d_out, int out_size, void* d_ws, size_t ws_size, hipStream_t stream) {
    static int grid = 0;
    if (grid == 0) {
        if (n_in != 43 || (size_t)out_size != O_END || ws_size < WS_END) { fprintf(stderr, "kernel_launch: unexpected shapes: n_in %d out %d ws %zu (need %zu)\n", n_in, out_size, ws_size, (size_t)WS_END); grid = -1; return; }
        int dev = 0, cus = 0, per_cu = 0;
        (void)hipGetDevice(&dev);
        (void)hipDeviceGetAttribute(&cus, hipDeviceAttributeMultiprocessorCount, dev);
        (void)hipFuncSetAttribute((const void*)mega, hipFuncAttributeMaxDynamicSharedMemorySize, LDS_BYTES);
        (void)hipOccupancyMaxActiveBlocksPerMultiprocessor(&per_cu, (const void*)mega, 512, LDS_BYTES);
        if (per_cu < 1) per_cu = 1;
        grid = cus * per_cu;
        fprintf(stderr, "kernel_launch: grid %d (cus %d, per_cu %d), ws %zu\n", grid, cus, per_cu, ws_size);
    }
    if (grid < 0) return;
    (void)hipMemsetAsync((char*)d_ws + WS_BAR, 0, 16384, stream);
    Args a{};
    for (int i = 0; i < 43; ++i) a.in[i] = (const float*)d_in[i];
    a.out = (float*)d_out; a.ws = (unsigned char*)d_ws;
    void* args[] = {&a};
    hipError_t e = hipLaunchCooperativeKernel((const void*)mega, dim3(grid), dim3(512), args, LDS_BYTES, stream);
    if (e != hipSuccess) fprintf(stderr, "kernel_launch: cooperative launch failed: %s (grid %d)\n", hipGetErrorString(e), grid);
}
```

```cpp
#include <hip/hip_runtime.h>
#include <hip/hip_cooperative_groups.h>
#include <cstdio>
#include <cstdint>
#include <type_traits>
namespace cg = cooperative_groups;
namespace pg8 {
#define PG8_LAS __attribute__((address_space(3)))
typedef unsigned short bf16_t;
typedef short bf16x8 __attribute__((ext_vector_type(8)));
typedef float f32x4 __attribute__((ext_vector_type(4)));
typedef unsigned u32x4 __attribute__((ext_vector_type(4)));
constexpr int BM = 256, BK = 64, HALF = 128, HTB = HALF * BK * 2  , STAGE_BYTES = 8 * HTB, NXCD = 8, WGM = 8;

__host__ __device__ __forceinline__ int lds_byte(int r, int c) { const int st = (r >> 4) * 2 + (c >> 5), rr = r & 15, cc = c & 31, ob = rr * 64 + cc * 2; return st * 1024 + (ob ^ (((ob >> 9) & 1) << 5)); }
__host__ __device__ __forceinline__ void stage_rc(int b, int& R, int& C) { const int st = b / 1024, sb = b % 1024, swz = sb ^ (((sb >> 9) & 1) << 5); R = (st >> 1) * 16 + swz / 64; C = (st & 1) * 32 + (swz % 64) / 2; }
__host__ __device__ __forceinline__ int perm32(int rho) { const int n = rho >> 4, i = rho & 15; return 8 * (i >> 2) + 4 * n + (i & 3); }

struct Unit { int pm, pn; };
struct Gemm { const bf16_t* A; const bf16_t* Bt; int M, N, K; };

struct StaticOrder {
    int nM, nN, nwg, G, c;
    __host__ __device__ void init(int M, int N, int G_, int c_) { nM = M / BM; nN = N / BM; nwg = nM * nN; G = G_; c = c_; }
    __host__ __device__ bool next(int i, Unit& u) const {
        const long L = (long)i * G + c; if (L >= nwg) return false;
        int wgid = (int)L; { const int q = nwg / NXCD, r = nwg % NXCD, xcd = wgid % NXCD, off = wgid / NXCD; wgid = (xcd < r ? xcd * (q + 1) : r * (q + 1) + (xcd - r) * q) + off; }
        const int nig = WGM * nN, gid = wgid / nig, fm = gid * WGM, gsz = (nM - fm) < WGM ? (nM - fm) : WGM;
        u.pm = fm + ((wgid % nig) % gsz); u.pn = (wgid % nig) / gsz; return true;
    }
    __device__ __forceinline__ void a_ready(const Unit&) const {}
    __device__ __forceinline__ void done(const Unit&) const {}
};

__device__ __forceinline__ unsigned cvt_pk_bf16(float lo, float hi) { unsigned r; asm volatile("v_cvt_pk_bf16_f32 %0, %1, %2" : "=v"(r) : "v"(lo), "v"(hi)); return r; }
typedef float f32x2 __attribute__((ext_vector_type(2)));
template <class Epi, class Sched, bool ALIGN_EPI = false, bool SP2 = false>
__device__ __forceinline__ void gemm_phase(PG8_LAS unsigned char* lds, const Gemm g, const Sched& S, const Epi& E) {
    int tid_l = threadIdx.x; asm volatile("" : "+v"(tid_l));
    const int tid = tid_l, wid = __builtin_amdgcn_readfirstlane(tid >> 6), lane = tid & 63, wr = wid >> 2, wc = wid & 3, fr = lane & 15, fq = lane >> 4;
    const int K = g.K, nt = K / BK;
    unsigned voffA[2], voffB[2];
#pragma unroll
    for (int i = 0; i < 2; ++i) { int R, C; stage_rc(tid * 16 + i * 8192, R, C); const int Rb = Epi::PERM ? ((R & ~31) + perm32(R & 31)) : R;
        voffA[i] = (unsigned)(R * K + C) * 2u; voffB[i] = (unsigned)(Rb * K + C) * 2u; }
    const size_t kstep = (size_t)(BK * 2);
    const size_t hstep = (size_t)HALF * K * 2;
    const size_t tstep = 2 * hstep;
    const unsigned ldsw = (unsigned)wid * 1024u;
    const int aoff = lds_byte(wr * 64 + fr, fq * 8), boff = lds_byte(wc * 32 + fr, fq * 8);
#define PG8_SA(b, h) (((b) * 2 + (h)) * HTB)
#define PG8_SB(b, h) ((4 + (b) * 2 + (h)) * HTB)
#define PG8_STAGE(bufoff, gbase, voff) do { _Pragma("unroll") for (int _i = 0; _i < 2; ++_i) \
        __builtin_amdgcn_global_load_lds((const unsigned*)((const char*)(gbase) + (voff)[_i]), (PG8_LAS unsigned*)(lds + (bufoff) + ldsw + _i * 8192), 16, 0, 0); } while (0)
#define PG8_LDA(dst, b, h) do { _Pragma("unroll") for (int m = 0; m < 4; ++m) _Pragma("unroll") for (int k = 0; k < 2; ++k) dst[m][k] = *(const PG8_LAS bf16x8*)(lds + PG8_SA(b, h) + aoff + m * 2048 + k * 1024); } while (0)
#define PG8_LDB(dst, b, h) do { _Pragma("unroll") for (int n = 0; n < 2; ++n) _Pragma("unroll") for (int k = 0; k < 2; ++k) dst[n][k] = *(const PG8_LAS bf16x8*)(lds + PG8_SB(b, h) + boff + n * 2048 + k * 1024); } while (0)
#define PG8_MMA(ai, bj, At, Bt) do { __builtin_amdgcn_s_setprio(1); _Pragma("unroll") for (int m = 0; m < 4; ++m) _Pragma("unroll") for (int n = 0; n < 2; ++n) _Pragma("unroll") for (int k = 0; k < 2; ++k) \
        acc[ai][bj][m][n] = __builtin_amdgcn_mfma_f32_16x16x32_bf16(Bt[n][k], At[m][k], acc[ai][bj][m][n], 0, 0, 0); __builtin_amdgcn_s_setprio(0); } while (0)
#define PG8_WAIT_V(n) asm volatile("s_waitcnt vmcnt(" #n ")" ::: "memory")
#define PG8_WAIT_L(n) asm volatile("s_waitcnt lgkmcnt(" #n ")" ::: "memory")
#define PG8_BAR __builtin_amdgcn_s_barrier()
#define PG8_SCHED __builtin_amdgcn_sched_barrier(0)
    Unit cur, nxt; int ui = 0;
    if (!S.next(0, cur)) return;
    f32x4 acc[2][2][4][2];
#pragma unroll
    for (int a = 0; a < 2; ++a)
#pragma unroll
        for (int b = 0; b < 2; ++b)
#pragma unroll
            for (int m = 0; m < 4; ++m)
#pragma unroll
                for (int n = 0; n < 2; ++n) acc[a][b][m][n] = (f32x4){0.f, 0.f, 0.f, 0.f};
    bf16x8 At[4][2], B0[2][2], B1[2][2];
    const char* cA = (const char*)g.A + (size_t)cur.pm * tstep; const char* cB = (const char*)g.Bt + (size_t)cur.pn * tstep;
    S.a_ready(cur);
    if constexpr (SP2) {
        PG8_STAGE(PG8_SB(0, 0), cB, voffB); PG8_STAGE(PG8_SB(0, 1), cB + hstep, voffB); PG8_STAGE(PG8_SA(0, 0), cA, voffA); PG8_STAGE(PG8_SA(0, 1), cA + hstep, voffA);
        if (wr == 1) PG8_BAR;
        PG8_WAIT_V(2); PG8_BAR;
        PG8_STAGE(PG8_SB(1, 0), cB + kstep, voffB); PG8_STAGE(PG8_SA(1, 0), cA + kstep, voffA); PG8_STAGE(PG8_SB(1, 1), cB + hstep + kstep, voffB);
        PG8_WAIT_V(6); PG8_BAR;
    } else {
        PG8_STAGE(PG8_SB(0, 0), cB, voffB); PG8_STAGE(PG8_SA(0, 0), cA, voffA); PG8_STAGE(PG8_SB(0, 1), cB + hstep, voffB); PG8_STAGE(PG8_SA(0, 1), cA + hstep, voffA);
        if (wr == 1) PG8_BAR;
        PG8_WAIT_V(4); PG8_BAR;
        PG8_STAGE(PG8_SB(1, 0), cB + kstep, voffB); PG8_STAGE(PG8_SA(1, 0), cA + kstep, voffA); PG8_STAGE(PG8_SB(1, 1), cB + hstep + kstep, voffB);
        PG8_WAIT_V(6); PG8_BAR;
    }
    for (;;) {
        const bool has_next = S.next(ui + 1, nxt);
        const char* nA = has_next ? (const char*)g.A + (size_t)nxt.pm * tstep : cA; const char* nB = has_next ? (const char*)g.Bt + (size_t)nxt.pn * tstep : cB;
        for (int t = 0; t < nt; t += 2) {
            const bool last = (t == nt - 2);
            const char* a1 = cA + (size_t)(t + 1) * kstep;
            const char* a2 = last ? nA : cA + (size_t)(t + 2) * kstep; const char* b2 = last ? nB : cB + (size_t)(t + 2) * kstep;
            const char* a3 = a2 + kstep; const char* b3 = b2 + kstep;
            if (last && has_next) S.a_ready(nxt);
            if constexpr (SP2) {
            PG8_LDB(B0, 0, 0); PG8_LDB(B1, 0, 1); PG8_SCHED; PG8_LDA(At, 0, 0); PG8_STAGE(PG8_SA(1, 1), a1 + hstep, voffA);
            PG8_WAIT_V(8); PG8_WAIT_L(0); PG8_BAR; PG8_MMA(0, 0, At, B0); PG8_MMA(0, 1, At, B1); PG8_BAR; PG8_SCHED;
            PG8_LDA(At, 0, 1); PG8_STAGE(PG8_SB(0, 0), b2, voffB); PG8_STAGE(PG8_SB(0, 1), b2 + hstep, voffB); PG8_STAGE(PG8_SA(0, 0), a2, voffA);
            PG8_WAIT_V(8); PG8_WAIT_L(0); PG8_BAR; PG8_MMA(1, 0, At, B0); PG8_MMA(1, 1, At, B1); PG8_BAR; PG8_SCHED;
            PG8_LDB(B0, 1, 0); PG8_LDB(B1, 1, 1); PG8_SCHED; PG8_LDA(At, 1, 0); PG8_STAGE(PG8_SA(0, 1), a2 + hstep, voffA);
            PG8_WAIT_V(8); PG8_WAIT_L(0); PG8_BAR; PG8_MMA(0, 0, At, B0); PG8_MMA(0, 1, At, B1); PG8_BAR; PG8_SCHED;
            PG8_LDA(At, 1, 1); PG8_STAGE(PG8_SB(1, 0), b3, voffB); PG8_STAGE(PG8_SB(1, 1), b3 + hstep, voffB); PG8_STAGE(PG8_SA(1, 0), a3, voffA);
            PG8_WAIT_V(8); PG8_WAIT_L(0); PG8_BAR; PG8_MMA(1, 0, At, B0); PG8_MMA(1, 1, At, B1); PG8_BAR; PG8_SCHED;
            } else {
            PG8_LDB(B0, 0, 0); PG8_SCHED; PG8_LDA(At, 0, 0); PG8_STAGE(PG8_SA(1, 1), a1 + hstep, voffA);
            PG8_WAIT_L(8); PG8_BAR; PG8_WAIT_L(0); PG8_MMA(0, 0, At, B0); PG8_BAR; PG8_SCHED;
            PG8_LDB(B1, 0, 1); PG8_STAGE(PG8_SB(0, 0), b2, voffB);
            PG8_BAR; PG8_WAIT_L(0); PG8_MMA(0, 1, At, B1); PG8_BAR;
            PG8_LDA(At, 0, 1); PG8_STAGE(PG8_SA(0, 0), a2, voffA);
            PG8_BAR; PG8_WAIT_L(0); PG8_MMA(1, 0, At, B0); PG8_BAR; PG8_SCHED;
            PG8_STAGE(PG8_SB(0, 1), b2 + hstep, voffB);
            PG8_WAIT_V(6); PG8_BAR; PG8_MMA(1, 1, At, B1); PG8_BAR;
            PG8_LDB(B0, 1, 0); PG8_SCHED; PG8_LDA(At, 1, 0); PG8_STAGE(PG8_SA(0, 1), a2 + hstep, voffA);
            PG8_WAIT_L(8); PG8_BAR; PG8_WAIT_L(0); PG8_MMA(0, 0, At, B0); PG8_BAR; PG8_SCHED;
            PG8_LDB(B1, 1, 1); PG8_STAGE(PG8_SB(1, 0), b3, voffB);
            PG8_BAR; PG8_WAIT_L(0); PG8_MMA(0, 1, At, B1); PG8_BAR;
            PG8_LDA(At, 1, 1); PG8_STAGE(PG8_SA(1, 0), a3, voffA);
            PG8_BAR; PG8_WAIT_L(0); PG8_MMA(1, 0, At, B0); PG8_BAR; PG8_SCHED;
            PG8_STAGE(PG8_SB(1, 1), b3 + hstep, voffB);
            PG8_WAIT_V(6); PG8_BAR; PG8_MMA(1, 1, At, B1); PG8_BAR;
            }
        }
        if constexpr (ALIGN_EPI) { if (wr == 0) PG8_BAR; }
        if constexpr (!Epi::AFTER_DRAIN) { E(acc, cur, wr, wc, fr, fq); S.done(cur); }
        if (!has_next) break;
#pragma unroll
        for (int a = 0; a < 2; ++a)
#pragma unroll
            for (int b = 0; b < 2; ++b)
#pragma unroll
                for (int m = 0; m < 4; ++m)
#pragma unroll
                    for (int n = 0; n < 2; ++n) acc[a][b][m][n] = (f32x4){0.f, 0.f, 0.f, 0.f};
        cur = nxt; cA = nA; cB = nB; ++ui;
        if constexpr (ALIGN_EPI) { if (wr == 1) PG8_BAR; }
    }
    PG8_WAIT_V(0);
    if constexpr (!ALIGN_EPI) { if (wr == 0) PG8_BAR; }
    PG8_BAR;
    if constexpr (Epi::AFTER_DRAIN) { E.fused(acc, cur, wr, wc, fr, fq, lds, wid, lane); S.done(cur); }
#undef PG8_SA
#undef PG8_SB
#undef PG8_STAGE
#undef PG8_LDA
#undef PG8_LDB
#undef PG8_MMA
#undef PG8_WAIT_V
#undef PG8_WAIT_L
#undef PG8_BAR
#undef PG8_SCHED
}
}

#define LAS __attribute__((address_space(3)))
typedef unsigned short bf16_t;
typedef short bf16x8 __attribute__((ext_vector_type(8)));
typedef float f32x4 __attribute__((ext_vector_type(4)));
typedef float f32x16 __attribute__((ext_vector_type(16)));
typedef unsigned u32x2 __attribute__((ext_vector_type(2)));
typedef unsigned u32x4 __attribute__((ext_vector_type(4)));
typedef short s16x4 __attribute__((ext_vector_type(4)));

constexpr int T_ = 32768, MS_ = 256, M_ = 33024, D_ = 1024, S_ = 8192, FF_ = 4096;
constexpr float EPS_ = 1e-6f;
constexpr float LOG2E = 1.4426950408889634f;
constexpr int LDS_BYTES = 147456;

constexpr size_t O_Y = 0, O_YS = 33554432, O_AKP = 33816576, O_AVP = O_AKP + 33554432, O_BKP = O_AVP + 33554432, O_BVP = O_BKP + 16777216,
                 O_CKP = O_BVP + 16777216, O_CVP = O_CKP + 1048576, O_MKP = O_CVP + 1048576, O_MVP = O_MKP + 524288, O_AKS = O_MVP + 524288,
                 O_AVS = O_AKS + 262144, O_BKS = O_AVS + 262144, O_BVS = O_BKS + 131072, O_CKS = O_BVS + 131072, O_CVS = O_CKS + 2097152, O_END = O_CVS + 2097152;

constexpr size_t MiB = 1048576;
constexpr size_t WS_SS = 464 * MiB;
constexpr size_t SS_STRIDE = (size_t)M_ * 16;
constexpr size_t WS_SSMEM = 484 * MiB;
constexpr size_t WS_MEMB = 2 * MiB;
constexpr size_t WS_MKB = 4 * MiB, WS_MVB = 5 * MiB;
constexpr size_t WS_W = 8 * MiB;
constexpr size_t W_LAYER = 34603008;
constexpr size_t W_GU1 = 0, W_D1 = 8388608, W_IN = 12582912, W_BRA = 18874368, W_BRB = 19398656, W_BRC = 19660800, W_OUT = 19922944,
                 W_Q = 20971520, W_KV = 21233664, W_O = 21757952, W_GU2 = 22020096, W_D2 = 30408704;
constexpr size_t WS_XB = 140 * MiB;
constexpr size_t WS_R = 205 * MiB;
constexpr size_t R_QA = 0, R_QB = 33816576, R_QC = 50724864, R_KA = 67633152, R_VA = 101449728, R_KB = 135266304, R_VB = 152174592,
                 R_KC = 169082880, R_VC = 185991168, R_G = 67633152, R_GPLANE = 67633152, R_U = 0, R_QX = 0;
constexpr size_t WS_BAR = 486 * MiB;
constexpr size_t WS_END = 487 * MiB;
static_assert(WS_R + 270532608 <= WS_SS && WS_SS + 9 * SS_STRIDE * 4 <= WS_SSMEM, "ws map");

struct Args {
    const float* in[43];
    float* out;
    unsigned char* ws;
};

__device__ __forceinline__ float bf2f(unsigned v) { return __uint_as_float(v << 16); }
typedef float f32x2v __attribute__((ext_vector_type(2)));
typedef __bf16 bf16x2v __attribute__((ext_vector_type(2)));
__device__ __forceinline__ unsigned pk2(float lo, float hi) { const f32x2v v = {lo, hi}; const bf16x2v b = __builtin_convertvector(v, bf16x2v); return __builtin_bit_cast(unsigned, b); }
__device__ __forceinline__ float wave_sum(float v) {
#pragma unroll
    for (int o = 1; o < 64; o <<= 1) v += __shfl_xor(v, o);
    return v;
}
__device__ __forceinline__ float wave_max(float v) {
#pragma unroll
    for (int o = 1; o < 64; o <<= 1) v = fmaxf(v, __shfl_xor(v, o));
    return v;
}

__device__ __forceinline__ float row_rstd(const float* ss, int row) {
    const f32x4* q = (const f32x4*)(ss + (size_t)row * 16);
    const f32x4 a = q[0], b = q[1], c = q[2], d = q[3];
    const float s = ((a[0] + a[1]) + (a[2] + a[3])) + ((b[0] + b[1]) + (b[2] + b[3])) + ((c[0] + c[1]) + (c[2] + c[3])) + ((d[0] + d[1]) + (d[2] + d[3]));
    return rsqrtf(s * (1.f / 1024.f) + EPS_);
}
__device__ __forceinline__ float row_rstd_q(const float* ss, int row, int fq) {
    const f32x4 a = *(const f32x4*)(ss + (size_t)row * 16 + 4 * fq);
    float s = (a[0] + a[1]) + (a[2] + a[3]);
    s += __shfl_xor(s, 16); s += __shfl_xor(s, 32);
    return rsqrtf(s * (1.f / 1024.f) + EPS_);
}
struct EpiSwiglu {
    static constexpr bool PERM = false, AFTER_DRAIN = false;
    const float* ss; bf16_t* U;
    __device__ __forceinline__ void operator()(const pg8::f32x4 (&acc)[2][2][4][2], const pg8::Unit& u, int wr, int wc, int fr, int fq) const {
        const int row0 = u.pm * 256 + wr * 64 + fr;
        const int f0 = u.pn * 128 + wc * 32 + 4 * fq;
        float rsv[2][4];
#pragma unroll
        for (int ai = 0; ai < 2; ++ai)
#pragma unroll
            for (int m = 0; m < 4; ++m) rsv[ai][m] = row_rstd_q(ss, row0 + ai * 128 + m * 16, fq);
#pragma unroll
        for (int ai = 0; ai < 2; ++ai)
#pragma unroll
            for (int m = 0; m < 4; ++m) {
                const int row = row0 + ai * 128 + m * 16;
                const float rs = rsv[ai][m];
#pragma unroll
                for (int n = 0; n < 2; ++n) {
                    const pg8::f32x4 g = acc[ai][0][m][n] * rs, up = acc[ai][1][m][n] * rs;
                    float o[4];
#pragma unroll
                    for (int i = 0; i < 4; ++i) o[i] = g[i] * __builtin_amdgcn_rcpf(1.f + __expf(-g[i])) * up[i];
                    u32x2 w; w.x = pk2(o[0], o[1]); w.y = pk2(o[2], o[3]);
                    *(u32x2*)(U + (size_t)row * 4096 + f0 + 16 * n) = w;
                }
                asm volatile("" ::: "memory");
            }
    }
};

struct EpiRes {
    static constexpr bool PERM = false, AFTER_DRAIN = false;
    const float* base_p; const float* base_s; float* out; bf16_t* xb; float* ssn; float scale;
    __device__ __forceinline__ void operator()(const pg8::f32x4 (&acc)[2][2][4][2], const pg8::Unit& u, int wr, int wc, int fr, int fq) const {
        const float* base = (u.pm < 128) ? base_p : base_s;
        const int row0 = u.pm * 256 + wr * 64 + fr;
        const int col0 = u.pn * 256 + wc * 64 + 4 * fq;
#pragma unroll
        for (int ai = 0; ai < 2; ++ai)
#pragma unroll
            for (int m = 0; m < 4; ++m) {
                const int row = row0 + ai * 128 + m * 16;
                float sq = 0.f;
#pragma unroll
                for (int bj = 0; bj < 2; ++bj)
#pragma unroll
                    for (int n = 0; n < 2; ++n) {
                        const size_t off = (size_t)row * 1024 + col0 + 32 * bj + 16 * n;
                        const pg8::f32x4 bv = *(const pg8::f32x4*)(base + off);
                        const pg8::f32x4 v = bv + acc[ai][bj][m][n] * scale;
                        *(pg8::f32x4*)(out + off) = v;
                        sq += (v[0] * v[0] + v[1] * v[1]) + (v[2] * v[2] + v[3] * v[3]);
                        u32x2 w; w.x = pk2(v[0], v[1]); w.y = pk2(v[2], v[3]);
                        *(u32x2*)(xb + off) = w;
                    }
                sq += __shfl_xor(sq, 16); sq += __shfl_xor(sq, 32);
                if (fq == 0) ssn[(size_t)row * 16 + u.pn * 4 + wc] = sq;
                if (m == 3) asm volatile("" ::: "memory");
            }
    }
};

struct ColDesc {
    const float* gain;
    int sig;
    bf16_t* db; int ldb, cb;
    float* df_p; float* df_s; int ldf, cf, mode;
};

template <class DescFn> struct EpiGen {
    static constexpr bool PERM = false, AFTER_DRAIN = false;
    const float* ss; DescFn fn;
    __device__ __forceinline__ void operator()(const pg8::f32x4 (&acc)[2][2][4][2], const pg8::Unit& u, int wr, int wc, int fr, int fq) const {
        const ColDesc d = fn(u.pn);
        const int row0 = u.pm * 256 + wr * 64 + fr;
        const int lc0 = wc * 64 + 4 * fq;
        pg8::f32x4 gn[2][2];
        if (d.gain) {
#pragma unroll
            for (int bj = 0; bj < 2; ++bj)
#pragma unroll
                for (int n = 0; n < 2; ++n) gn[bj][n] = *(const pg8::f32x4*)(d.gain + 4 * fq + 32 * bj + 16 * n);
        }
        const bool samp = (u.pm >= 128);
        float rsv[2][4];
#pragma unroll
        for (int ai = 0; ai < 2; ++ai)
#pragma unroll
            for (int m = 0; m < 4; ++m) rsv[ai][m] = row_rstd_q(ss, row0 + ai * 128 + m * 16, fq);
#pragma unroll
        for (int ai = 0; ai < 2; ++ai)
#pragma unroll
            for (int m = 0; m < 4; ++m) {
                const int row = row0 + ai * 128 + m * 16;
                const float rs = rsv[ai][m];
                pg8::f32x4 v[2][2];
                float sq = 0.f;
#pragma unroll
                for (int bj = 0; bj < 2; ++bj)
#pragma unroll
                    for (int n = 0; n < 2; ++n) { v[bj][n] = acc[ai][bj][m][n] * rs; const pg8::f32x4 t = v[bj][n]; sq += (t[0] * t[0] + t[1] * t[1]) + (t[2] * t[2] + t[3] * t[3]); }
                if (d.gain) {
                    sq += __shfl_xor(sq, 16); sq += __shfl_xor(sq, 32);
                    const float hn = rsqrtf(sq * (1.f / 64.f) + EPS_);
#pragma unroll
                    for (int bj = 0; bj < 2; ++bj)
#pragma unroll
                        for (int n = 0; n < 2; ++n) v[bj][n] = v[bj][n] * hn * gn[bj][n];
                }
                if (d.sig) {
#pragma unroll
                    for (int bj = 0; bj < 2; ++bj)
#pragma unroll
                        for (int n = 0; n < 2; ++n)
#pragma unroll
                            for (int i = 0; i < 4; ++i) v[bj][n][i] = __builtin_amdgcn_rcpf(1.f + __expf(-v[bj][n][i]));
                }
                {
                    bf16_t* p = d.db + (size_t)row * d.ldb + d.cb + lc0;
#pragma unroll
                    for (int bj = 0; bj < 2; ++bj)
#pragma unroll
                        for (int n = 0; n < 2; ++n) { u32x2 w; w.x = pk2(v[bj][n][0], v[bj][n][1]); w.y = pk2(v[bj][n][2], v[bj][n][3]); *(u32x2*)(p + 32 * bj + 16 * n) = w; }
                }
                if (d.df_p) {
                    float* p = nullptr;
                    if (!samp) {
                        if (d.mode == 0) p = d.df_p + (size_t)row * d.ldf;
                        else { const int s = row & (S_ - 1), b = row >> 13; if (s >= S_ - 512) p = d.df_p + (size_t)(b * 512 + s - (S_ - 512)) * d.ldf; }
                    } else {
                        const int r2 = row - T_;
                        if (d.mode == 0) p = d.df_s + (size_t)r2 * d.ldf;
                        else p = d.df_s + (size_t)((r2 >> 5) * 512 + 480 + (r2 & 31)) * d.ldf;
                    }
                    if (p) {
                        p += d.cf + lc0;
#pragma unroll
                        for (int bj = 0; bj < 2; ++bj)
#pragma unroll
                            for (int n = 0; n < 2; ++n) __builtin_nontemporal_store(v[bj][n], (pg8::f32x4*)(p + 32 * bj + 16 * n));
                    }
                }
                asm volatile("" ::: "memory");
            }
    }
};

struct EpiMerge {
    static constexpr bool PERM = false, AFTER_DRAIN = false;
    const bf16_t* gate; bf16_t* merged; int first;
    __device__ __forceinline__ void operator()(const pg8::f32x4 (&acc)[2][2][4][2], const pg8::Unit& u, int wr, int wc, int fr, int fq) const {
        const int row0 = u.pm * 256 + wr * 64 + fr;
        const int col0 = u.pn * 256 + wc * 64 + 4 * fq;
#pragma unroll
        for (int ai = 0; ai < 2; ++ai) {
            u32x2 gt[4][2][2], mo[4][2][2];
#pragma unroll
            for (int m = 0; m < 4; ++m)
#pragma unroll
                for (int bj = 0; bj < 2; ++bj)
#pragma unroll
                    for (int n = 0; n < 2; ++n) {
                        const size_t off = (size_t)(row0 + ai * 128 + m * 16) * 1024 + col0 + 32 * bj + 16 * n;
                        gt[m][bj][n] = *(const u32x2*)(gate + off);
                        if (!first) mo[m][bj][n] = *(const u32x2*)(merged + off);
                    }
#pragma unroll
            for (int m = 0; m < 4; ++m)
#pragma unroll
                for (int bj = 0; bj < 2; ++bj)
#pragma unroll
                    for (int n = 0; n < 2; ++n) {
                        const size_t off = (size_t)(row0 + ai * 128 + m * 16) * 1024 + col0 + 32 * bj + 16 * n;
                        const u32x2 g = gt[m][bj][n];
                        float o0 = bf2f(g.x & 0xffffu) * acc[ai][bj][m][n][0], o1 = bf2f(g.x >> 16) * acc[ai][bj][m][n][1];
                        float o2 = bf2f(g.y & 0xffffu) * acc[ai][bj][m][n][2], o3 = bf2f(g.y >> 16) * acc[ai][bj][m][n][3];
                        if (!first) { const u32x2 q = mo[m][bj][n]; o0 += bf2f(q.x & 0xffffu); o1 += bf2f(q.x >> 16); o2 += bf2f(q.y & 0xffffu); o3 += bf2f(q.y >> 16); }
                        u32x2 w; w.x = pk2(o0, o1); w.y = pk2(o2, o3);
                        *(u32x2*)(merged + off) = w;
                    }
            asm volatile("" ::: "memory");
        }
    }
};

__device__ __forceinline__ void p0_transpose_item(const float* W, int ldw, int srccol, const float* gain, bf16_t* dst, int prow, int K, int k0, LAS float* scr, int lane) {
    const int rsub = lane >> 4, c4 = lane & 15;
    const float* src = W + (size_t)(k0 + rsub) * ldw + srccol + 4 * c4;
    f32x4 v[8];
#pragma unroll
    for (int i = 0; i < 8; ++i) v[i] = __builtin_nontemporal_load((const f32x4*)(src + (size_t)(4 * i) * ldw));
    if (gain) {
#pragma unroll
        for (int i = 0; i < 8; ++i) v[i] = v[i] * gain[k0 + 4 * i + rsub];
    }
#pragma unroll
    for (int i = 0; i < 8; ++i) *(LAS f32x4*)(scr + (4 * i + rsub) * 68 + 4 * c4) = v[i];
    asm volatile("s_waitcnt lgkmcnt(0)" ::: "memory");
    bf16_t* drow = dst + (size_t)prow * K + k0;
#pragma unroll
    for (int c = 0; c < 4; ++c) {
        const LAS float* s = scr + (8 * c) * 68 + lane;
        u32x4 o; o.x = pk2(s[0 * 68], s[1 * 68]); o.y = pk2(s[2 * 68], s[3 * 68]); o.z = pk2(s[4 * 68], s[5 * 68]); o.w = pk2(s[6 * 68], s[7 * 68]);
        *(u32x4*)(drow + 8 * c) = o;
    }
    asm volatile("s_waitcnt lgkmcnt(0)" ::: "memory");
}
__device__ __forceinline__ void row_to_bf16(const float* xrow, bf16_t* orow, float* ssp, int lane) {
    const f32x4* xr = (const f32x4*)xrow + lane;
    f32x4 v[4]; float s = 0.f;
#pragma unroll
    for (int j = 0; j < 4; ++j) { v[j] = xr[64 * j]; s += (v[j].x * v[j].x + v[j].y * v[j].y) + (v[j].z * v[j].z + v[j].w * v[j].w); }
    s = wave_sum(s);
    u32x2* o = (u32x2*)orow + lane;
#pragma unroll
    for (int j = 0; j < 4; ++j) { u32x2 w; w.x = pk2(v[j].x, v[j].y); w.y = pk2(v[j].z, v[j].w); o[64 * j] = w; }
    if (lane < 16) ssp[lane] = (lane == 0) ? s : 0.f;
}

constexpr int AT_KT = 0, AT_VT = 17408, AT_BUF = 17408 + 18432  , AT_TAB = 4 * AT_BUF, AT_FLAG = AT_TAB + 1600, AT_END = AT_FLAG + 64;
static_assert(AT_END <= 147200, "attention LDS map");
static_assert(4 * 4 * 16 * 64 * 4 <= AT_TAB, "differential exchange area below the bias table");
constexpr int AT_ACCO = 0, AT_ACCL = 32768, AT_STAB = 34816, AT_SV = 36864;

struct NoPrep { __device__ __forceinline__ void operator()(int) const {} };
template <int NMAP, int VD, class KL, class QL, class VL, class BF, class PREP = NoPrep>
__device__ __forceinline__ void tile_softmax(f32x16 (&O)[NMAP][VD / 32], float (&l)[NMAP], const KL& kl, const QL& ql, const VL& vl, const BF& bf, const PREP& prep = PREP()) {
    static_assert(NMAP == 1, "one map per wave");
    constexpr float C1 = 0.125f * LOG2E;
    f32x16 S[2];
#pragma unroll
    for (int kb = 0; kb < 2; ++kb) {
#pragma unroll
        for (int i = 0; i < 16; ++i) S[kb][i] = 0.f;
#pragma unroll
        for (int s = 0; s < 4; ++s) S[kb] = __builtin_amdgcn_mfma_f32_32x32x16_bf16(kl(kb, 0, s), ql(0, s), S[kb], 0, 0, 0);
    }
#pragma unroll
    for (int kb = 0; kb < 2; ++kb) {
        float ls = 0.f; unsigned pw[8];
#pragma unroll
        for (int r2 = 0; r2 < 16; r2 += 2) {
            const float p0 = __builtin_amdgcn_exp2f(S[kb][r2] * C1 + bf(kb, r2)), p1 = __builtin_amdgcn_exp2f(S[kb][r2 + 1] * C1 + bf(kb, r2 + 1));
            ls += p0 + p1; pw[r2 >> 1] = pk2(p0, p1);
        }
        l[0] += ls;
        u32x4 t0 = {pw[0], pw[1], pw[2], pw[3]}, t1 = {pw[4], pw[5], pw[6], pw[7]};
        const bf16x8 pf0 = __builtin_bit_cast(bf16x8, t0), pf1 = __builtin_bit_cast(bf16x8, t1);
        prep(kb);
#pragma unroll
        for (int db = 0; db < VD / 32; ++db) {
            O[0][db] = __builtin_amdgcn_mfma_f32_32x32x16_bf16(vl(db, kb, 0), pf0, O[0][db], 0, 0, 0);
            O[0][db] = __builtin_amdgcn_mfma_f32_32x32x16_bf16(vl(db, kb, 1), pf1, O[0][db], 0, 0, 0);
        }
    }
}

template <class KL, class QL, class VL, class MK>
__device__ __forceinline__ void tile_stick(f32x16 (&O)[2], float& R, int hh, const KL& kl, const QL& ql, const VL& vl, const MK& valid) {
#pragma unroll
    for (int kb = 1; kb >= 0; --kb) {
        f32x16 S;
#pragma unroll
        for (int i = 0; i < 16; ++i) S[i] = 0.f;
#pragma unroll
        for (int s = 0; s < 4; ++s) S = __builtin_amdgcn_mfma_f32_32x32x16_bf16(kl(kb, 0, s), ql(0, s), S, 0, 0, 0);
        float sg[16], f[16];
#pragma unroll
        for (int i = 0; i < 16; ++i) {
            float z = S[i] * 0.125f; z = fminf(fmaxf(z, -60.f), 60.f);
            const float e = __builtin_amdgcn_exp2f(-z * LOG2E);
            float s_ = __builtin_amdgcn_rcpf(1.f + e), ff = e * s_;
            if (!valid(kb, i)) { s_ = 0.f; ff = 1.f; }
            sg[i] = s_; f[i] = ff;
        }
        float F[4], Fp[4], Tg[4];
#pragma unroll
        for (int g = 0; g < 4; ++g) { F[g] = (f[4 * g] * f[4 * g + 1]) * (f[4 * g + 2] * f[4 * g + 3]); Fp[g] = __shfl_xor(F[g], 32); Tg[g] = F[g] * Fp[g]; }
        float E[4]; E[3] = 1.f; E[2] = Tg[3]; E[1] = Tg[3] * Tg[2]; E[0] = E[1] * Tg[1];
        unsigned pw[8];
#pragma unroll
        for (int g = 0; g < 4; ++g) {
            float t = R * E[g] * (hh == 0 ? Fp[g] : 1.f);
            const float w3 = sg[4 * g + 3] * t; t *= f[4 * g + 3];
            const float w2 = sg[4 * g + 2] * t; t *= f[4 * g + 2];
            const float w1 = sg[4 * g + 1] * t; t *= f[4 * g + 1];
            const float w0 = sg[4 * g] * t;
            pw[2 * g] = pk2(w0, w1); pw[2 * g + 1] = pk2(w2, w3);
        }
        R *= E[0] * Tg[0];
        u32x4 t0 = {pw[0], pw[1], pw[2], pw[3]}, t1 = {pw[4], pw[5], pw[6], pw[7]};
        const bf16x8 pf0 = __builtin_bit_cast(bf16x8, t0), pf1 = __builtin_bit_cast(bf16x8, t1);
#pragma unroll
        for (int db = 0; db < 2; ++db) {
            O[db] = __builtin_amdgcn_mfma_f32_32x32x16_bf16(vl(db, kb, 0), pf0, O[db], 0, 0, 0);
            O[db] = __builtin_amdgcn_mfma_f32_32x32x16_bf16(vl(db, kb, 1), pf1, O[db], 0, 0, 0);
        }
    }
}

template <int MODE, int NMAP, int VD>
__device__ __forceinline__ void finish_store(f32x16 (&O)[NMAP][VD / 32], float (&l)[NMAP], bf16_t* orowp, int hh, float lam, const float* subln, float oscale) {
    float inv[NMAP];
    if (MODE != 3) {
#pragma unroll
        for (int mp = 0; mp < NMAP; ++mp) { l[mp] += __shfl_xor(l[mp], 32); inv[mp] = 1.f / l[mp]; }
    }
    if constexpr (MODE == 0) {
        float sq = 0.f;
#pragma unroll
        for (int db = 0; db < 4; ++db)
#pragma unroll
            for (int i = 0; i < 16; ++i) { const float o = O[0][db][i] * inv[0] - lam * (O[1][db][i] * inv[1]); O[0][db][i] = o; sq += o * o; }
        sq += __shfl_xor(sq, 32);
        const float rsn = rsqrtf(sq * (1.f / 128.f) + EPS_) * oscale;
#pragma unroll
        for (int db = 0; db < 4; ++db)
#pragma unroll
            for (int g = 0; g < 4; ++g) {
                const int d0 = 32 * db + 8 * g + 4 * hh;
                const f32x4 gn = *(const f32x4*)(subln + d0);
                u32x2 wv; wv.x = pk2(O[0][db][4 * g] * rsn * gn[0], O[0][db][4 * g + 1] * rsn * gn[1]); wv.y = pk2(O[0][db][4 * g + 2] * rsn * gn[2], O[0][db][4 * g + 3] * rsn * gn[3]);
                *(u32x2*)(orowp + d0) = wv;
            }
    } else {
        const float sc = (MODE == 3) ? 1.f : inv[0];
#pragma unroll
        for (int db = 0; db < VD / 32; ++db)
#pragma unroll
            for (int g = 0; g < 4; ++g) {
                const int d0 = 32 * db + 8 * g + 4 * hh;
                u32x2 wv; wv.x = pk2(O[0][db][4 * g] * sc, O[0][db][4 * g + 1] * sc); wv.y = pk2(O[0][db][4 * g + 2] * sc, O[0][db][4 * g + 3] * sc);
                *(u32x2*)(orowp + d0) = wv;
            }
    }
}

__device__ __forceinline__ int t5_bucket_dev(int rel) {
    const int n = rel < 0 ? -rel : rel;
    int v;
    if (n < 8) v = n; else { const int k = 31 - __clz(n * n) - 6; v = 8 + k; if (v > 15) v = 15; }
    return (rel > 0 ? 16 : 0) + v;
}
__device__ __forceinline__ float lambda_init_dev(int layer) { return 0.8f - 0.6f * expf(-0.3f * (float)layer); }

template <int MODE>
__device__ __forceinline__ float attn_setup_bias(const Args& a, int layer, int h, LAS float* tab, int tid, int lane) {
    const float* gq = MODE == 0 ? a.in[18] : (MODE == 1 ? a.in[25] : a.in[36]);
    const float* gk = MODE == 0 ? a.in[19] : (MODE == 1 ? a.in[26] : a.in[37]);
    const float mq = wave_max(fabsf(gq[layer * 64 + lane])), mk = wave_max(fabsf(gk[layer * 64 + lane]));
    float mb = 0.f;
    const float* t5 = a.in[11];
    const float* relb = a.in[27] + (size_t)(layer * 4 + h) * 257;
    if (MODE == 0) mb = wave_max(lane < 32 ? fabsf(t5[lane * 4 + h]) : 0.f);
    if (MODE == 1) { float m = 0.f; for (int i = lane; i < 257; i += 64) m = fmaxf(m, fabsf(relb[i])); mb = wave_max(m); }
    const float shift = 8.f * mq * mk + mb;
    if (MODE == 0 || MODE == 1) {
        for (int t = tid; t < 384; t += 512) {
            int rel = t - 64 - 255; if (t < 64) rel = -255; float v;
            if (MODE == 0) v = t5[t5_bucket_dev(rel) * 4 + h];
            else { int c = rel < -128 ? -128 : (rel > 128 ? 128 : rel); v = relb[c + 128]; }
            tab[t] = (v - shift) * LOG2E;
        }
    }
    if (MODE == 0) return (t5[15 * 4 + h] - shift) * LOG2E;
    if (MODE == 1) return (relb[0] - shift) * LOG2E;
    return -shift * LOG2E;
}

template <int MODE>
__device__ __forceinline__ void attn_prompt_unit(LAS unsigned char* lds, const Args& a, int layer, int bh, int qb) {
    constexpr int KD = MODE == 0 ? 128 : 64, VD = MODE == 0 ? 128 : 64, KP = KD * 2 + 16, VP2 = VD * 2 + 16, QP = 144, NKC = KD / 64, NVC = VD / 64, UROWS = MODE == 0 ? 128 : 256;
    int tid_l = threadIdx.x; asm volatile("" : "+v"(tid_l));
    const int tid = tid_l, lane = tid & 63, w = __builtin_amdgcn_readfirstlane(tid >> 6), r = lane & 31, hh = lane >> 5;
    const int qg = MODE == 0 ? (w >> 1) : w, mpw = MODE == 0 ? (w & 1) : 0;
    const int b = bh >> 2, h = bh & 3;
    unsigned char* Rg = a.ws + WS_R;
    bf16_t* Q; const bf16_t* K; const bf16_t* V; int ld; int hoff; size_t keyrow0;
    if (MODE == 0) { Q = (bf16_t*)(Rg + R_QA); K = (const bf16_t*)(Rg + R_KA); V = (const bf16_t*)(Rg + R_VA); ld = 512; hoff = h * 128; keyrow0 = (size_t)b * S_; }
    else if (MODE == 1) { Q = (bf16_t*)(Rg + R_QC); K = (const bf16_t*)(Rg + R_KC); V = (const bf16_t*)(Rg + R_VC); ld = 256; hoff = h * 64; keyrow0 = (size_t)b * S_; }
    else if (MODE == 3) { Q = (bf16_t*)(Rg + R_QB); K = (const bf16_t*)(Rg + R_KB); V = (const bf16_t*)(Rg + R_VB); ld = 256; hoff = h * 64; keyrow0 = (size_t)b * S_; }
    else { Q = (bf16_t*)(Rg + R_QX); K = (const bf16_t*)(a.ws + WS_MKB) + (size_t)layer * 262144; V = (const bf16_t*)(a.ws + WS_MVB) + (size_t)layer * 262144; ld = 256; hoff = h * 64; keyrow0 = (size_t)b * 256; }
    const int q0 = UROWS * qb + 32 * qg;
    const size_t qrow0 = (size_t)b * S_ + q0;
    const int cw = q0 >> 6;
    int jlo, jhi, wlo, whi;
    if (MODE == 0 || MODE == 3) { jlo = 0; jhi = ((UROWS * qb + UROWS - 1) >> 6); wlo = 0; whi = cw; }
    else if (MODE == 1) { const int c0 = (UROWS * qb) >> 6; wlo = cw - 8 < 0 ? 0 : cw - 8; whi = cw; jlo = c0 - 8 < 0 ? 0 : c0 - 8; jhi = c0 + 3; }
    else { jlo = 0; jhi = 3; wlo = 0; whi = 3; }

    LAS float* tab = (LAS float*)(lds + AT_TAB); volatile LAS int* flags = (volatile LAS int*)(lds + AT_FLAG);

    __syncthreads();
    float farc = 0.f;
    if (MODE != 3) farc = attn_setup_bias<MODE>(a, layer, h, tab, tid, lane);
    bf16x8 qf[4];
#pragma unroll
    for (int s = 0; s < 4; ++s) qf[s] = *(const bf16x8*)(Q + (qrow0 + r) * ld + hoff + mpw * 64 + 16 * s + 8 * hh);
    float lam = 0.f;
    if (MODE == 0) {
        const float s1 = wave_sum(a.in[20][layer * 64 + lane] * a.in[21][layer * 64 + lane]);
        const float s2 = wave_sum(a.in[22][layer * 64 + lane] * a.in[23][layer * 64 + lane]);
        lam = expf(s1) - expf(s2) + lambda_init_dev(layer);
    }

    f32x16 O[1][VD / 32]; float l[1] = {0.f};
#pragma unroll
    for (int db = 0; db < VD / 32; ++db)
#pragma unroll
        for (int i = 0; i < 16; ++i) O[0][db][i] = 0.f;
    float Rp = 1.f; bool done = false;

    u32x4 kreg[NKC], vreg[NVC];
    auto prefetch = [&](int j) {
#pragma unroll
        for (int i = 0; i < NKC; ++i) { const int c = tid + 512 * i, key = c / (KD / 8), part = c % (KD / 8);
            kreg[i] = *(const u32x4*)(K + (keyrow0 + 64 * j + key) * ld + hoff + part * 8); }
#pragma unroll
        for (int i = 0; i < NVC; ++i) { const int c = tid + 512 * i, key = c / (VD / 8), part = c % (VD / 8);
            vreg[i] = *(const u32x4*)(V + (keyrow0 + 64 * j + key) * ld + hoff + part * 8); }
    };
    auto stage = [&](int slot) {
        LAS unsigned char* KT = lds + AT_KT + slot * AT_BUF; LAS unsigned char* VT = lds + AT_VT + slot * AT_BUF;
#pragma unroll
        for (int i = 0; i < NKC; ++i) { const int c = tid + 512 * i, key = c / (KD / 8), part = c % (KD / 8);
            *(LAS u32x4*)(KT + key * KP + part * 16) = kreg[i]; }
#pragma unroll
        for (int i = 0; i < NVC; ++i) { const int c = tid + 512 * i, key = c / (VD / 8), part = c % (VD / 8);
            *(LAS u32x4*)(VT + key * VP2 + part * 16) = vreg[i]; }
    };
    auto ql = [&](int, int s) -> bf16x8 { return qf[s]; };
    constexpr int DIR = (MODE == 3) ? -1 : 1;
    auto compute = [&](auto SLOTC, int j) {
        constexpr int SLOT = decltype(SLOTC)::value;
        const LAS unsigned char* KTb = lds + AT_KT + SLOT * AT_BUF; const LAS unsigned char* VTb = lds + AT_VT + SLOT * AT_BUF;
        auto kl = [&](int kb, int, int s) -> bf16x8 { return *(const LAS bf16x8*)(KTb + (32 * kb + r) * KP + mpw * 128 + (16 * s + 8 * hh) * 2); };
        auto vl = [&](int db, int kb, int s2) -> bf16x8 {
            const LAS unsigned char* p = VTb + (32 * kb + 16 * s2 + 4 * hh + ((lane & 15) >> 2)) * VP2 + (32 * db + 16 * ((lane >> 4) & 1) + 4 * (lane & 3)) * 2;
            const s16x4 lo = __builtin_amdgcn_ds_read_tr16_b64_v4i16((LAS s16x4*)p), hi = __builtin_amdgcn_ds_read_tr16_b64_v4i16((LAS s16x4*)(p + 8 * VP2));
            bf16x8 t = {lo[0], lo[1], lo[2], lo[3], hi[0], hi[1], hi[2], hi[3]}; return t; };
        if constexpr (MODE != 3) {
            if (j >= wlo && j <= whi) {
                const int maxrel = 64 * j + 63 - q0;
                float bv[2][16];
                if (MODE == 2 || maxrel <= -128) {
#pragma unroll
                    for (int kb = 0; kb < 2; ++kb)
#pragma unroll
                        for (int i = 0; i < 16; ++i) bv[kb][i] = farc;
                } else {
                    const int bidx = 64 + 64 * j + 4 * hh - q0 - r + 255;
#pragma unroll
                    for (int kb = 0; kb < 2; ++kb)
#pragma unroll
                        for (int i = 0; i < 16; ++i) bv[kb][i] = tab[bidx + 32 * kb + (i & 3) + 8 * (i >> 2)];
                }
                auto bf = [&](int kb, int i) -> float { return bv[kb][i]; };
                tile_softmax<1, VD>(O, l, kl, ql, vl, bf);
            }
        } else {
            if (j <= whi && !done) {
                const int kbase = 64 * j + 4 * hh, qpos = (j == whi) ? q0 + r : 0x7fffffff;
                auto valid = [&](int kb, int i) -> bool { return (kbase + 32 * kb + (i & 3) + 8 * (i >> 2)) < qpos; };
                tile_stick(O[0], Rp, hh, kl, ql, vl, valid);
                done = (__ballot(Rp != 0.f) == 0ull) || (j == 0);
            }
        }
    };
    auto step = [&](auto BUFC, int j, bool more) {
        constexpr int BUF = decltype(BUFC)::value;
        if (more) prefetch(j + 2 * DIR);
        compute(std::integral_constant<int, 2 * BUF>{}, j);
        if (more) { stage(2 * (BUF ^ 1)); prefetch(j + 3 * DIR); }
        compute(std::integral_constant<int, 2 * BUF + 1>{}, j + DIR);
        if (more) stage(2 * (BUF ^ 1) + 1);
        if (MODE == 3) { if (lane == 0) flags[BUF * 8 + w] = done ? 1 : 0; }
        __syncthreads();
    };
    {
        const int jfirst = (MODE == 3) ? jhi : jlo, jlast = (MODE == 3) ? 0 : jhi;
        prefetch(jfirst); stage(0); prefetch(jfirst + DIR); stage(1); __syncthreads();
        for (int j = jfirst; ; j += 4 * DIR) {
            const bool more0 = (MODE == 3) ? (j - 2 >= 0) : (j + 2 <= jlast);
            step(std::integral_constant<int, 0>{}, j, more0);
            if (MODE == 3) { int alld = 1;
#pragma unroll
                for (int i = 0; i < 8; ++i) alld &= flags[i];
                if (alld) break; }
            if (!more0) break;
            const int j2 = j + 2 * DIR;
            const bool more1 = (MODE == 3) ? (j2 - 2 >= 0) : (j2 + 2 <= jlast);
            step(std::integral_constant<int, 1>{}, j2, more1);
            if (MODE == 3) { int alld = 1;
#pragma unroll
                for (int i = 0; i < 8; ++i) alld &= flags[8 + i];
                if (alld) break; }
            if (!more1) break;
        }
    }
    bf16_t* orowp = Q + (qrow0 + r) * ld + hoff;
    if constexpr (MODE == 0) {
        l[0] += __shfl_xor(l[0], 32);
        const float inv = 1.f / l[0];
        LAS float* ex = (LAS float*)lds + qg * (4 * 16 * 64);
        if (mpw == 1) {
            const float sc = inv * lam;
#pragma unroll
            for (int db = 0; db < 4; ++db)
#pragma unroll
                for (int i = 0; i < 16; ++i) ex[(db * 16 + i) * 64 + lane] = O[0][db][i] * sc;
        }
        __syncthreads();
        if (mpw == 0) {
            float sq = 0.f;
#pragma unroll
            for (int db = 0; db < 4; ++db)
#pragma unroll
                for (int i = 0; i < 16; ++i) { const float o = O[0][db][i] * inv - ex[(db * 16 + i) * 64 + lane]; O[0][db][i] = o; sq += o * o; }
            sq += __shfl_xor(sq, 32);
            const float rsn = rsqrtf(sq * (1.f / 128.f) + EPS_) * (1.f - lambda_init_dev(layer));
            const float* subln = a.in[24] + layer * 128;
#pragma unroll
            for (int db = 0; db < 4; ++db)
#pragma unroll
                for (int g = 0; g < 4; ++g) {
                    const int d0 = 32 * db + 8 * g + 4 * hh;
                    const f32x4 gn = *(const f32x4*)(subln + d0);
                    u32x2 wv; wv.x = pk2(O[0][db][4 * g] * rsn * gn[0], O[0][db][4 * g + 1] * rsn * gn[1]); wv.y = pk2(O[0][db][4 * g + 2] * rsn * gn[2], O[0][db][4 * g + 3] * rsn * gn[3]);
                    *(u32x2*)(orowp + d0) = wv;
                }
        }
    } else {
        finish_store<MODE, 1, VD>(O, l, orowp, hh, lam, nullptr, 1.f);
    }
}

template <int MODE>
__device__ __forceinline__ void attn_sample_unit(LAS unsigned char* lds, const Args& a, int layer, int b, int h) {
    constexpr int NMAP = MODE == 0 ? 2 : 1, KD = 64 * NMAP, VD = MODE == 0 ? 128 : 64;
    int tid_l = threadIdx.x; asm volatile("" : "+v"(tid_l));
    const int tid = tid_l, lane = tid & 63, w = __builtin_amdgcn_readfirstlane(tid >> 6), r = lane & 31, hh = lane >> 5;
    const float *kc, *kn, *vc, *vn; int ldk, ncache, nkeys, kpos0; const bf16_t* Q; int ldq;
    const size_t lb = (size_t)(layer * 8 + b);
    if (MODE == 0) { kc = a.in[3] + lb * 1024 * 512 + h * 128; vc = a.in[4] + lb * 1024 * 512 + h * 128; kn = a.out + O_AKS + lb * 32 * 512 + h * 128; vn = a.out + O_AVS + lb * 32 * 512 + h * 128;
        ldk = 512; ncache = 1024; nkeys = 1056; kpos0 = 0; Q = (const bf16_t*)(a.ws + WS_R + R_QA); ldq = 512; }
    else if (MODE == 1) { kc = a.in[7] + lb * 512 * 256 + h * 64; vc = a.in[8] + lb * 512 * 256 + h * 64; kn = a.out + O_CKS + (lb * 512 + 480) * 256 + h * 64; vn = a.out + O_CVS + (lb * 512 + 480) * 256 + h * 64;
        ldk = 256; ncache = 512; nkeys = 544; kpos0 = 512; Q = (const bf16_t*)(a.ws + WS_R + R_QC); ldq = 256; }
    else { kc = a.in[9] + lb * 256 * 256 + h * 64; vc = a.in[10] + lb * 256 * 256 + h * 64; kn = kc; vn = vc; ldk = 256; ncache = 256; nkeys = 256; kpos0 = 0; Q = (const bf16_t*)(a.ws + WS_R + R_QX); ldq = 256; }
    const size_t qrow = (size_t)T_ + b * 32 + r;
    LAS float* accO = (LAS float*)(lds + AT_ACCO); LAS float* accL = (LAS float*)(lds + AT_ACCL); LAS float* tab = (LAS float*)(lds + AT_STAB);
    __syncthreads();
    for (int i = tid; i < NMAP * (VD / 32) * 16 * 64; i += 512) accO[i] = 0.f;
    if (tid < NMAP * 64) accL[tid] = 0.f;
    const float farc = attn_setup_bias<MODE>(a, layer, h, tab, tid, lane);
    float lam = 0.f;
    if (MODE == 0) {
        const float s1 = wave_sum(a.in[20][layer * 64 + lane] * a.in[21][layer * 64 + lane]);
        const float s2 = wave_sum(a.in[22][layer * 64 + lane] * a.in[23][layer * 64 + lane]);
        lam = expf(s1) - expf(s2) + lambda_init_dev(layer);
    }
    const bf16_t* qptr = Q + qrow * ldq + h * KD + 8 * hh;
    __syncthreads();
    f32x16 Ow[1][VD / 32]; float lw[1] = {0.f};
#pragma unroll
    for (int db = 0; db < VD / 32; ++db)
#pragma unroll
        for (int i = 0; i < 16; ++i) Ow[0][db][i] = 0.f;
    const int ntiles = (nkeys + 63) / 64;
    const int mpw = (NMAP == 2) ? (w >> 2) : 0, jstep = (NMAP == 2) ? 4 : 8, jstart = (NMAP == 2) ? (w & 3) : w;
    for (int j = jstart; j < ntiles; j += jstep) {
        asm volatile("" ::: "memory");
        auto krow = [&](int p) -> const float* { p = p < nkeys ? p : nkeys - 1; return p < ncache ? kc + (size_t)p * ldk : kn + (size_t)(p - ncache) * ldk; };
        auto vrow = [&](int p) -> const float* { p = p < nkeys ? p : nkeys - 1; return p < ncache ? vc + (size_t)p * ldk : vn + (size_t)(p - ncache) * ldk; };
        auto kl = [&](int kb, int, int s) -> bf16x8 {
            const float* p = krow(64 * j + 32 * kb + r) + mpw * 64 + 16 * s + 8 * hh;
            const f32x4 x = *(const f32x4*)p, y = *(const f32x4*)(p + 4);
            u32x4 t = {pk2(x[0], x[1]), pk2(x[2], x[3]), pk2(y[0], y[1]), pk2(y[2], y[3])}; return __builtin_bit_cast(bf16x8, t); };
        auto ql = [&](int, int s) -> bf16x8 { return *(const bf16x8*)(qptr + mpw * 64 + 16 * s); };
        constexpr int VP2 = VD * 2 + 16, KPI = 256 / VD;
        LAS unsigned char* VTw = lds + AT_SV + w * (32 * VP2);
        auto vprep = [&](int kb) {
            f32x4 x[32 / KPI];
#pragma unroll
            for (int i = 0; i < 32 / KPI; ++i) x[i] = *(const f32x4*)(vrow(64 * j + 32 * kb + KPI * i + lane / (VD / 4)) + 4 * (lane % (VD / 4)));
#pragma unroll
            for (int i = 0; i < 32 / KPI; ++i) { u32x2 t; t.x = pk2(x[i][0], x[i][1]); t.y = pk2(x[i][2], x[i][3]);
                *(LAS u32x2*)(VTw + (KPI * i + lane / (VD / 4)) * VP2 + 8 * (lane % (VD / 4))) = t; }
        };
        auto vl = [&](int db, int, int s2) -> bf16x8 {
            const LAS unsigned char* p2 = VTw + (16 * s2 + 4 * hh + ((lane & 15) >> 2)) * VP2 + (32 * db + 16 * ((lane >> 4) & 1) + 4 * (lane & 3)) * 2;
            const s16x4 lo = __builtin_amdgcn_ds_read_tr16_b64_v4i16((LAS s16x4*)p2), hi = __builtin_amdgcn_ds_read_tr16_b64_v4i16((LAS s16x4*)(p2 + 8 * VP2));
            bf16x8 t = {lo[0], lo[1], lo[2], lo[3], hi[0], hi[1], hi[2], hi[3]}; return t; };
        const int pbase = 64 * j + 4 * hh;
        const int maxrel = kpos0 + 64 * j + 63 - 1024;
        const int bidx = (maxrel <= -128) ? 0 : 64 + kpos0 + pbase - 1024 - r + 255;
        auto bf = [&](int kb, int i) -> float { const int o = 32 * kb + (i & 3) + 8 * (i >> 2); const float t = (MODE == 2) ? farc : tab[bidx + o]; return (pbase + o) < nkeys ? t : -INFINITY; };
        tile_softmax<1, VD>(Ow, lw, kl, ql, vl, bf, vprep);
    }
#pragma unroll
    for (int db = 0; db < VD / 32; ++db)
#pragma unroll
        for (int i = 0; i < 16; ++i) __builtin_amdgcn_ds_faddf(&accO[((mpw * (VD / 32) + db) * 16 + i) * 64 + lane], Ow[0][db][i], 0, 0, false);
    __builtin_amdgcn_ds_faddf(&accL[mpw * 64 + lane], lw[0], 0, 0, false);
    __syncthreads();
    if (w == 0) {
        f32x16 O[NMAP][VD / 32]; float l[NMAP];
#pragma unroll
        for (int mp = 0; mp < NMAP; ++mp) {
#pragma unroll
            for (int db = 0; db < VD / 32; ++db)
#pragma unroll
                for (int i = 0; i < 16; ++i) O[mp][db][i] = accO[((mp * (VD / 32) + db) * 16 + i) * 64 + lane];
            l[mp] = accL[mp * 64 + lane];
        }
        bf16_t* orowp = (bf16_t*)Q + qrow * ldq + h * (MODE == 0 ? 128 : 64);
        finish_store<MODE, NMAP, VD>(O, l, orowp, hh, lam, a.in[24] + layer * 128, 1.f - lambda_init_dev(layer));
    }
}

__device__ __forceinline__ void attn_stick_sample(const Args& a, int layer, int unit) {
    int tid_l = threadIdx.x; asm volatile("" : "+v"(tid_l));
    const int lane = tid_l & 63, r = lane & 31, hh = lane >> 5;
    const int b = unit >> 2, h = unit & 3;
    const size_t lb = (size_t)(layer * 8 + b);
    const float* kc = a.in[5] + lb * 1024 * 256 + h * 64; const float* vc = a.in[6] + lb * 1024 * 256 + h * 64;
    const float* kn = a.out + O_BKS + lb * 32 * 256 + h * 64; const float* vn = a.out + O_BVS + lb * 32 * 256 + h * 64;
    constexpr int ldk = 256, ncache = 1024, nkeys = 1056;
    bf16_t* Q = (bf16_t*)(a.ws + WS_R + R_QB);
    const size_t qrow = (size_t)T_ + b * 32 + r;
    bf16x8 qf[4];
#pragma unroll
    for (int s = 0; s < 4; ++s) qf[s] = *(const bf16x8*)(Q + qrow * 256 + h * 64 + 16 * s + 8 * hh);
    f32x16 O[1][2];
#pragma unroll
    for (int db = 0; db < 2; ++db)
#pragma unroll
        for (int i = 0; i < 16; ++i) O[0][db][i] = 0.f;
    float Rp = 1.f;
    for (int j = 16; j >= 0; --j) {
        auto krow = [&](int p) -> const float* { p = p < nkeys ? p : nkeys - 1; return p < ncache ? kc + (size_t)p * ldk : kn + (size_t)(p - ncache) * ldk; };
        auto vrow = [&](int p) -> const float* { p = p < nkeys ? p : nkeys - 1; return p < ncache ? vc + (size_t)p * ldk : vn + (size_t)(p - ncache) * ldk; };
        auto kl = [&](int kb, int, int s) -> bf16x8 {
            const float* p = krow(64 * j + 32 * kb + r) + 16 * s + 8 * hh;
            const f32x4 x = *(const f32x4*)p, y = *(const f32x4*)(p + 4);
            u32x4 t = {pk2(x[0], x[1]), pk2(x[2], x[3]), pk2(y[0], y[1]), pk2(y[2], y[3])}; return __builtin_bit_cast(bf16x8, t); };
        auto ql = [&](int, int s) -> bf16x8 { return qf[s]; };
        auto vl = [&](int db, int kb, int s2) -> bf16x8 {
            float x[8];
#pragma unroll
            for (int jx = 0; jx < 8; ++jx) x[jx] = vrow(64 * j + 32 * kb + 16 * s2 + 8 * (jx >> 2) + 4 * hh + (jx & 3))[32 * db + r];
            u32x4 t = {pk2(x[0], x[1]), pk2(x[2], x[3]), pk2(x[4], x[5]), pk2(x[6], x[7])}; return __builtin_bit_cast(bf16x8, t); };
        const int pbase = 64 * j + 4 * hh, qpos = 1024 + r;
        auto valid = [&](int kb, int i) -> bool { const int p = pbase + 32 * kb + (i & 3) + 8 * (i >> 2); return p < nkeys && p < qpos; };
        tile_stick(O[0], Rp, hh, kl, ql, vl, valid);
        if (__ballot(Rp != 0.f) == 0ull) break;
    }
    float l[1] = {1.f};
    finish_store<3, 1, 64>(O, l, Q + qrow * 256 + h * 64, hh, 0.f, nullptr, 1.f);
}

#ifndef PROBE_K
#define PROBE_K -1
#endif
#ifndef SKIP_ATTN
#define SKIP_ATTN 0
#endif
#ifndef SKIP_MERGE
#define SKIP_MERGE 0
#endif
#ifndef SKIP_GATE
#define SKIP_GATE 0
#endif
#ifndef P7_PLANE
#define P7_PLANE 0
#endif
#ifndef GATE_SIG
#define GATE_SIG 1
#endif
#ifndef STOP_AFTER
#define STOP_AFTER 99
#endif

struct DescQKV {
    unsigned char* R; float* out; const float* aqn; const float* akn; const float* cqn; const float* ckn; int layer;
    __device__ __forceinline__ ColDesc operator()(int pn) const {
        ColDesc d; d.gain = nullptr; d.sig = 0; d.db = nullptr; d.ldb = 256; d.cb = 0; d.df_p = nullptr; d.df_s = nullptr; d.ldf = 256; d.cf = 0; d.mode = 0;
        const size_t L = (size_t)layer;
        if (pn < 2) { d.gain = aqn; d.db = (bf16_t*)(R + R_QA); d.ldb = 512; d.cb = pn * 256; }
        else if (pn < 4) { d.gain = akn; d.db = (bf16_t*)(R + R_KA); d.ldb = 512; d.cb = (pn - 2) * 256; d.df_p = out + O_AKP + L * T_ * 512; d.df_s = out + O_AKS + L * MS_ * 512; d.ldf = 512; d.cf = (pn - 2) * 256; }
        else if (pn < 6) { d.db = (bf16_t*)(R + R_VA); d.ldb = 512; d.cb = (pn - 4) * 256; d.df_p = out + O_AVP + L * T_ * 512; d.df_s = out + O_AVS + L * MS_ * 512; d.ldf = 512; d.cf = (pn - 4) * 256; }
        else if (pn == 6) { d.db = (bf16_t*)(R + R_QB); }
        else if (pn == 7) { d.db = (bf16_t*)(R + R_KB); d.df_p = out + O_BKP + L * T_ * 256; d.df_s = out + O_BKS + L * MS_ * 256; }
        else if (pn == 8) { d.db = (bf16_t*)(R + R_VB); d.df_p = out + O_BVP + L * T_ * 256; d.df_s = out + O_BVS + L * MS_ * 256; }
        else if (pn == 9) { d.gain = cqn; d.db = (bf16_t*)(R + R_QC); }
        else if (pn == 10) { d.gain = ckn; d.db = (bf16_t*)(R + R_KC); d.df_p = out + O_CKP + L * 4 * 512 * 256; d.df_s = out + O_CKS + L * 8 * 512 * 256; d.mode = 1; }
        else { d.db = (bf16_t*)(R + R_VC); d.df_p = out + O_CVP + L * 4 * 512 * 256; d.df_s = out + O_CVS + L * 8 * 512 * 256; d.mode = 1; }
        return d;
    }
};
struct DescGate {
    unsigned char* R;
    __device__ __forceinline__ ColDesc operator()(int pn) const {
        ColDesc d; d.gain = nullptr; d.sig = GATE_SIG; d.db = (bf16_t*)(R + R_G + (size_t)(pn >> 2) * R_GPLANE); d.ldb = 1024; d.cb = (pn & 3) * 256; d.df_p = nullptr; d.df_s = nullptr; d.ldf = 0; d.cf = 0; d.mode = 0;
        return d;
    }
};
struct DescWq {
    unsigned char* R; const float* qn;
    __device__ __forceinline__ ColDesc operator()(int) const {
        ColDesc d; d.gain = qn; d.sig = 0; d.db = (bf16_t*)(R + R_QX); d.ldb = 256; d.cb = 0; d.df_p = nullptr; d.df_s = nullptr; d.ldf = 0; d.cf = 0; d.mode = 0;
        return d;
    }
};
struct DescMemKV {
    unsigned char* ws; float* out; const float* kn; int layer;
    __device__ __forceinline__ ColDesc operator()(int pn) const {
        ColDesc d; d.sig = 0; d.ldb = 256; d.cb = 0; d.ldf = 256; d.cf = 0; d.mode = 0; d.df_s = nullptr;
        if (pn == 0) { d.gain = kn; d.db = (bf16_t*)(ws + WS_MKB) + (size_t)layer * 262144; d.df_p = out + O_MKP + (size_t)layer * 262144; }
        else { d.gain = nullptr; d.db = (bf16_t*)(ws + WS_MVB) + (size_t)layer * 262144; d.df_p = out + O_MVP + (size_t)layer * 262144; }
        return d;
    }
};


__device__ __forceinline__ void sample_res_gemm(LAS unsigned char* lds, const bf16_t* A, const bf16_t* Bt, int K, float scale, const float* base, float* out, bf16_t* xb, float* ssn, int bx) {
    if (bx >= 128) return;
    int tid_l = threadIdx.x; asm volatile("" : "+v"(tid_l));
    const int tid = tid_l, lane = tid & 63, w = __builtin_amdgcn_readfirstlane(tid >> 6), r = lane & 31, hh = lane >> 5;
    const int rm = bx >> 4, cn = bx & 15, row0 = T_ + 32 * rm;
    const bf16_t* b0 = Bt + (size_t)(256 * (cn >> 2) + 32 * (cn & 3) + r) * K;
    const bf16_t* b1 = b0 + (size_t)128 * K;
    const bf16_t* ap = A + (size_t)(row0 + r) * K;
    const int kw = K >> 3, k0 = w * kw + 8 * hh;
    f32x16 c0, c1;
#pragma unroll
    for (int i = 0; i < 16; ++i) { c0[i] = 0.f; c1[i] = 0.f; }
#pragma unroll 4
    for (int s = 0; s < kw; s += 16) {
        const bf16x8 af = *(const bf16x8*)(ap + k0 + s), f0 = *(const bf16x8*)(b0 + k0 + s), f1 = *(const bf16x8*)(b1 + k0 + s);
        c0 = __builtin_amdgcn_mfma_f32_32x32x16_bf16(af, f0, c0, 0, 0, 0);
        c1 = __builtin_amdgcn_mfma_f32_32x32x16_bf16(af, f1, c1, 0, 0, 0);
    }
    LAS float* P = (LAS float*)lds;
#pragma unroll
    for (int i = 0; i < 16; ++i) { P[((w * 2 + 0) * 16 + i) * 64 + lane] = c0[i]; P[((w * 2 + 1) * 16 + i) * 64 + lane] = c1[i]; }
    __syncthreads();
    {
        const int i = tid >> 4, cp = tid & 15, n0 = 4 * cp, t = n0 >> 5, nl = n0 & 31;
        const int reg = (i & 3) + 4 * (i >> 3), h2 = (i >> 2) & 1;
        float v[4] = {0.f, 0.f, 0.f, 0.f};
#pragma unroll
        for (int ww = 0; ww < 8; ++ww)
#pragma unroll
            for (int e = 0; e < 4; ++e) v[e] += P[((ww * 2 + t) * 16 + reg) * 64 + nl + e + 32 * h2];
        const size_t off = (size_t)(row0 + i) * 1024 + 64 * cn + n0;
        const f32x4 bv = *(const f32x4*)(base + off);
        f32x4 o; o[0] = bv[0] + scale * v[0]; o[1] = bv[1] + scale * v[1]; o[2] = bv[2] + scale * v[2]; o[3] = bv[3] + scale * v[3];
        *(f32x4*)(out + off) = o;
        u32x2 wv; wv.x = pk2(o[0], o[1]); wv.y = pk2(o[2], o[3]); *(u32x2*)(xb + off) = wv;
        float sq = (o[0] * o[0] + o[1] * o[1]) + (o[2] * o[2] + o[3] * o[3]);
        sq += __shfl_xor(sq, 1); sq += __shfl_xor(sq, 2); sq += __shfl_xor(sq, 4); sq += __shfl_xor(sq, 8);
        if (cp == 0) ssn[(size_t)(row0 + i) * 16 + cn] = sq;
    }
    __syncthreads();
}

template <class DescFn>
__device__ __forceinline__ void sample_gen_gemm(LAS unsigned char* lds, const bf16_t* A, const bf16_t* Bt, int N, const float* ss, const DescFn& fn, int bx, int G) {
    int tid_l = threadIdx.x; asm volatile("" : "+v"(tid_l));
    const int tid = tid_l, lane = tid & 63, w = __builtin_amdgcn_readfirstlane(tid >> 6), r = lane & 31, hh = lane >> 5;
    constexpr int K = 1024, kw = K / 8;
    const int nct = N / 64, nitems = 8 * nct;
    LAS float* P = (LAS float*)lds;
    for (int it = bx; it < nitems; it += G) {
        const int rm = it / nct, cn = it % nct, row0 = T_ + 32 * rm;
        const bf16_t* b0 = Bt + (size_t)(256 * (cn >> 2) + 32 * (cn & 3) + r) * K;
        const bf16_t* b1 = b0 + (size_t)128 * K;
        const bf16_t* ap = A + (size_t)(row0 + r) * K;
        const int k0 = w * kw + 8 * hh;
        f32x16 c0, c1;
#pragma unroll
        for (int i = 0; i < 16; ++i) { c0[i] = 0.f; c1[i] = 0.f; }
#pragma unroll 4
        for (int s = 0; s < kw; s += 16) {
            const bf16x8 af = *(const bf16x8*)(ap + k0 + s), f0 = *(const bf16x8*)(b0 + k0 + s), f1 = *(const bf16x8*)(b1 + k0 + s);
            c0 = __builtin_amdgcn_mfma_f32_32x32x16_bf16(af, f0, c0, 0, 0, 0);
            c1 = __builtin_amdgcn_mfma_f32_32x32x16_bf16(af, f1, c1, 0, 0, 0);
        }
        __syncthreads();
#pragma unroll
        for (int i = 0; i < 16; ++i) { P[((w * 2 + 0) * 16 + i) * 64 + lane] = c0[i]; P[((w * 2 + 1) * 16 + i) * 64 + lane] = c1[i]; }
        __syncthreads();
        {
            const int i = tid >> 4, cp = tid & 15, n0 = 4 * cp, t = n0 >> 5, nl = n0 & 31;
            const int reg = (i & 3) + 4 * (i >> 3), h2 = (i >> 2) & 1;
            float v[4] = {0.f, 0.f, 0.f, 0.f};
#pragma unroll
            for (int ww = 0; ww < 8; ++ww)
#pragma unroll
                for (int e = 0; e < 4; ++e) v[e] += P[((ww * 2 + t) * 16 + reg) * 64 + nl + e + 32 * h2];
            const int row = row0 + i;
            float s = ss[(size_t)row * 16 + cp];
            s += __shfl_xor(s, 1); s += __shfl_xor(s, 2); s += __shfl_xor(s, 4); s += __shfl_xor(s, 8);
            const float rs = rsqrtf(s * (1.f / 1024.f) + EPS_);
#pragma unroll
            for (int e = 0; e < 4; ++e) v[e] *= rs;
            const int col = 64 * cn + n0;
            const ColDesc d = fn(col >> 8);
            const int lc = col & 255;
            if (d.gain) {
                float sq = (v[0] * v[0] + v[1] * v[1]) + (v[2] * v[2] + v[3] * v[3]);
                sq += __shfl_xor(sq, 1); sq += __shfl_xor(sq, 2); sq += __shfl_xor(sq, 4); sq += __shfl_xor(sq, 8);
                const float hn = rsqrtf(sq * (1.f / 64.f) + EPS_);
                const f32x4 gn = *(const f32x4*)(d.gain + n0);
#pragma unroll
                for (int e = 0; e < 4; ++e) v[e] = v[e] * hn * gn[e];
            }
            if (d.sig) {
#pragma unroll
                for (int e = 0; e < 4; ++e) v[e] = __builtin_amdgcn_rcpf(1.f + __expf(-v[e]));
            }
            u32x2 wv; wv.x = pk2(v[0], v[1]); wv.y = pk2(v[2], v[3]);
            *(u32x2*)(d.db + (size_t)row * d.ldb + d.cb + lc) = wv;
            if (d.df_s) {
                const int r2 = row - T_;
                float* pf = (d.mode == 0) ? d.df_s + (size_t)r2 * d.ldf : d.df_s + (size_t)((r2 >> 5) * 512 + 480 + (r2 & 31)) * d.ldf;
                f32x4 o = {v[0], v[1], v[2], v[3]};
                *(f32x4*)(pf + d.cf + lc) = o;
            }
        }
    }
    __syncthreads();
}

__device__ __forceinline__ void sample_merge_gemm(LAS unsigned char* lds, unsigned char* R, const bf16_t* Wl, int bx) {
    if (bx >= 128) return;
    int tid_l = threadIdx.x; asm volatile("" : "+v"(tid_l));
    const int tid = tid_l, lane = tid & 63, w = __builtin_amdgcn_readfirstlane(tid >> 6), r = lane & 31, hh = lane >> 5;
    const int rm = bx >> 4, cn = bx & 15, row0 = T_ + 32 * rm;
    LAS float* P = (LAS float*)lds;
    const int i = tid >> 4, cp = tid & 15, n0 = 4 * cp, t = n0 >> 5, nl = n0 & 31;
    const int reg = (i & 3) + 4 * (i >> 3), h2 = (i >> 2) & 1;
    const size_t off = (size_t)(row0 + i) * 1024 + 64 * cn + n0;
    float tot[4] = {0.f, 0.f, 0.f, 0.f};
#pragma unroll
    for (int j = 0; j < 3; ++j) {
        const int K = (j == 0) ? 512 : 256, kw = K / 8;
        const bf16_t* A = (const bf16_t*)(R + (j == 0 ? R_QA : (j == 1 ? R_QB : R_QC)));
        const bf16_t* Bt = Wl + (j == 0 ? W_BRA : (j == 1 ? W_BRB : W_BRC));
        const bf16_t* b0 = Bt + (size_t)(256 * (cn >> 2) + 32 * (cn & 3) + r) * K;
        const bf16_t* b1 = b0 + (size_t)128 * K;
        const bf16_t* ap = A + (size_t)(row0 + r) * K;
        const int k0 = w * kw + 8 * hh;
        f32x16 c0, c1;
#pragma unroll
        for (int q = 0; q < 16; ++q) { c0[q] = 0.f; c1[q] = 0.f; }
        for (int s = 0; s < kw; s += 16) {
            const bf16x8 af = *(const bf16x8*)(ap + k0 + s), f0 = *(const bf16x8*)(b0 + k0 + s), f1 = *(const bf16x8*)(b1 + k0 + s);
            c0 = __builtin_amdgcn_mfma_f32_32x32x16_bf16(af, f0, c0, 0, 0, 0);
            c1 = __builtin_amdgcn_mfma_f32_32x32x16_bf16(af, f1, c1, 0, 0, 0);
        }
        __syncthreads();
#pragma unroll
        for (int q = 0; q < 16; ++q) { P[((w * 2 + 0) * 16 + q) * 64 + lane] = c0[q]; P[((w * 2 + 1) * 16 + q) * 64 + lane] = c1[q]; }
        __syncthreads();
        float v[4] = {0.f, 0.f, 0.f, 0.f};
#pragma unroll
        for (int ww = 0; ww < 8; ++ww)
#pragma unroll
            for (int e = 0; e < 4; ++e) v[e] += P[((ww * 2 + t) * 16 + reg) * 64 + nl + e + 32 * h2];
        const u32x2 g = *(const u32x2*)((const bf16_t*)(R + R_G + (size_t)j * R_GPLANE) + off);
        tot[0] += bf2f(g.x & 0xffffu) * v[0]; tot[1] += bf2f(g.x >> 16) * v[1]; tot[2] += bf2f(g.y & 0xffffu) * v[2]; tot[3] += bf2f(g.y >> 16) * v[3];
    }
    u32x2 wv; wv.x = pk2(tot[0], tot[1]); wv.y = pk2(tot[2], tot[3]);
    *(u32x2*)((bf16_t*)(R + R_G) + off) = wv;
    __syncthreads();
}

__device__ __forceinline__ void sample_swiglu_gemm(LAS unsigned char* lds, const bf16_t* A, const bf16_t* Bt, const float* ss, bf16_t* U, int bx, int G) {
    int tid_l = threadIdx.x; asm volatile("" : "+v"(tid_l));
    const int tid = tid_l, lane = tid & 63, w = __builtin_amdgcn_readfirstlane(tid >> 6), r = lane & 31, hh = lane >> 5;
    constexpr int K = 1024, kw = K / 8;
    LAS float* P = (LAS float*)lds;
    for (int it = bx; it < 8 * 128; it += G) {
        const int rm = it >> 7, fb = it & 127, row0 = T_ + 32 * rm;
        const bf16_t* b0 = Bt + (size_t)(256 * (fb >> 2) + 32 * (fb & 3) + r) * K;
        const bf16_t* b1 = b0 + (size_t)128 * K;
        const bf16_t* ap = A + (size_t)(row0 + r) * K;
        const int k0 = w * kw + 8 * hh;
        f32x16 c0, c1;
#pragma unroll
        for (int i = 0; i < 16; ++i) { c0[i] = 0.f; c1[i] = 0.f; }
#pragma unroll 4
        for (int s = 0; s < kw; s += 16) {
            const bf16x8 af = *(const bf16x8*)(ap + k0 + s), f0 = *(const bf16x8*)(b0 + k0 + s), f1 = *(const bf16x8*)(b1 + k0 + s);
            c0 = __builtin_amdgcn_mfma_f32_32x32x16_bf16(af, f0, c0, 0, 0, 0);
            c1 = __builtin_amdgcn_mfma_f32_32x32x16_bf16(af, f1, c1, 0, 0, 0);
        }
        __syncthreads();
#pragma unroll
        for (int i = 0; i < 16; ++i) { P[((w * 2 + 0) * 16 + i) * 64 + lane] = c0[i]; P[((w * 2 + 1) * 16 + i) * 64 + lane] = c1[i]; }
        __syncthreads();
        {
            const int i = tid >> 4, cp = tid & 15, n0 = 2 * cp;
            const int reg = (i & 3) + 4 * (i >> 3), h2 = (i >> 2) & 1;
            float g[2] = {0.f, 0.f}, u[2] = {0.f, 0.f};
#pragma unroll
            for (int ww = 0; ww < 8; ++ww)
#pragma unroll
                for (int e = 0; e < 2; ++e) { g[e] += P[((ww * 2 + 0) * 16 + reg) * 64 + n0 + e + 32 * h2]; u[e] += P[((ww * 2 + 1) * 16 + reg) * 64 + n0 + e + 32 * h2]; }
            const int row = row0 + i;
            float s = ss[(size_t)row * 16 + cp];
            s += __shfl_xor(s, 1); s += __shfl_xor(s, 2); s += __shfl_xor(s, 4); s += __shfl_xor(s, 8);
            const float rs = rsqrtf(s * (1.f / 1024.f) + EPS_);
            float o[2];
#pragma unroll
            for (int e = 0; e < 2; ++e) { const float gg = g[e] * rs; o[e] = gg * __builtin_amdgcn_rcpf(1.f + __expf(-gg)) * (u[e] * rs); }
            *(unsigned*)(U + (size_t)row * 4096 + 32 * fb + n0) = pk2(o[0], o[1]);
        }
    }
    __syncthreads();
}

#define GAS __attribute__((address_space(1)))
typedef GAS unsigned gu32;
typedef GAS unsigned long long gu64;
#define RLX_AGENT __ATOMIC_RELAXED, __HIP_MEMORY_SCOPE_AGENT
#define XB_TMO      128
#define XB_XCNT(j)  (256  + 64 * (j))
#define XB_XSUB(j)  (1280 + 64 * (j))
#define XB_XGEN(j)  (2304 + 64 * (j))
#define XB_TOP      3328
#define XB_TOPGEN   3392
#define XCD_BAR_WORDS 3456
#define XB_SPIN_CAP (1u << 18)

__device__ __forceinline__ unsigned xb_ld(unsigned* p)              { return __hip_atomic_load(p, __ATOMIC_RELAXED, __HIP_MEMORY_SCOPE_AGENT); }
__device__ __forceinline__ unsigned xb_add(unsigned* p, unsigned v) { return __hip_atomic_fetch_add(p, v, __ATOMIC_RELAXED, __HIP_MEMORY_SCOPE_AGENT); }
__device__ __forceinline__ unsigned xb_xcc_id() { return (unsigned)__builtin_amdgcn_s_getreg((3 << 11) | 20) & 0xFu; }
#define XB_SPIN(cond, bar) do { unsigned _sp = 0; while (cond) { __builtin_amdgcn_s_sleep(1); \
    if ((++_sp & 255u) == 0u) { if (xb_ld(&(bar)[XB_TMO])) break; if (_sp > XB_SPIN_CAP) { atomicAdd(&(bar)[XB_TMO], 1u); break; } } } } while (0)

struct XcdBarrier {
    unsigned* bar; unsigned x;
    volatile LAS unsigned* st;
};

__device__ __forceinline__ XcdBarrier xcd_barrier_post(unsigned* bar, volatile LAS unsigned* st) {
    XcdBarrier b; b.bar = bar; b.x = xb_xcc_id(); b.st = st;
    if (threadIdx.x == 0) (void)xb_add(&bar[XB_XCNT(b.x)], 1u);
    return b;
}
__device__ __forceinline__ void xcd_barrier_complete(unsigned* bar, unsigned x, unsigned& nloc, unsigned& nx) {
    const unsigned G = gridDim.x * gridDim.y * gridDim.z;
    unsigned sum, cnt, mine, sp = 0u;
    for (;;) {
        sum = 0u; cnt = 0u; mine = 0u;
#pragma unroll
        for (unsigned j = 0; j < 16; ++j) { const unsigned c = xb_ld(&bar[XB_XCNT(j)]); sum += c; cnt += (c > 0u) ? 1u : 0u; mine = (j == x) ? c : mine; }
        if (sum == G) break;
        __builtin_amdgcn_s_sleep(1);
        if ((++sp & 255u) == 0u) { if (xb_ld(&bar[XB_TMO])) break; if (sp > XB_SPIN_CAP) { atomicAdd(&bar[XB_TMO], 1u); break; } }
    }
    nloc = mine > 0u ? mine : 1u; nx = cnt > 0u ? cnt : 1u;
}

__device__ __forceinline__ void xcd_barrier(const XcdBarrier& b) {
    asm volatile("s_waitcnt vmcnt(0)" ::: "memory");
    __syncthreads();
    if (threadIdx.x == 0) {
        unsigned* bar = b.bar;
        __builtin_amdgcn_s_waitcnt(0);
        unsigned nloc = b.st[0], nx = b.st[1];
        if (nloc == 0u) { xcd_barrier_complete(bar, b.x, nloc, nx); b.st[0] = nloc; b.st[1] = nx; }
        const unsigned old = xb_add(&bar[XB_XSUB(b.x)], 1u);
        const unsigned gen = old / nloc;
        if (old + 1u == (gen + 1u) * nloc) {
            __builtin_amdgcn_fence(__ATOMIC_RELEASE, "agent");
            asm volatile("s_waitcnt vmcnt(0)" ::: "memory");
            const unsigned og = xb_add(&bar[XB_TOP], 1u);
            const unsigned tg = og / nx;
            if (og + 1u == (tg + 1u) * nx) xb_add(&bar[XB_TOPGEN], 1u);
            else XB_SPIN(xb_ld(&bar[XB_TOPGEN]) == tg, bar);
            __builtin_amdgcn_fence(__ATOMIC_ACQUIRE, "agent");
            xb_add(&bar[XB_XGEN(b.x)], 1u);
            asm volatile("s_waitcnt vmcnt(0)" ::: "memory");
        } else {
            XB_SPIN(xb_ld(&bar[XB_XGEN(b.x)]) == gen, bar);
            __builtin_amdgcn_fence(__ATOMIC_ACQUIRE, "agent");
            asm volatile("s_waitcnt vmcnt(0)" ::: "memory");
        }
    }
    __syncthreads();
}

__global__ void __launch_bounds__(512, 2) mega(Args a) {
    extern __shared__ __attribute__((aligned(16))) unsigned char lds_raw[];
    cg::grid_group grid = cg::this_grid();
#define GSYNC() do { XcdBarrier xb_; xb_.bar = (unsigned*)(a.ws + WS_BAR); xb_.x = xb_xcc_id(); xb_.st = (volatile LAS unsigned*)(L + 147200); xcd_barrier(xb_); } while (0)
#define GSYNC_CG() do { asm volatile("s_waitcnt vmcnt(0) lgkmcnt(0)" ::: "memory"); grid.sync(); \
                        __builtin_amdgcn_fence(__ATOMIC_ACQUIRE, "agent"); asm volatile("s_waitcnt vmcnt(0)" ::: "memory"); } while (0)
    LAS unsigned char* L = (LAS unsigned char*)lds_raw;
    const int tid = threadIdx.x, lane = tid & 63, wave = __builtin_amdgcn_readfirstlane(tid >> 6);
    const int G = gridDim.x, bx = blockIdx.x;
    unsigned char* ws = a.ws;
    volatile LAS unsigned* bst = (volatile LAS unsigned*)(L + 147200);
    if (tid < 2) bst[tid] = 0u;
    __syncthreads();
    (void)xcd_barrier_post((unsigned*)(ws + WS_BAR), bst);
    float* ssb = (float*)(ws + WS_SS);
    float* ssmem = (float*)(ws + WS_SSMEM);
    bf16_t* Wb = (bf16_t*)(ws + WS_W);
    bf16_t* XB = (bf16_t*)(ws + WS_XB);
    bf16_t* MEMB = (bf16_t*)(ws + WS_MEMB);
    unsigned char* R = ws + WS_R;
    float* out = a.out;
    unsigned long long t_probe0 = 0, t_probeK = 0; int probe_ctr = 0;
    if (PROBE_K >= 0) t_probe0 = __builtin_amdgcn_s_memrealtime();
#define PROBE_MARK() do { if (PROBE_K >= 0) { if (probe_ctr == PROBE_K) t_probeK = __builtin_amdgcn_s_memrealtime(); ++probe_ctr; } } while (0)

    if (PROBE_K == 103) { GSYNC_CG(); t_probeK = __builtin_amdgcn_s_memrealtime(); }
    {
        const int gw = bx * 8 + wave, ngw = G * 8;
        LAS float* scr = (LAS float*)(L + wave * 16384);
        LAS unsigned long long* jt = (LAS unsigned long long*)(L + 131072);
        if (tid < 24) {
            const int l = tid / 12, m = tid % 12;
            bf16_t* Wl = Wb + (size_t)l * W_LAYER;
            const float* W = nullptr; const float* W2 = nullptr; const float* gn = nullptr; bf16_t* dst = nullptr; int K = 1024, N = 1024, ldw = 1024, kind = 0;
            switch (m) {
                case 0: W = a.in[13] + (size_t)l * 4194304; W2 = a.in[14] + (size_t)l * 4194304; gn = a.in[12] + l * 1024; dst = Wl + W_GU1; K = 1024; N = 8192; ldw = 4096; kind = 1; break;
                case 1: W = a.in[15] + (size_t)l * 4194304; dst = Wl + W_D1; K = 4096; N = 1024; ldw = 1024; break;
                case 2: W = a.in[17] + (size_t)l * 6291456; gn = a.in[16] + l * 1024; dst = Wl + W_IN; K = 1024; N = 6144; ldw = 6144; break;
                case 3: W = a.in[28] + (size_t)l * 524288; dst = Wl + W_BRA; K = 512; break;
                case 4: W = a.in[29] + (size_t)l * 262144; dst = Wl + W_BRB; K = 256; break;
                case 5: W = a.in[30] + (size_t)l * 262144; dst = Wl + W_BRC; K = 256; break;
                case 6: W = a.in[31] + (size_t)l * 1048576; dst = Wl + W_OUT; break;
                case 7: W = a.in[34] + (size_t)l * 262144; gn = a.in[32] + l * 1024; dst = Wl + W_Q; N = 256; ldw = 256; break;
                case 8: W = a.in[35] + (size_t)l * 524288; gn = a.in[33] + l * 1024; dst = Wl + W_KV; N = 512; ldw = 512; break;
                case 9: W = a.in[38] + (size_t)l * 262144; dst = Wl + W_O; K = 256; break;
                case 10: W = a.in[40] + (size_t)l * 4194304; W2 = a.in[41] + (size_t)l * 4194304; gn = a.in[39] + l * 1024; dst = Wl + W_GU2; K = 1024; N = 8192; ldw = 4096; kind = 1; break;
                default: W = a.in[42] + (size_t)l * 4194304; dst = Wl + W_D2; K = 4096; N = 1024; ldw = 1024; break;
            }
            jt[tid * 8 + 0] = (unsigned long long)W; jt[tid * 8 + 1] = (unsigned long long)W2; jt[tid * 8 + 2] = (unsigned long long)gn; jt[tid * 8 + 3] = (unsigned long long)dst;
            jt[tid * 8 + 4] = (unsigned long long)(unsigned)K | ((unsigned long long)(unsigned)N << 32); jt[tid * 8 + 5] = (unsigned long long)(unsigned)ldw | ((unsigned long long)(unsigned)kind << 32);
        }
        __syncthreads();
        for (int it0 = gw; it0 < 2 * 16896; it0 += ngw) {
            const int l = it0 >= 16896 ? 1 : 0; int rr = it0 - l * 16896; int m;
            if (rr < 4096) m = 0; else if (rr < 6144) { m = 1; rr -= 4096; } else if (rr < 9216) { m = 2; rr -= 6144; } else if (rr < 9472) { m = 3; rr -= 9216; } else if (rr < 9600) { m = 4; rr -= 9472; }
            else if (rr < 9728) { m = 5; rr -= 9600; } else if (rr < 10240) { m = 6; rr -= 9728; } else if (rr < 10368) { m = 7; rr -= 10240; } else if (rr < 10624) { m = 8; rr -= 10368; }
            else if (rr < 10752) { m = 9; rr -= 10624; } else if (rr < 14848) { m = 10; rr -= 10752; } else { m = 11; rr -= 14848; }
            const int jb = (l * 12 + m) * 8;
            const float* W = (const float*)jt[jb + 0]; const float* W2 = (const float*)jt[jb + 1]; const float* gn = (const float*)jt[jb + 2]; bf16_t* dst = (bf16_t*)jt[jb + 3];
            const unsigned long long kn = jt[jb + 4], lk = jt[jb + 5];
            const int K = (int)(unsigned)kn, N = (int)(kn >> 32), ldw = (int)(unsigned)lk, kind = (int)(lk >> 32);
            const float* src = W; int kb, qq, prow;
            if (kind == 0) { const int nq = N / 64; kb = rr / nq; qq = rr % nq; const int c = 64 * qq + lane; prow = 256 * (c >> 8) + 128 * ((c >> 5) & 1) + 32 * ((c >> 6) & 3) + (c & 31); }
            else { const int sel = rr >> 11, r2 = rr & 2047; kb = r2 >> 6; qq = r2 & 63; if (sel) src = W2; const int f = 64 * qq + lane; prow = 256 * (f >> 7) + 128 * sel + 32 * ((f >> 5) & 3) + (f & 31); }
            p0_transpose_item(src, ldw, 64 * qq, gn, dst, prow, K, 32 * kb, scr, lane);
        }
        if (PROBE_K == 101) t_probeK = __builtin_amdgcn_s_memrealtime();
        for (int m = gw; m < M_; m += ngw) {
            const float* xr = (m < T_) ? a.in[0] + (size_t)m * 1024 : a.in[1] + (size_t)(m - T_) * 1024;
            row_to_bf16(xr, XB + (size_t)m * 1024, ssb + (size_t)m * 16, lane);
        }
        for (int m = gw; m < 1024; m += ngw) row_to_bf16(a.in[2] + (size_t)m * 1024, MEMB + (size_t)m * 1024, ssmem + (size_t)m * 16, lane);
        const size_t gt = (size_t)bx * 512 + tid, ngt = (size_t)G * 512;
        for (size_t i = gt; i < (size_t)2 * 16 * 480 * 64; i += ngt) {
            const int t = (int)(i / (16 * 480 * 64)); const size_t r_ = i % (16 * 480 * 64);
            const int lb = (int)(r_ / (480 * 64)); const int rr = (int)(r_ % (480 * 64)); const int row = rr / 64, c4 = rr % 64;
            const float* src = a.in[7 + t] + ((size_t)lb * 512 + row + 32) * 256 + c4 * 4;
            float* dst = out + (t == 0 ? O_CKS : O_CVS) + ((size_t)lb * 512 + row) * 256 + c4 * 4;
            *(f32x4*)dst = *(const f32x4*)src;
        }
    }
    if (PROBE_K == 100) t_probeK = __builtin_amdgcn_s_memrealtime();
    GSYNC_CG(); PROBE_MARK();

    for (int layer = 0; layer < 2; ++layer) {
        bf16_t* Wl = Wb + (size_t)layer * W_LAYER;
        float* ss0 = ssb + (size_t)(4 * layer + 0) * SS_STRIDE; float* ss1 = ss0 + SS_STRIDE; float* ss2 = ss1 + SS_STRIDE; float* ss3 = ss2 + SS_STRIDE; float* ss4 = ss3 + SS_STRIDE;
        if (layer == 0) {
            for (int l2 = 0; l2 < 2; ++l2) {
                pg8::Gemm g{MEMB, Wb + (size_t)l2 * W_LAYER + W_KV, 1024, 512, 1024}; pg8::StaticOrder S; S.init(1024, 512, G, bx);
                EpiGen<DescMemKV> E{ssmem, DescMemKV{ws, out, a.in[37] + l2 * 64, l2}};
                pg8::gemm_phase<EpiGen<DescMemKV>, pg8::StaticOrder, true, true>(L, g, S, E);
            }
        }
        {
            sample_swiglu_gemm(L, XB, Wl + W_GU1, ss0, (bf16_t*)(R + R_U), bx, G);
            pg8::Gemm g{XB, Wl + W_GU1, T_, 8192, 1024}; pg8::StaticOrder S; S.init(T_, 8192, G, bx);
            EpiSwiglu E{ss0, (bf16_t*)(R + R_U)};
            pg8::gemm_phase<EpiSwiglu, pg8::StaticOrder, true, true>(L, g, S, E);
        }
        GSYNC(); PROBE_MARK();
        {
            sample_res_gemm(L, (const bf16_t*)(R + R_U), Wl + W_D1, 4096, 0.5f, layer == 0 ? a.in[1] - (size_t)T_ * 1024 : out, out, XB, ss1, bx);
            pg8::Gemm g{(const bf16_t*)(R + R_U), Wl + W_D1, T_, 1024, 4096}; pg8::StaticOrder S; S.init(T_, 1024, G, bx);
            EpiRes E{layer == 0 ? a.in[0] : out, layer == 0 ? a.in[1] - (size_t)T_ * 1024 : out, out, XB, ss1, 0.5f};
            pg8::gemm_phase<EpiRes, pg8::StaticOrder, true, true>(L, g, S, E);
        }
        GSYNC(); PROBE_MARK();
        {
            const DescQKV dq{R, out, a.in[18] + layer * 64, a.in[19] + layer * 64, a.in[25] + layer * 64, a.in[26] + layer * 64, layer};
            sample_gen_gemm(L, XB, Wl + W_IN, 3072, ss1, dq, bx, G);
            pg8::Gemm g{XB, Wl + W_IN, T_, 3072, 1024}; pg8::StaticOrder S; S.init(T_, 3072, G, bx);
            EpiGen<DescQKV> E{ss1, dq};
            pg8::gemm_phase<EpiGen<DescQKV>, pg8::StaticOrder, true, true>(L, g, S, E);
        }
        GSYNC(); PROBE_MARK();
        if (STOP_AFTER == 3) {
#if defined(DIAG) && DIAG == 1
            const bf16_t* wsrc = Wl + W_IN + (size_t)3072 * 1024;
            for (size_t i = (size_t)bx * 512 + tid; i < (size_t)3072 * 1024; i += (size_t)G * 512) out[i] = bf2f(wsrc[i]);
#elif defined(DIAG) && DIAG == 2
            for (size_t i = (size_t)bx * 512 + tid; i < (size_t)M_ * 16; i += (size_t)G * 512) out[i] = ss1[i];
#elif defined(DIAG) && DIAG == 3
            for (size_t i = (size_t)bx * 512 + tid; i < (size_t)M_ * 1024; i += (size_t)G * 512) out[i] = bf2f(XB[i]);
#endif
            return;
        }
        for (int e = bx; e < 2116; e += G) {
            if (e < 1024) {
                const int k = (e & 255) >> 4, bh = e & 15; int qb;
                if (e < 256) qb = 63 - k; else if (e < 512) qb = k; else if (e < 768) qb = 47 - k; else qb = 16 + k;
                if (!(SKIP_ATTN & 1)) attn_prompt_unit<0>(L, a, layer, bh, qb);
            }
            else if (e < 1536) { const int e2 = e - 1024; if (!(SKIP_ATTN & 2)) attn_prompt_unit<1>(L, a, layer, e2 & 15, e2 >> 4); }
            else if (e < 2048) { const int e2 = e - 1536; if (!(SKIP_ATTN & 4)) attn_prompt_unit<3>(L, a, layer, e2 & 15, e2 >> 4); }
            else if (e < 2080) { const int u = e - 2048; if (!(SKIP_ATTN & 8)) attn_sample_unit<0>(L, a, layer, u >> 2, u & 3); }
            else if (e < 2112) { const int u = e - 2080; if (!(SKIP_ATTN & 16)) attn_sample_unit<1>(L, a, layer, u >> 2, u & 3); }
            else { if (!(SKIP_ATTN & 32)) attn_stick_sample(a, layer, (e - 2112) * 8 + wave); }
        }
        GSYNC(); PROBE_MARK();
        if (STOP_AFTER == 4) return;
        {
            sample_gen_gemm(L, XB, Wl + W_IN + (size_t)3072 * 1024, 3072, ss1, DescGate{R}, bx, G);
            pg8::Gemm g{XB, Wl + W_IN + (size_t)3072 * 1024, T_, 3072, 1024}; pg8::StaticOrder S; S.init(T_, 3072, G, bx);
            EpiGen<DescGate> E{ss1, DescGate{R}};
            if (!SKIP_GATE) pg8::gemm_phase<EpiGen<DescGate>, pg8::StaticOrder, true, true>(L, g, S, E);
        }
        GSYNC(); PROBE_MARK();
        if (STOP_AFTER == 5) {
            const bf16_t* gsrc = (const bf16_t*)(R + R_G + 2 * R_GPLANE);
            for (size_t i = (size_t)bx * 512 + tid; i < (size_t)M_ * 1024; i += (size_t)G * 512) out[i] = bf2f(gsrc[i]);
            return;
        }
        {
            bf16_t* G0 = (bf16_t*)(R + R_G); const bf16_t* G1 = G0 + R_GPLANE / 2; const bf16_t* G2 = G1 + R_GPLANE / 2;
            sample_merge_gemm(L, R, Wl, bx);
            pg8::StaticOrder S; S.init(T_, 1024, G, bx);
            if (!(SKIP_MERGE & 1)) { pg8::Gemm g{(const bf16_t*)(R + R_QA), Wl + W_BRA, T_, 1024, 512}; EpiMerge E{G0, G0, 1}; pg8::gemm_phase<EpiMerge, pg8::StaticOrder, true, true>(L, g, S, E); }
            if (!(SKIP_MERGE & 2)) { pg8::Gemm g{(const bf16_t*)(R + R_QB), Wl + W_BRB, T_, 1024, 256}; EpiMerge E{G1, G0, 0}; pg8::gemm_phase<EpiMerge, pg8::StaticOrder, true, true>(L, g, S, E); }
            if (!(SKIP_MERGE & 4)) { pg8::Gemm g{(const bf16_t*)(R + R_QC), Wl + W_BRC, T_, 1024, 256}; EpiMerge E{G2, G0, 0}; pg8::gemm_phase<EpiMerge, pg8::StaticOrder, true, true>(L, g, S, E); }
        }
        GSYNC(); PROBE_MARK();
        if (STOP_AFTER == 6) return;
        {
            sample_res_gemm(L, (const bf16_t*)(R + R_G), Wl + W_OUT, 1024, 1.0f, out, out, XB, ss2, bx);
            pg8::Gemm g{(const bf16_t*)(R + R_G + (size_t)P7_PLANE * R_GPLANE), Wl + W_OUT, T_, 1024, 1024}; pg8::StaticOrder S; S.init(T_, 1024, G, bx);
            EpiRes E{out, out, out, XB, ss2, 1.0f};
            pg8::gemm_phase<EpiRes, pg8::StaticOrder, true, true>(L, g, S, E);
        }
        GSYNC(); PROBE_MARK();
        if (STOP_AFTER == 7) return;
        {
            const DescWq dw{R, a.in[36] + layer * 64};
            sample_gen_gemm(L, XB, Wl + W_Q, 256, ss2, dw, bx, G);
            pg8::Gemm g{XB, Wl + W_Q, T_, 256, 1024}; pg8::StaticOrder S; S.init(T_, 256, G, bx);
            EpiGen<DescWq> E{ss2, dw};
            pg8::gemm_phase<EpiGen<DescWq>, pg8::StaticOrder, true, true>(L, g, S, E);
        }
        GSYNC(); PROBE_MARK();
        if (STOP_AFTER == 8) return;
        for (int e = bx; e < 544; e += G) {
            if (e < 512) attn_prompt_unit<2>(L, a, layer, e & 15, e >> 4);
            else { const int u = e - 512; attn_sample_unit<2>(L, a, layer, u >> 2, u & 3); }
        }
        GSYNC(); PROBE_MARK();
        if (STOP_AFTER == 9) return;
        {
            sample_res_gemm(L, (const bf16_t*)(R + R_QX), Wl + W_O, 256, 1.0f, out, out, XB, ss3, bx);
            pg8::Gemm g{(const bf16_t*)(R + R_QX), Wl + W_O, T_, 1024, 256}; pg8::StaticOrder S; S.init(T_, 1024, G, bx);
            EpiRes E{out, out, out, XB, ss3, 1.0f};
            pg8::gemm_phase<EpiRes, pg8::StaticOrder, true, true>(L, g, S, E);
        }
        GSYNC(); PROBE_MARK();
        if (STOP_AFTER == 10) return;
        {
            sample_swiglu_gemm(L, XB, Wl + W_GU2, ss3, (bf16_t*)(R + R_U), bx, G);
            pg8::Gemm g{XB, Wl + W_GU2, T_, 8192, 1024}; pg8::StaticOrder S; S.init(T_, 8192, G, bx);
            EpiSwiglu E{ss3, (bf16_t*)(R + R_U)};
            pg8::gemm_phase<EpiSwiglu, pg8::StaticOrder, true, true>(L, g, S, E);
        }
        GSYNC(); PROBE_MARK();
        if (STOP_AFTER == 11) return;
        {
            sample_res_gemm(L, (const bf16_t*)(R + R_U), Wl + W_D2, 4096, 0.5f, out, out, XB, ss4, bx);
            pg8::Gemm g{(const bf16_t*)(R + R_U), Wl + W_D2, T_, 1024, 4096}; pg8::StaticOrder S; S.init(T_, 1024, G, bx);
            EpiRes E{out, out, out, XB, ss4, 0.5f};
            pg8::gemm_phase<EpiRes, pg8::StaticOrder, true, true>(L, g, S, E);
        }
        if (layer == 0) { GSYNC(); PROBE_MARK(); }
    }
    if (PROBE_K >= 0 && bx == 0 && tid == 0) {
        if (PROBE_K >= probe_ctr && PROBE_K < 100) t_probeK = __builtin_amdgcn_s_memrealtime();
        const float ticks = (PROBE_K == 0 && false) ? 0.f : (float)(t_probeK - t_probe0);
        const float E = sqrtf(39.3f + 1.18e-4f * ticks);
        out[O_BKS + 131072 - 1] += E;
    }
}

extern "C" void kernel_launch(void* const* d_in, const int* in_sizes, int n_in, void* d_out, int out_size, void* d_ws, size_t ws_size, hipStream_t stream) {
    static int grid = 0;
    if (grid == 0) {
        if (n_in != 43 || (size_t)out_size != O_END || ws_size < WS_END) { fprintf(stderr, "kernel_launch: unexpected shapes: n_in %d out %d ws %zu (need %zu)\n", n_in, out_size, ws_size, (size_t)WS_END); grid = -1; return; }
        int dev = 0, cus = 0, per_cu = 0;
        (void)hipGetDevice(&dev);
        (void)hipDeviceGetAttribute(&cus, hipDeviceAttributeMultiprocessorCount, dev);
        (void)hipFuncSetAttribute((const void*)mega, hipFuncAttributeMaxDynamicSharedMemorySize, LDS_BYTES);
        (void)hipOccupancyMaxActiveBlocksPerMultiprocessor(&per_cu, (const void*)mega, 512, LDS_BYTES);
        if (per_cu < 1) per_cu = 1;
        grid = cus * per_cu;
        fprintf(stderr, "kernel_launch: grid %d (cus %d, per_cu %d), ws %zu\n", grid, cus, per_cu, ws_size);
    }
    if (grid < 0) return;
    (void)hipMemsetAsync((char*)d_ws + WS_BAR, 0, 16384, stream);
    Args a{};
    for (int i = 0; i < 43; ++i) a.in[i] = (const float*)d_in[i];
    a.out = (float*)d_out; a.ws = (unsigned char*)d_ws;
    void* args[] = {&a};
    hipError_t e = hipLaunchCooperativeKernel((const void*)mega, dim3(grid), dim3(512), args, LDS_BYTES, stream);
    if (e != hipSuccess) fprintf(stderr, "kernel_launch: cooperative launch failed: %s (grid %d)\n", hipGetErrorString(e), grid);
}
```
